# Optimizing an MI355X kernel written in HIP

```python
import math
import jax, jax.numpy as jnp
from jax import lax
import numpy as np

D_MODEL = 2048
BATCH = 4
SEQ = 4096
DEPTH = 2

GRID_W = 64
CTX_LEN = 256
N_MIXERS = 2
N_HYENA_LAYERS = (DEPTH + 1) // 2
N_S5_LAYERS = DEPTH // 2
HY_EMB = 33
HY_BANDS = (HY_EMB - 1) // 2
HY_ORDER = 64
HY_DECAY_TARGET = 1e-2
HY_FAST_PCT = 0.3
HY_SLOW_PCT = 1.5
S5_H = 16
S5_P = 64
S5_G = D_MODEL // S5_H
S5_DT_MIN = 1e-3
S5_DT_MAX = 1e-1
N_GROUPS = 4
EXPERTS_PER_GROUP = 8
N_EXPERTS = N_GROUPS * EXPERTS_PER_GROUP
TOP_K = 2
D_EXPERT = D_MODEL // 2
MOE_BLOCK = 128
NORM_EPS = 1e-6

kernel_name = "hybrid_hyena_s5_hmoe_dit"


def _rmsnorm(x, g):
    x32 = x.astype(jnp.float32)
    y = x32 * lax.rsqrt(jnp.mean(x32 * x32, axis=-1, keepdims=True) + NORM_EPS)
    return y.astype(x.dtype) * g


def _modulate(h, shift, scale):
    return h * (1 + scale) + shift


def _hyena_filter(L, fw1, fb1, fw2, fb2, fw3, freq):
    f32 = jnp.float32
    t = jnp.linspace(0.0, 1.0, L, dtype=f32)[:, None]
    w = (2.0 * math.pi / L) * jnp.arange(L, dtype=f32)[:, None]
    bands = jnp.linspace(1e-4, HY_BANDS - 1, HY_BANDS, dtype=f32)[None, :]
    z = jnp.concatenate([t, jnp.cos(bands * w), -jnp.sin(bands * w)], axis=-1)
    fr = freq.astype(f32)
    h = jnp.sin(fr * (z @ fw1.astype(f32) + fb1.astype(f32)))
    h = jnp.sin(fr * (h @ fw2.astype(f32) + fb2.astype(f32)))
    h = (h @ fw3.astype(f32)).reshape(L, 2, D_MODEL)
    max_decay = math.log(HY_DECAY_TARGET) / HY_FAST_PCT
    min_decay = math.log(HY_DECAY_TARGET) / HY_SLOW_PCT
    deltas = jnp.abs(jnp.linspace(min_decay, max_decay, D_MODEL, dtype=f32))
    h = h * jnp.exp(-t * deltas)[:, None, :]
    k = jnp.concatenate([h[:, 0], jnp.zeros((1, D_MODEL), f32), h[:0:-1, 1]], axis=0)
    return k / jnp.sum(jnp.abs(k), axis=0, keepdims=True)


def _hyena_mix(u, w_in, b_in, conv_w, conv_b, fw1, fb1, fw2, fb2, fw3, freq, skip, w_out, b_out):
    L = u.shape[1]
    z = u @ w_in + b_in
    zp = jnp.pad(z, ((0, 0), (1, 1), (0, 0)))
    z = zp[:, :-2] * conv_w[0] + zp[:, 1:-1] * conv_w[1] + zp[:, 2:] * conv_w[2] + conv_b
    x0, x1, v = jnp.split(z, 3, axis=-1)
    v = (v * x1).astype(jnp.float32)
    k = _hyena_filter(L, fw1, fb1, fw2, fb2, fw3, freq)
    n = 2 * L
    y = jnp.fft.irfft(jnp.fft.rfft(v, n=n, axis=1) * jnp.fft.rfft(k, n=n, axis=0)[None], n=n, axis=1)[:, :L]
    y = y + skip.astype(jnp.float32) * v
    y = y.astype(u.dtype) * x0
    return y @ w_out + b_out


def _ssm_op(e1, e2):
    a1, b1 = e1
    a2, b2 = e2
    return a1 * a2, a2 * b1 + b2


def _diag_scan(bu, lam_bar, h0):
    if h0 is not None:
        bu = bu.at[:, 0].add(lam_bar * h0)
    a = jnp.broadcast_to(lam_bar, (1, bu.shape[1]) + lam_bar.shape)
    _, h = lax.associative_scan(_ssm_op, (a, bu), axis=1)
    return h


def _s5_mix(u_lat, u_ctx, a_re, a_im, log_step, b_re, b_im, c_re, c_im, d_skip, w1, b1, w2, b2, ctx_out):
    f32 = jnp.float32
    Bn, L, _ = u_lat.shape
    Lc = u_ctx.shape[1]
    ul = u_lat.astype(f32)
    uc = u_ctx.astype(f32)
    ulg = ul.reshape(Bn, L, S5_G, S5_H)
    ucg = uc.reshape(Bn, Lc, S5_G, S5_H)
    y_lat = d_skip.astype(f32) * ul
    y_ctx = d_skip.astype(f32) * uc if ctx_out else None
    for d in range(2):
        lam = lax.complex(a_re[d].astype(f32), a_im[d].astype(f32))
        step = jnp.exp(log_step[d].astype(f32))[:, None]
        lam_bar = jnp.exp(lam * step)
        b_bar = ((lam_bar - 1.0) / lam)[..., None] * lax.complex(b_re[d].astype(f32), b_im[d].astype(f32))
        c_mat = lax.complex(c_re[d].astype(f32), c_im[d].astype(f32))
        orient = (lambda t: jnp.flip(t, axis=1)) if d == 1 else (lambda t: t)
        h_ctx = _diag_scan(orient(jnp.einsum('blgh,gph->blgp', ucg, b_bar)), lam_bar, None)
        h_lat = _diag_scan(orient(jnp.einsum('blgh,gph->blgp', ulg, b_bar)), lam_bar, h_ctx[:, -1])
        y_lat = y_lat + orient(jnp.real(jnp.einsum('blgp,ghp->blgh', h_lat, c_mat))).reshape(Bn, L, D_MODEL)
        if ctx_out:
            y_ctx = y_ctx + orient(jnp.real(jnp.einsum('blgp,ghp->blgh', h_ctx, c_mat))).reshape(Bn, Lc, D_MODEL)

    def glu(y, dtype):
        y = jax.nn.gelu(y).astype(dtype)
        return (y @ w1 + b1) * jax.nn.sigmoid(y @ w2 + b2)

    o_lat = glu(y_lat, u_lat.dtype)
    o_ctx = glu(y_ctx, u_ctx.dtype) if ctx_out else None
    return o_lat, o_ctx


def _hier_moe(t, wg, bg, we, be, w_gate, w_up, w_down):
    T = t.shape[0]
    pg = jax.nn.softmax((t @ wg + bg).astype(jnp.float32), axis=-1)
    p_top, g_idx = lax.top_k(pg, 1)
    le = (t @ we + be).astype(jnp.float32).reshape(T, N_GROUPS, EXPERTS_PER_GROUP)
    le_sel = jnp.take_along_axis(le, g_idx[:, :, None], axis=1)[:, 0]
    vals, e_idx = lax.top_k(le_sel, TOP_K)
    gate = p_top * jax.nn.softmax(vals, axis=-1)
    expert = g_idx * EXPERTS_PER_GROUP + e_idx

    A = T * TOP_K
    e_flat = expert.reshape(-1)
    order = jnp.argsort(e_flat)
    e_sorted = e_flat[order]
    tok_sorted = order // TOP_K
    gate_sorted = gate.reshape(-1)[order].astype(t.dtype)
    counts = jax.ops.segment_sum(jnp.ones((A,), jnp.int32), e_flat, num_segments=N_EXPERTS)
    start = jnp.cumsum(counts) - counts
    padded = (counts + MOE_BLOCK - 1) // MOE_BLOCK * MOE_BLOCK
    pad_end = jnp.cumsum(padded)
    pad_start = pad_end - padded
    dest = pad_start[e_sorted] + jnp.arange(A, dtype=jnp.int32) - start[e_sorted]
    n_blocks = -(-A // MOE_BLOCK) + N_EXPERTS
    buf = jnp.zeros((n_blocks * MOE_BLOCK, t.shape[1]), t.dtype).at[dest].set(t[tok_sorted])
    block_expert = jnp.minimum(
        jnp.searchsorted(pad_end, jnp.arange(n_blocks, dtype=jnp.int32) * MOE_BLOCK, side='right'),
        N_EXPERTS - 1)

    def expert_block(args):
        xb, e = args
        h = jax.nn.silu(xb @ w_gate[e]) * (xb @ w_up[e])
        return h @ w_down[e]

    out = lax.map(expert_block, (buf.reshape(n_blocks, MOE_BLOCK, -1), block_expert))
    y = out.reshape(n_blocks * MOE_BLOCK, -1)[dest] * gate_sorted[:, None]
    return jax.ops.segment_sum(y, tok_sorted, num_segments=T)


def setup_inputs(seed: int = 0) -> dict:
    key = jax.random.key(seed)
    ks = iter(jax.random.split(key, 64))
    f32 = jnp.float32
    D = D_MODEL
    NH, NS = N_HYENA_LAYERS, N_S5_LAYERS

    def nrm(shape, scale):
        return scale * jax.random.normal(next(ks), shape, f32)

    return {
        "x": nrm((BATCH, SEQ, D), 1.0),
        "c": nrm((BATCH, D), 1.0),
        "ctx": nrm((BATCH, CTX_LEN, D), 1.0),
        "c_ctx": nrm((D,), 1.0),
        "ada_w": nrm((DEPTH, D, 6 * D), 0.5 * D ** -0.5),
        "ada_b": nrm((DEPTH, 6 * D), 0.02),
        "norm_g": 1.0 + nrm((DEPTH, 2, D), 0.05),
        "final_g": 1.0 + nrm((D,), 0.05),
        "hy_w_in": nrm((NH, D, 3 * D), D ** -0.5),
        "hy_b_in": nrm((NH, 3 * D), 0.02),
        "hy_conv_w": nrm((NH, 3, 3 * D), 3 ** -0.5),
        "hy_conv_b": nrm((NH, 3 * D), 0.02),
        "hy_fw1": nrm((NH, HY_EMB, HY_ORDER), HY_EMB ** -0.5),
        "hy_fb1": nrm((NH, HY_ORDER), 0.5),
        "hy_fw2": nrm((NH, HY_ORDER, HY_ORDER), HY_ORDER ** -0.5),
        "hy_fb2": nrm((NH, HY_ORDER), 0.5),
        "hy_fw3": nrm((NH, HY_ORDER, 2 * D), HY_ORDER ** -0.5),
        "hy_freq": 1.0 + nrm((NH, HY_ORDER), 0.1),
        "hy_skip": nrm((NH, D), 0.5),
        "hy_w_out": nrm((NH, D, D), D ** -0.5),
        "hy_b_out": nrm((NH, D), 0.02),
        "s5_a_re": -0.5 + nrm((NS, 2, S5_G, S5_P), 0.01),
        "s5_a_im": math.pi * jnp.arange(S5_P, dtype=f32) + nrm((NS, 2, S5_G, S5_P), 0.01),
        "s5_log_step": jax.random.uniform(next(ks), (NS, 2, S5_G), f32,
                                          math.log(S5_DT_MIN), math.log(S5_DT_MAX)),
        "s5_b_re": nrm((NS, 2, S5_G, S5_P, S5_H), (2 * S5_H) ** -0.5),
        "s5_b_im": nrm((NS, 2, S5_G, S5_P, S5_H), (2 * S5_H) ** -0.5),
        "s5_c_re": nrm((NS, 2, S5_G, S5_H, S5_P), S5_P ** -0.5),
        "s5_c_im": nrm((NS, 2, S5_G, S5_H, S5_P), S5_P ** -0.5),
        "s5_d": nrm((NS, D), 1.0),
        "s5_w1": nrm((NS, D, D), D ** -0.5),
        "s5_b1": nrm((NS, D), 0.02),
        "s5_w2": nrm((NS, D, D), D ** -0.5),
        "s5_b2": nrm((NS, D), 0.02),
        "moe_wg": nrm((DEPTH, D, N_GROUPS), D ** -0.5),
        "moe_bg": nrm((DEPTH, N_GROUPS), 0.01),
        "moe_we": nrm((DEPTH, D, N_EXPERTS), D ** -0.5),
        "moe_be": nrm((DEPTH, N_EXPERTS), 0.01),
        "moe_w_gate": nrm((DEPTH, N_EXPERTS, D, D_EXPERT), D ** -0.5),
        "moe_w_up": nrm((DEPTH, N_EXPERTS, D, D_EXPERT), D ** -0.5),
        "moe_w_down": nrm((DEPTH, N_EXPERTS, D_EXPERT, D), D_EXPERT ** -0.5),
    }


def reference(x, c, ctx, c_ctx, ada_w, ada_b, norm_g, final_g,
              hy_w_in, hy_b_in, hy_conv_w, hy_conv_b, hy_fw1, hy_fb1, hy_fw2, hy_fb2, hy_fw3,
              hy_freq, hy_skip, hy_w_out, hy_b_out,
              s5_a_re, s5_a_im, s5_log_step, s5_b_re, s5_b_im, s5_c_re, s5_c_im, s5_d,
              s5_w1, s5_b1, s5_w2, s5_b2,
              moe_wg, moe_bg, moe_we, moe_be, moe_w_gate, moe_w_up, moe_w_down):
    xl, xc = x, ctx
    for i in range(DEPTH):
        last = i == DEPTH - 1
        j = i // N_MIXERS
        sh_a, sc_a, gt_a, sh_f, sc_f, gt_f = [m[:, None, :] for m in
                                             jnp.split(jax.nn.silu(c) @ ada_w[i] + ada_b[i], 6, axis=-1)]
        csh_a, csc_a, cgt_a, csh_f, csc_f, cgt_f = jnp.split(jax.nn.silu(c_ctx) @ ada_w[i] + ada_b[i], 6, axis=-1)

        hl = _modulate(_rmsnorm(xl, norm_g[i, 0]), sh_a, sc_a)
        hc = _modulate(_rmsnorm(xc, norm_g[i, 0]), csh_a, csc_a)
        if i % N_MIXERS == 0:
            ol = _hyena_mix(hl, hy_w_in[j], hy_b_in[j], hy_conv_w[j], hy_conv_b[j], hy_fw1[j], hy_fb1[j],
                            hy_fw2[j], hy_fb2[j], hy_fw3[j], hy_freq[j], hy_skip[j], hy_w_out[j], hy_b_out[j])
            oc = None if last else _hyena_mix(hc, hy_w_in[j], hy_b_in[j], hy_conv_w[j], hy_conv_b[j], hy_fw1[j],
                                              hy_fb1[j], hy_fw2[j], hy_fb2[j], hy_fw3[j], hy_freq[j],
                                              hy_skip[j], hy_w_out[j], hy_b_out[j])
        else:
            ol, oc = _s5_mix(hl, hc, s5_a_re[j], s5_a_im[j], s5_log_step[j], s5_b_re[j], s5_b_im[j],
                             s5_c_re[j], s5_c_im[j], s5_d[j], s5_w1[j], s5_b1[j], s5_w2[j], s5_b2[j],
                             not last)
        xl = xl + gt_a * ol
        if not last:
            xc = xc + cgt_a * oc

        n_lat = xl.shape[0] * xl.shape[1]
        tok = _modulate(_rmsnorm(xl, norm_g[i, 1]), sh_f, sc_f).reshape(n_lat, D_MODEL)
        if not last:
            tok_c = _modulate(_rmsnorm(xc, norm_g[i, 1]), csh_f, csc_f).reshape(-1, D_MODEL)
            tok = jnp.concatenate([tok, tok_c], axis=0)
        mo = _hier_moe(tok, moe_wg[i], moe_bg[i], moe_we[i], moe_be[i],
                       moe_w_gate[i], moe_w_up[i], moe_w_down[i])
        xl = xl + gt_f * mo[:n_lat].reshape(xl.shape)
        if not last:
            xc = xc + cgt_f * mo[n_lat:].reshape(xc.shape)
    return _rmsnorm(xl, final_g)
```

```cpp
#define MK_N_LAUNCHES 17
#include <hip/hip_runtime.h>
#include <cstdio>
#include <cstdint>

#define LAS __attribute__((address_space(3)))
#define GAS __attribute__((address_space(1)))
typedef unsigned short bf16;
typedef short bf16x8 __attribute__((ext_vector_type(8)));
typedef float f32x4 __attribute__((ext_vector_type(4)));
typedef float f32x2 __attribute__((ext_vector_type(2)));
typedef float f32x16 __attribute__((ext_vector_type(16)));
typedef unsigned u32x4 __attribute__((ext_vector_type(4)));
typedef unsigned u32x2 __attribute__((ext_vector_type(2)));

constexpr int D = 2048, NB = 4, SL = 4096, CL = 256, TL = NB * SL  , TC = NB * CL  , TT = TL + TC  ;
constexpr int NE = 32, DE = 1024, NRB_MAX = 168, ZLD = TT;
constexpr float EPS = 1e-6f;
constexpr int NWAVES = 8, NTHR = 512;

constexpr size_t MiB = 1u << 20;
constexpr size_t WS_CTL = 0, CTL_BYTES = 1 * MiB;
constexpr size_t WS_MOD = 1 * MiB;
constexpr size_t WS_LIST = 2 * MiB;
constexpr size_t WS_TOKPOS = 5 * MiB;
constexpr size_t WS_GATE = 5 * MiB + 512 * 1024;
constexpr size_t WS_KRN = 6 * MiB;
constexpr size_t WS_KRC = 38 * MiB;
constexpr size_t WS_WIN = 40 * MiB;
constexpr size_t WS_WOUT = 64 * MiB;
constexpr size_t WS_W12 = 72 * MiB;
constexpr size_t WS_WGU = 88 * MiB;
constexpr size_t WS_WD = 600 * MiB;
constexpr size_t WS_XC = 856 * MiB;
constexpr size_t WS_U = 864 * MiB;
constexpr size_t WS_ZT = 932 * MiB;
constexpr size_t WS_YXT = 1136 * MiB;
constexpr size_t WS_YX = 1204 * MiB;
constexpr size_t WS_H = 1272 * MiB;
constexpr size_t WS_EO = 1356 * MiB;
constexpr size_t WS_END = 1524 * MiB;
constexpr size_t WS_YF = WS_ZT, WS_YB = WS_ZT + 64 * MiB, WS_G = WS_ZT + 128 * MiB;

constexpr int CW_TMO = 0;
constexpr int CW_BAR = 4096;
constexpr int CW_CNT = 8192;

constexpr int LDS_BYTES = 147456;
constexpr int ROWTAB_OFF = 131072;
constexpr int TAB_OFF = 139264;
constexpr int MISC_OFF = 141312;

#define LDS_WAIT() asm volatile("s_waitcnt lgkmcnt(0)" ::: "memory")
#define VM_WAIT() asm volatile("s_waitcnt vmcnt(0)" ::: "memory")
__device__ __forceinline__ unsigned f2bf(float f) { unsigned u = __builtin_bit_cast(unsigned, f); return (u + 0x7fffu + ((u >> 16) & 1u)) >> 16; }
__device__ __forceinline__ unsigned pk2(float lo, float hi) { return f2bf(lo) | (f2bf(hi) << 16); }
__device__ __forceinline__ float bf2f(unsigned short b) { return __builtin_bit_cast(float, ((unsigned)b) << 16); }
__device__ __forceinline__ float bflo(unsigned w) { return __builtin_bit_cast(float, w << 16); }
__device__ __forceinline__ float bfhi(unsigned w) { return __builtin_bit_cast(float, w & 0xffff0000u); }
__device__ __forceinline__ float wave_sum(float v) {
#pragma unroll
    for (int o = 1; o < 64; o <<= 1) v += __shfl_xor(v, o);
    return v;
}
__device__ __forceinline__ float sigmoidf_(float x) { return 1.0f / (1.0f + __expf(-x)); }
__device__ __forceinline__ float siluf_(float x) { return x / (1.0f + __expf(-x)); }

#define XB_TMO      128
#define XB_XCNT(j)  (256  + 64 * (j))
#define XB_XSUB(j)  (1280 + 64 * (j))
#define XB_XGEN(j)  (2304 + 64 * (j))
#define XB_TOP      3328
#define XB_TOPGEN   3392
#define XCD_BAR_WORDS 3456
#define XB_SPIN_CAP (1u << 18)
__device__ __forceinline__ unsigned xb_ld(unsigned* p)              { return __hip_atomic_load(p, __ATOMIC_RELAXED, __HIP_MEMORY_SCOPE_AGENT); }
__device__ __forceinline__ unsigned xb_add(unsigned* p, unsigned v) { return __hip_atomic_fetch_add(p, v, __ATOMIC_RELAXED, __HIP_MEMORY_SCOPE_AGENT); }
__device__ __forceinline__ unsigned xb_xcc_id() { return (unsigned)__builtin_amdgcn_s_getreg((3 << 11) | 20) & 0xFu; }
#define XB_SPIN(cond, bar) do { unsigned _sp = 0; while (cond) { __builtin_amdgcn_s_sleep(1); \
    if ((++_sp & 255u) == 0u) { if (xb_ld(&(bar)[XB_TMO])) break; if (_sp > XB_SPIN_CAP) { atomicAdd(&(bar)[XB_TMO], 1u); break; } } } } while (0)
struct XcdBarrier { unsigned* bar; unsigned x; volatile LAS unsigned* st; };
__device__ __forceinline__ XcdBarrier xcd_barrier_post(unsigned* bar, volatile LAS unsigned* st) {
    XcdBarrier b; b.bar = bar; b.x = xb_xcc_id(); b.st = st;
    if (threadIdx.x == 0) (void)xb_add(&bar[XB_XCNT(b.x)], 1u);
    return b;
}
__device__ __forceinline__ void xcd_barrier_complete(unsigned* bar, unsigned x, unsigned& nloc, unsigned& nx) {
    const unsigned G = gridDim.x * gridDim.y * gridDim.z;
    unsigned sum, cnt, mine, sp = 0u;
    for (;;) {
        sum = 0u; cnt = 0u; mine = 0u;
#pragma unroll
        for (unsigned j = 0; j < 16; ++j) { const unsigned c = xb_ld(&bar[XB_XCNT(j)]); sum += c; cnt += (c > 0u) ? 1u : 0u; mine = (j == x) ? c : mine; }
        if (sum == G) break;
        __builtin_amdgcn_s_sleep(1);
        if ((++sp & 255u) == 0u) { if (xb_ld(&bar[XB_TMO])) break; if (sp > XB_SPIN_CAP) { atomicAdd(&bar[XB_TMO], 1u); break; } }
    }
    nloc = mine > 0u ? mine : 1u; nx = cnt > 0u ? cnt : 1u;
}
__device__ __forceinline__ void xcd_barrier(const XcdBarrier& b) {
    asm volatile("s_waitcnt vmcnt(0)" ::: "memory");
    __syncthreads();
    if (threadIdx.x == 0) {
        unsigned* bar = b.bar;
        __builtin_amdgcn_s_waitcnt(0);
        unsigned nloc = b.st[0], nx = b.st[1];
        if (nloc == 0u) { xcd_barrier_complete(bar, b.x, nloc, nx); b.st[0] = nloc; b.st[1] = nx; }
        const unsigned old = xb_add(&bar[XB_XSUB(b.x)], 1u);
        const unsigned gen = old / nloc;
        if (old + 1u == (gen + 1u) * nloc) {
            __builtin_amdgcn_fence(__ATOMIC_RELEASE, "agent");
            asm volatile("s_waitcnt vmcnt(0)" ::: "memory");
            const unsigned og = xb_add(&bar[XB_TOP], 1u);
            const unsigned tg = og / nx;
            if (og + 1u == (tg + 1u) * nx) xb_add(&bar[XB_TOPGEN], 1u);
            else XB_SPIN(xb_ld(&bar[XB_TOPGEN]) == tg, bar);
            __builtin_amdgcn_fence(__ATOMIC_ACQUIRE, "agent");
            xb_add(&bar[XB_XGEN(b.x)], 1u);
            asm volatile("s_waitcnt vmcnt(0)" ::: "memory");
        } else {
            XB_SPIN(xb_ld(&bar[XB_XGEN(b.x)]) == gen, bar);
            __builtin_amdgcn_fence(__ATOMIC_ACQUIRE, "agent");
            asm volatile("s_waitcnt vmcnt(0)" ::: "memory");
        }
    }
    __syncthreads();
}
namespace pg8 {
constexpr int BM = 256, BK = 64, HALF = 128, HTB = HALF * BK * 2, STAGE_BYTES = 8 * HTB, NXCD = 8, WGM = 8;
__device__ __forceinline__ int lds_byte(int r, int c) { const int st = (r >> 4) * 2 + (c >> 5), rr = r & 15, cc = c & 31, ob = rr * 64 + cc * 2; return st * 1024 + (ob ^ (((ob >> 9) & 1) << 5)); }
__device__ __forceinline__ void stage_rc(int b, int& R, int& C) { const int st = b / 1024, sb = b % 1024, swz = sb ^ (((sb >> 9) & 1) << 5); R = (st >> 1) * 16 + swz / 64; C = (st & 1) * 32 + (swz % 64) / 2; }
__device__ __forceinline__ int perm32(int rho) { const int n = rho >> 4, i = rho & 15; return 8 * (i >> 2) + 4 * n + (i & 3); }

struct Unit { const char* A; const char* B; int pm, pn, ui; };

struct DenseOrder {
    const char* A; const char* B; int nM, nN, nwg, G, c; size_t tstep;
    __device__ __forceinline__ void init(const void* A_, const void* B_, int M, int N, int K, int G_, int c_) { A = (const char*)A_; B = (const char*)B_; nM = M / BM; nN = N / BM; nwg = nM * nN; G = G_; c = c_; tstep = (size_t)BM * K * 2; }
    __device__ __forceinline__ bool next(int i, Unit& u) const {
        const long L = (long)i * G + c; if (L >= nwg) return false;
        int wgid = (int)L; { const int q = nwg / NXCD, r = nwg % NXCD, xcd = wgid % NXCD, off = wgid / NXCD; wgid = (xcd < r ? xcd * (q + 1) : r * (q + 1) + (xcd - r) * q) + off; }
        const int nig = WGM * nN, gid = wgid / nig, fm = gid * WGM, gsz = (nM - fm) < WGM ? (nM - fm) : WGM;
        u.pm = fm + ((wgid % nig) % gsz); u.pn = (wgid % nig) / gsz; u.ui = i;
        u.A = A + (size_t)u.pm * tstep; u.B = B + (size_t)u.pn * tstep; return true;
    }
};
struct MoeOrder {
    const char* A; const char* B; const LAS int* rb_e; int nrb, nN, G, c; size_t tstepA, tstepB, estepB; bool gather;
    __device__ __forceinline__ bool next(int i, Unit& u) const {
        const int L = i * G + c; if (L >= nrb * nN) return false;
        const int rbi = L / nN, pn = L - rbi * nN; const int e = rb_e[rbi];
        u.pm = rbi; u.pn = pn; u.ui = i; u.A = gather ? A : A + (size_t)rbi * tstepA; u.B = B + (size_t)e * estepB + (size_t)pn * tstepB; return true;
    }
};

__device__ __forceinline__ unsigned cvt_pk_bf16(float lo, float hi) { unsigned r; asm volatile("v_cvt_pk_bf16_f32 %0, %1, %2" : "=v"(r) : "v"(lo), "v"(hi)); return r; }

typedef f32x4 Acc[2][2][4][2];

struct EpiZT {
    static constexpr bool PERM = true;
    bf16* O; int ldc; const float* bias;
    __device__ __forceinline__ void operator()(const Acc& acc, const Unit& u, int wr, int wc, int fr, int fq) const {
        const int row0 = u.pm * BM + wr * 64 + fr, col0 = u.pn * BM + wc * 32 + 8 * fq;
#pragma unroll
        for (int ai = 0; ai < 2; ++ai)
#pragma unroll
            for (int m = 0; m < 4; ++m) { const int r = row0 + ai * HALF + m * 16; const float bv = bias[r]; bf16* rowp = O + (size_t)r * ldc + col0;
#pragma unroll
                for (int bj = 0; bj < 2; ++bj) { const f32x4 v0 = acc[ai][bj][m][0] + bv, v1 = acc[ai][bj][m][1] + bv;
                    u32x4 w; w.x = cvt_pk_bf16(v0[0], v0[1]); w.y = cvt_pk_bf16(v0[2], v0[3]); w.z = cvt_pk_bf16(v1[0], v1[1]); w.w = cvt_pk_bf16(v1[2], v1[3]);
                    *(u32x4*)(rowp + bj * HALF) = w; } }
    }
};
struct EpiBf {
    static constexpr bool PERM = true;
    bf16* O; int ldc;
    __device__ __forceinline__ void operator()(const Acc& acc, const Unit& u, int wr, int wc, int fr, int fq) const {
        const int row0 = u.pm * BM + wr * 64 + fr, col0 = u.pn * BM + wc * 32 + 8 * fq;
#pragma unroll
        for (int ai = 0; ai < 2; ++ai)
#pragma unroll
            for (int m = 0; m < 4; ++m) { bf16* rowp = O + (size_t)(row0 + ai * HALF + m * 16) * ldc + col0;
#pragma unroll
                for (int bj = 0; bj < 2; ++bj) { const f32x4 v0 = acc[ai][bj][m][0], v1 = acc[ai][bj][m][1];
                    u32x4 w; w.x = cvt_pk_bf16(v0[0], v0[1]); w.y = cvt_pk_bf16(v0[2], v0[3]); w.z = cvt_pk_bf16(v1[0], v1[1]); w.w = cvt_pk_bf16(v1[2], v1[3]);
                    *(u32x4*)(rowp + bj * HALF) = w; } }
    }
};
struct EpiGU {
    static constexpr bool PERM = true;
    bf16* O; int ldc;
    __device__ __forceinline__ void operator()(const Acc& acc, const Unit& u, int wr, int wc, int fr, int fq) const {
        const int row0 = u.pm * BM + wr * 64 + fr, col0 = u.pn * HALF + wc * 32 + 8 * fq;
#pragma unroll
        for (int ai = 0; ai < 2; ++ai)
#pragma unroll
            for (int m = 0; m < 4; ++m) { bf16* rowp = O + (size_t)(row0 + ai * HALF + m * 16) * ldc + col0;
                f32x4 h0, h1;
#pragma unroll
                for (int j = 0; j < 4; ++j) { h0[j] = siluf_(acc[ai][0][m][0][j]) * acc[ai][1][m][0][j]; h1[j] = siluf_(acc[ai][0][m][1][j]) * acc[ai][1][m][1][j]; }
                u32x4 w; w.x = cvt_pk_bf16(h0[0], h0[1]); w.y = cvt_pk_bf16(h0[2], h0[3]); w.z = cvt_pk_bf16(h1[0], h1[1]); w.w = cvt_pk_bf16(h1[2], h1[3]);
                *(u32x4*)rowp = w; }
    }
};
struct EpiRes {
    static constexpr bool PERM = false;
    const float* base_l; float* out_l; const float* gate_l;
    const float* base_c; float* out_c; const float* gate_c; int gstride; const float* bias;
    __device__ __forceinline__ void operator()(const Acc& acc, const Unit& u, int wr, int wc, int fr, int fq) const {
        const bool isc = u.pm >= TL / BM; const int prow = isc ? u.pm - TL / BM : u.pm;
        const float* base = isc ? base_c : base_l; float* out = isc ? out_c : out_l; const float* gate = isc ? gate_c : gate_l + (size_t)(u.pm / (SL / BM)) * gstride;
        const int row0 = prow * BM + wr * 64 + fr, col0 = u.pn * BM + wc * 32 + 4 * fq;
        f32x4 bv[2][2], gv[2][2];
#pragma unroll
        for (int bj = 0; bj < 2; ++bj)
#pragma unroll
            for (int n = 0; n < 2; ++n) { bv[bj][n] = *(const f32x4*)(bias + col0 + bj * HALF + n * 16); gv[bj][n] = *(const f32x4*)(gate + col0 + bj * HALF + n * 16); }
#pragma unroll
        for (int ai = 0; ai < 2; ++ai)
#pragma unroll
            for (int m = 0; m < 4; ++m) { const size_t off = (size_t)(row0 + ai * HALF + m * 16) * D + col0;
#pragma unroll
                for (int bj = 0; bj < 2; ++bj)
#pragma unroll
                    for (int n = 0; n < 2; ++n) { const f32x4 bs = *(const f32x4*)(base + off + bj * HALF + n * 16);
                        *(f32x4*)(out + off + bj * HALF + n * 16) = bs + gv[bj][n] * (acc[ai][bj][m][n] + bv[bj][n]); }
                asm volatile("" ::: "memory"); }
    }
};
struct EpiGlu {
    static constexpr bool PERM = false;
    float* x; const float* gate; int gstride; const float* b1; const float* b2;
    __device__ __forceinline__ void operator()(const Acc& acc, const Unit& u, int wr, int wc, int fr, int fq) const {
        const float* g = gate + (size_t)(u.pm / (SL / BM)) * gstride;
        const int row0 = u.pm * BM + wr * 64 + fr, col0 = u.pn * HALF + wc * 32 + 4 * fq;
        f32x4 b1v[2], b2v[2], gv[2];
#pragma unroll
        for (int n = 0; n < 2; ++n) { b1v[n] = *(const f32x4*)(b1 + col0 + n * 16); b2v[n] = *(const f32x4*)(b2 + col0 + n * 16); gv[n] = *(const f32x4*)(g + col0 + n * 16); }
#pragma unroll
        for (int ai = 0; ai < 2; ++ai)
#pragma unroll
            for (int m = 0; m < 4; ++m) { float* rowp = x + (size_t)(row0 + ai * HALF + m * 16) * D + col0;
#pragma unroll
                for (int n = 0; n < 2; ++n) { const f32x4 a = acc[ai][0][m][n] + b1v[n], b = acc[ai][1][m][n] + b2v[n]; f32x4 o;
#pragma unroll
                    for (int j = 0; j < 4; ++j) o[j] = a[j] * sigmoidf_(b[j]);
                    const f32x4 bs = *(const f32x4*)(rowp + n * 16); *(f32x4*)(rowp + n * 16) = bs + gv[n] * o; }
                asm volatile("" ::: "memory"); }
    }
};

template <class Epi, class Sched, bool GATHER>
__device__ __forceinline__ void gemm_phase(LAS unsigned char* lds, const int K, const Sched& S, const Epi& E, const LAS unsigned* rowtab) {
    const int tid = threadIdx.x, wid = __builtin_amdgcn_readfirstlane(tid >> 6), lane = tid & 63, wr = wid >> 2, wc = wid & 3, fr = lane & 15, fq = lane >> 4;
    const int nt = K / BK;
    unsigned voffB[2]; unsigned cv[2][2], nv[2][2]; int Rr[2], Cc[2];
    const size_t kstep = (size_t)(BK * 2);
    const size_t hstep = (size_t)HALF * K * 2;
#pragma unroll
    for (int i = 0; i < 2; ++i) { int R, C; stage_rc(tid * 16 + i * 8192, R, C); const int Rb = Epi::PERM ? ((R & ~31) + perm32(R & 31)) : R;
        Rr[i] = R; Cc[i] = C; voffB[i] = (unsigned)(Rb * K + C) * 2u;
        if constexpr (!GATHER) { cv[0][i] = (unsigned)(R * K + C) * 2u; cv[1][i] = cv[0][i] + (unsigned)hstep; } }
    const unsigned ldsw = (unsigned)wid * 1024u;
    const int aoff = lds_byte(wr * 64 + fr, fq * 8), boff = lds_byte(wc * 32 + fr, fq * 8);
#define PG8_SA(b, h) (((b) * 2 + (h)) * HTB)
#define PG8_SB(b, h) ((4 + (b) * 2 + (h)) * HTB)
#define PG8_STAGE(bufoff, gbase, voff) do { _Pragma("unroll") for (int _i = 0; _i < 2; ++_i) \
        __builtin_amdgcn_global_load_lds((const unsigned*)((const char*)(gbase) + (voff)[_i]), (LAS unsigned*)(lds + (bufoff) + ldsw + _i * 8192), 16, 0, 0); } while (0)
#define PG8_LDROWS(dst, uix) do { _Pragma("unroll") for (int _h = 0; _h < 2; ++_h) _Pragma("unroll") for (int _i = 0; _i < 2; ++_i) \
        dst[_h][_i] = rowtab[(uix) * 256 + _h * 128 + Rr[_i]] + (unsigned)(Cc[_i] * 2); } while (0)
#define PG8_LDA(dst, b, h) do { _Pragma("unroll") for (int m = 0; m < 4; ++m) _Pragma("unroll") for (int k = 0; k < 2; ++k) dst[m][k] = *(const LAS bf16x8*)(lds + PG8_SA(b, h) + aoff + m * 2048 + k * 1024); } while (0)
#define PG8_LDB(dst, b, h) do { _Pragma("unroll") for (int n = 0; n < 2; ++n) _Pragma("unroll") for (int k = 0; k < 2; ++k) dst[n][k] = *(const LAS bf16x8*)(lds + PG8_SB(b, h) + boff + n * 2048 + k * 1024); } while (0)
#define PG8_MMA(ai, bj, At, Bt) do { __builtin_amdgcn_s_setprio(1); _Pragma("unroll") for (int m = 0; m < 4; ++m) _Pragma("unroll") for (int n = 0; n < 2; ++n) _Pragma("unroll") for (int k = 0; k < 2; ++k) \
        acc[ai][bj][m][n] = __builtin_amdgcn_mfma_f32_16x16x32_bf16(Bt[n][k], At[m][k], acc[ai][bj][m][n], 0, 0, 0); __builtin_amdgcn_s_setprio(0); } while (0)
#define PG8_WAIT_V(n) asm volatile("s_waitcnt vmcnt(" #n ")" ::: "memory")
#define PG8_WAIT_L(n) asm volatile("s_waitcnt lgkmcnt(" #n ")" ::: "memory")
#define PG8_BAR __builtin_amdgcn_s_barrier()
#define PG8_SCHED __builtin_amdgcn_sched_barrier(0)
    Unit cur, nxt; int ui = 0;
    if (!S.next(0, cur)) return;
    Acc acc;
#pragma unroll
    for (int a = 0; a < 2; ++a)
#pragma unroll
        for (int b = 0; b < 2; ++b)
#pragma unroll
            for (int m = 0; m < 4; ++m)
#pragma unroll
                for (int n = 0; n < 2; ++n) acc[a][b][m][n] = (f32x4){0.f, 0.f, 0.f, 0.f};
    bf16x8 At[4][2], B0[2][2], B1[2][2];
    const char* cA = cur.A; const char* cB = cur.B;
    if constexpr (GATHER) { PG8_LDROWS(cv, cur.ui); PG8_WAIT_L(0); }
    PG8_STAGE(PG8_SB(0, 0), cB, voffB); PG8_STAGE(PG8_SB(0, 1), cB + hstep, voffB); PG8_STAGE(PG8_SA(0, 0), cA, cv[0]); PG8_STAGE(PG8_SA(0, 1), cA, cv[1]);
    if (wr == 1) PG8_BAR;
    PG8_WAIT_V(2); PG8_BAR;
    PG8_STAGE(PG8_SB(1, 0), cB + kstep, voffB); PG8_STAGE(PG8_SA(1, 0), cA + kstep, cv[0]); PG8_STAGE(PG8_SB(1, 1), cB + hstep + kstep, voffB);
    PG8_WAIT_V(6); PG8_BAR;
    for (;;) {
        const bool has_next = S.next(ui + 1, nxt);
        const char* nA = has_next ? nxt.A : cA; const char* nB = has_next ? nxt.B : cB;
        for (int t = 0; t < nt; t += 2) {
            const bool last = (t == nt - 2);
            const char* a1 = cA + (size_t)(t + 1) * kstep;
            const char* a2 = last ? nA : cA + (size_t)(t + 2) * kstep; const char* b2 = last ? nB : cB + (size_t)(t + 2) * kstep;
            const char* a3 = a2 + kstep; const char* b3 = b2 + kstep;
            if constexpr (GATHER) { if (last) { PG8_LDROWS(nv, has_next ? nxt.ui : cur.ui); } else {
#pragma unroll
                for (int h = 0; h < 2; ++h)
#pragma unroll
                    for (int i = 0; i < 2; ++i) nv[h][i] = cv[h][i]; } }
            else {
#pragma unroll
                for (int h = 0; h < 2; ++h)
#pragma unroll
                    for (int i = 0; i < 2; ++i) nv[h][i] = cv[h][i]; }
            PG8_LDB(B0, 0, 0); PG8_LDB(B1, 0, 1); PG8_SCHED; PG8_LDA(At, 0, 0); PG8_STAGE(PG8_SA(1, 1), a1, cv[1]);
            PG8_WAIT_V(8); PG8_WAIT_L(0); PG8_BAR; PG8_MMA(0, 0, At, B0); PG8_MMA(0, 1, At, B1); PG8_BAR; PG8_SCHED;
            PG8_LDA(At, 0, 1); PG8_STAGE(PG8_SB(0, 0), b2, voffB); PG8_STAGE(PG8_SB(0, 1), b2 + hstep, voffB); PG8_STAGE(PG8_SA(0, 0), a2, nv[0]);
            PG8_WAIT_V(8); PG8_WAIT_L(0); PG8_BAR; PG8_MMA(1, 0, At, B0); PG8_MMA(1, 1, At, B1); PG8_BAR; PG8_SCHED;
            PG8_LDB(B0, 1, 0); PG8_LDB(B1, 1, 1); PG8_SCHED; PG8_LDA(At, 1, 0); PG8_STAGE(PG8_SA(0, 1), a2, nv[1]);
            PG8_WAIT_V(8); PG8_WAIT_L(0); PG8_BAR; PG8_MMA(0, 0, At, B0); PG8_MMA(0, 1, At, B1); PG8_BAR; PG8_SCHED;
            PG8_LDA(At, 1, 1); PG8_STAGE(PG8_SB(1, 0), b3, voffB); PG8_STAGE(PG8_SB(1, 1), b3 + hstep, voffB); PG8_STAGE(PG8_SA(1, 0), a3, nv[0]);
            PG8_WAIT_V(8); PG8_WAIT_L(0); PG8_BAR; PG8_MMA(1, 0, At, B0); PG8_MMA(1, 1, At, B1); PG8_BAR; PG8_SCHED;
        }
        if (wr == 0) PG8_BAR;
        E(acc, cur, wr, wc, fr, fq);
        if (!has_next) break;
#pragma unroll
        for (int a = 0; a < 2; ++a)
#pragma unroll
            for (int b = 0; b < 2; ++b)
#pragma unroll
                for (int m = 0; m < 4; ++m)
#pragma unroll
                    for (int n = 0; n < 2; ++n) acc[a][b][m][n] = (f32x4){0.f, 0.f, 0.f, 0.f};
        cur = nxt; cA = nA; cB = nB; ++ui;
        if constexpr (GATHER) {
#pragma unroll
            for (int h = 0; h < 2; ++h)
#pragma unroll
                for (int i = 0; i < 2; ++i) cv[h][i] = nv[h][i]; }
        if (wr == 1) PG8_BAR;
    }
    PG8_WAIT_V(0);
    PG8_BAR;
#undef PG8_SA
#undef PG8_SB
#undef PG8_STAGE
#undef PG8_LDROWS
#undef PG8_LDA
#undef PG8_LDB
#undef PG8_MMA
#undef PG8_WAIT_V
#undef PG8_WAIT_L
#undef PG8_BAR
#undef PG8_SCHED
}
}
struct Params { const float* in[40]; float* out; unsigned char* ws; int ph_lo, ph_hi; };
enum { I_X = 0, I_C, I_CTX, I_CCTX, I_ADAW, I_ADAB, I_NORMG, I_FINALG, I_HWIN, I_HBIN, I_HCW, I_HCB, I_FW1, I_FB1, I_FW2, I_FB2, I_FW3, I_FREQ, I_SKIP, I_HWOUT, I_HBOUT,
       I_SARE, I_SAIM, I_SLOG, I_SBRE, I_SBIM, I_SCRE, I_SCIM, I_SD, I_SW1, I_SB1, I_SW2, I_SB2, I_MWG, I_MBG, I_MWE, I_MBE, I_MGATE, I_MUP, I_MDOWN };

struct Frame {
    LAS unsigned char* lds; unsigned* ctl; unsigned char* ws; const float* const* in; float* out;
    int tid, lane, wave, G, c;
};
#define MODP(F, l, r) ((const float*)((F).ws + WS_MOD) + ((size_t)(l) * 5 + (r)) * 12288)

__device__ __forceinline__ void p0_transpose_item(const float* W, int K, int N, bf16* WT, int k0, int n0, int drow0, LAS float* scr, int lane) {
    f32x4 v[8];
#pragma unroll
    for (int i = 0; i < 8; ++i) v[i] = *(const GAS f32x4*)(W + (size_t)(k0 + 8 * i + (lane >> 3)) * N + n0 + 4 * (lane & 7));
#pragma unroll
    for (int i = 0; i < 8; ++i) { LAS float* s = scr + (8 * i + (lane >> 3)) * 33 + 4 * (lane & 7); s[0] = v[i][0]; s[1] = v[i][1]; s[2] = v[i][2]; s[3] = v[i][3]; }
    LDS_WAIT(); asm volatile("" ::: "memory");
    const int c = lane & 7;
#pragma unroll
    for (int j = 0; j < 4; ++j) { const int n = (lane >> 3) + 8 * j; const LAS float* s = scr + (8 * c) * 33 + n;
        u32x4 o; o.x = pk2(s[0 * 33], s[1 * 33]); o.y = pk2(s[2 * 33], s[3 * 33]); o.z = pk2(s[4 * 33], s[5 * 33]); o.w = pk2(s[6 * 33], s[7 * 33]);
        *(GAS u32x4*)(WT + (size_t)(drow0 + n) * K + k0 + 8 * c) = o; }
    LDS_WAIT(); asm volatile("" ::: "memory");
}
__device__ __forceinline__ void p0_job(const float* W, int K, int N, bf16* WT, bool ilv, int ilv_off, int idx, LAS float* scr, int lane) {
    const int nblk = N / 32, kb = idx / nblk, nb = idx - kb * nblk, n0 = 32 * nb;
    const int drow0 = ilv ? ((n0 >> 7) * 256 + ilv_off + (n0 & 127)) : n0;
    p0_transpose_item(W, K, N, WT, 64 * kb, n0, drow0, scr, lane);
}

__device__ __forceinline__ void p0_prologue(Frame& F) {
    const float* const* in = F.in;
    {
        LAS float* sl = (LAS float*)F.lds;
        for (int i = F.tid; i < 2048 * 5; i += NTHR) { const int r = i / 2048, k = i - r * 2048; const float cv = r < 4 ? in[I_C][r * 2048 + k] : in[I_CCTX][k]; sl[k * 8 + r] = siluf_(cv); }
        __syncthreads();
        LAS float* red = (LAS float*)(F.lds + 65536);
        for (int it = F.c; it < 768; it += F.G) {
            const int l = it / 384, j = it - l * 384; const float* W = in[I_ADAW] + (size_t)l * 2048 * 12288 + 32 * j + (F.lane & 31);
            float a0 = 0.f, a1 = 0.f, a2 = 0.f, a3 = 0.f, a4 = 0.f;
            const int kbase = 256 * F.wave + (F.lane >> 5);
#pragma unroll 16
            for (int kk = 0; kk < 128; ++kk) { const int k = kbase + 2 * kk; const float w = W[(size_t)k * 12288];
                const f32x4 s = *(const LAS f32x4*)(sl + k * 8); const float s4 = sl[k * 8 + 4];
                a0 += s[0] * w; a1 += s[1] * w; a2 += s[2] * w; a3 += s[3] * w; a4 += s4 * w; }
            a0 += __shfl_xor(a0, 32); a1 += __shfl_xor(a1, 32); a2 += __shfl_xor(a2, 32); a3 += __shfl_xor(a3, 32); a4 += __shfl_xor(a4, 32);
            if (F.lane < 32) { LAS float* r = red + F.wave * 160 + F.lane; r[0] = a0; r[32] = a1; r[64] = a2; r[96] = a3; r[128] = a4; }
            __syncthreads();
            if (F.tid < 160) { float s = 0.f;
#pragma unroll
                for (int w = 0; w < 8; ++w) s += red[w * 160 + F.tid];
                const int r = F.tid >> 5, col = 32 * j + (F.tid & 31);
                ((float*)(F.ws + WS_MOD))[((size_t)l * 5 + r) * 12288 + col] = s + in[I_ADAB][l * 12288 + col]; }
            __syncthreads();
        }
    }
    {
        LAS float* zf = (LAS float*)F.lds;
        LAS float* h1 = (LAS float*)(F.lds + 20480);
        LAS float* h2T = (LAS float*)(F.lds + 57344);
        for (int it = F.c; it < 256; it += F.G) {
            const int pb = it >> 3, cb = it & 7, pbase = pb * 136;
            for (int i = F.tid; i < 136 * 33; i += NTHR) { const int p = i / 33, m = i - p * 33; const int gp = pbase + p; const int Lq = gp < SL ? SL : CL, j = gp < SL ? gp : gp - SL;
                float v;
                if (m == 0) v = (float)j / (float)(Lq - 1);
                else { const int mm = (m - 1) & 15; const float band = 1e-4f + (float)mm * ((15.0f - 1e-4f) / 15.0f); const float w = (6.283185307179586f / (float)Lq) * (float)j; const float a = band * w;
                    v = (m <= 16) ? cosf(a) : -sinf(a); }
                zf[i] = v; }
            __syncthreads();
            for (int i = F.tid; i < 136 * 64; i += NTHR) { const int p = i >> 6, o = i & 63; float s = in[I_FB1][o];
                for (int m = 0; m < 33; ++m) s += zf[p * 33 + m] * in[I_FW1][m * 64 + o];
                h1[i] = sinf(in[I_FREQ][o] * s); }
            __syncthreads();
            for (int i = F.tid; i < 136 * 64; i += NTHR) { const int p = i >> 6, o = i & 63; float s = in[I_FB2][o];
                for (int m = 0; m < 64; ++m) s += h1[p * 64 + m] * in[I_FW2][m * 64 + o];
                h2T[o * 136 + p] = sinf(in[I_FREQ][o] * s); }
            __syncthreads();
            const int cg = F.tid & 127, pg = F.tid >> 7, c0 = 512 * cb + 4 * cg, p0 = 34 * pg;
            f32x4 acc[34];
#pragma unroll
            for (int i = 0; i < 34; ++i) acc[i] = (f32x4){0.f, 0.f, 0.f, 0.f};
            for (int o = 0; o < 64; ++o) { const f32x4 w = *(const GAS f32x4*)(in[I_FW3] + (size_t)o * 4096 + c0);
#pragma unroll
                for (int i = 0; i < 17; ++i) { const f32x2 hv = *(const LAS f32x2*)(h2T + o * 136 + p0 + 2 * i); acc[2 * i] += w * hv[0]; acc[2 * i + 1] += w * hv[1]; } }
            const int dir = c0 >> 11, d0 = c0 & 2047;
            const float dstep = ((-15.350567286626973f) - (-3.0701134573253945f)) / 2047.0f;
            float delta[4];
#pragma unroll
            for (int q = 0; q < 4; ++q) delta[q] = fabsf(-3.0701134573253945f + (float)(d0 + q) * dstep);
#pragma unroll
            for (int i = 0; i < 17; ++i) { const int gp = pbase + p0 + 2 * i; const bool lat = gp < SL; const int Lq = lat ? SL : CL, j = lat ? gp : gp - SL;
                const float t0 = (float)j / (float)(Lq - 1), t1 = (float)(j + 1) / (float)(Lq - 1);
#pragma unroll
                for (int q = 0; q < 4; ++q) { const unsigned w = pk2(acc[2 * i][q] * __expf(-t0 * delta[q]), acc[2 * i + 1][q] * __expf(-t1 * delta[q]));
                    bf16* dst = lat ? (bf16*)(F.ws + WS_KRN) + ((size_t)(d0 + q) * 2 + dir) * SL + j : (bf16*)(F.ws + WS_KRC) + ((size_t)(d0 + q) * 2 + dir) * CL + j;
                    *(unsigned*)dst = w; } }
            __syncthreads();
        }
    }
    {
        LAS float* scr = (LAS float*)(F.lds + F.wave * 8448);
        const int gw = F.c * NWAVES + F.wave, NGW = F.G * NWAVES;
        constexpr int N_IN = 32 * 192, N_SQ = 32 * 64, N_E = 1024, N_HEAD = N_IN + 3 * N_SQ, NITEMS = N_HEAD + 64 * 3 * N_E;
        for (int it = gw; it < NITEMS; it += NGW) {
            int r = it;
            if (r < N_IN) { p0_job(in[I_HWIN], 2048, 6144, (bf16*)(F.ws + WS_WIN), false, 0, r, scr, F.lane); continue; } r -= N_IN;
            if (r < N_SQ) { p0_job(in[I_HWOUT], 2048, 2048, (bf16*)(F.ws + WS_WOUT), false, 0, r, scr, F.lane); continue; } r -= N_SQ;
            if (r < N_SQ) { p0_job(in[I_SW1], 2048, 2048, (bf16*)(F.ws + WS_W12), true, 0, r, scr, F.lane); continue; } r -= N_SQ;
            if (r < N_SQ) { p0_job(in[I_SW2], 2048, 2048, (bf16*)(F.ws + WS_W12), true, 128, r, scr, F.lane); continue; } r -= N_SQ;
            const int le = r / (3 * N_E), q = r - le * 3 * N_E, which = q / N_E, idx = q - which * N_E;
            if (which == 0) p0_job(in[I_MGATE] + (size_t)le * 2048 * 1024, 2048, 1024, (bf16*)(F.ws + WS_WGU) + (size_t)le * 2048 * 2048, true, 0, idx, scr, F.lane);
            else if (which == 1) p0_job(in[I_MUP] + (size_t)le * 2048 * 1024, 2048, 1024, (bf16*)(F.ws + WS_WGU) + (size_t)le * 2048 * 2048, true, 128, idx, scr, F.lane);
            else p0_job(in[I_MDOWN] + (size_t)le * 1024 * 2048, 1024, 2048, (bf16*)(F.ws + WS_WD) + (size_t)le * 2048 * 1024, false, 0, idx, scr, F.lane);
        }
    }
}
struct Row { f32x4 v[8]; };
__device__ __forceinline__ void row_load(Row& r, const float* p, int lane) {
#pragma unroll
    for (int i = 0; i < 8; ++i) r.v[i] = *(const GAS f32x4*)(p + 4 * lane + 256 * i);
}
__device__ __forceinline__ float row_rstd(const Row& r) {
    float s = 0.f;
#pragma unroll
    for (int i = 0; i < 8; ++i) s += (r.v[i][0] * r.v[i][0] + r.v[i][1] * r.v[i][1]) + (r.v[i][2] * r.v[i][2] + r.v[i][3] * r.v[i][3]);
    return 1.0f / sqrtf(wave_sum(s) * (1.0f / D) + EPS);
}
__device__ __forceinline__ void row_norm_mod_store(const Row& r, float rstd, const float* g, const float* sh, const float* sc, bf16* o, int lane) {
#pragma unroll
    for (int i = 0; i < 8; ++i) { const int c = 4 * lane + 256 * i;
        const f32x4 gv = *(const GAS f32x4*)(g + c), sv = *(const GAS f32x4*)(sc + c), hv = *(const GAS f32x4*)(sh + c);
        const f32x4 y = (r.v[i] * rstd * gv) * (sv + 1.0f) + hv;
        u32x2 w; w.x = pk2(y[0], y[1]); w.y = pk2(y[2], y[3]); *(GAS u32x2*)(o + c) = w; }
}
__device__ __forceinline__ int moe_pos(const LAS int* rbfirst, int packed) { return 256 * rbfirst[packed >> 20] + (packed & 0xfffff); }
__device__ __forceinline__ void row_add_moe(Row& r, const float* gt, const bf16* eo, int p0, int p1, float g0, float g1, int lane) {
#pragma unroll
    for (int i = 0; i < 8; ++i) { const int c = 4 * lane + 256 * i;
        const u32x2 a = *(const GAS u32x2*)(eo + (size_t)p0 * D + c), b = *(const GAS u32x2*)(eo + (size_t)p1 * D + c); const f32x4 gv = *(const GAS f32x4*)(gt + c);
        f32x4 m; m[0] = g0 * bflo(a.x) + g1 * bflo(b.x); m[1] = g0 * bfhi(a.x) + g1 * bfhi(b.x); m[2] = g0 * bflo(a.y) + g1 * bflo(b.y); m[3] = g0 * bfhi(a.y) + g1 * bfhi(b.y);
        r.v[i] += gv * m; }
}
__device__ __forceinline__ void row_store(const Row& r, float* p, int lane) {
#pragma unroll
    for (int i = 0; i < 8; ++i) *(GAS f32x4*)(p + 4 * lane + 256 * i) = r.v[i];
}
__device__ __forceinline__ int moe_tables(Frame& F, int l) {
    LAS int* rb_e = (LAS int*)(F.lds + TAB_OFF); LAS int* rbfirst = rb_e + 168; LAS int* cnt = rbfirst + 33;
    __syncthreads();
    if (F.tid < 32) cnt[F.tid] = (int)xb_ld(F.ctl + CW_CNT + (l * 32 + F.tid) * 64);
    __syncthreads();
    if (F.tid == 0) { int a = 0; for (int e = 0; e < 32; ++e) { rbfirst[e] = a; const int n = (cnt[e] + 255) >> 8; for (int k = 0; k < n; ++k) rb_e[a + k] = e; a += n; } rbfirst[32] = a; }
    __syncthreads();
    return rbfirst[32];
}

__device__ __forceinline__ void p_norm1_l0(Frame& F) {
    const int gw = F.c * NWAVES + F.wave, NGW = F.G * NWAVES;
    for (int r = gw; r < TT; r += NGW) {
        const bool lat = r < TL; const float* src = lat ? F.in[I_X] + (size_t)r * D : F.in[I_CTX] + (size_t)(r - TL) * D; const float* mod = MODP(F, 0, lat ? (r >> 12) : 4);
        Row row; row_load(row, src, F.lane); const float rstd = row_rstd(row);
        row_norm_mod_store(row, rstd, F.in[I_NORMG], mod, mod + 2048, (bf16*)(F.ws + WS_U) + (size_t)r * D, F.lane);
    }
}
__device__ __forceinline__ void p_comb_norm1_l1(Frame& F) {
    moe_tables(F, 0);
    const LAS int* rbfirst = (const LAS int*)(F.lds + TAB_OFF) + 168;
    const int gw = F.c * NWAVES + F.wave, NGW = F.G * NWAVES;
    const int* tokpos = (const int*)(F.ws + WS_TOKPOS); const float* gates = (const float*)(F.ws + WS_GATE);
    for (int r = gw; r < TT; r += NGW) {
        const bool lat = r < TL; float* xp = lat ? F.out + (size_t)r * D : (float*)(F.ws + WS_XC) + (size_t)(r - TL) * D; const int mr = lat ? (r >> 12) : 4;
        Row row; row_load(row, xp, F.lane);
        const int p0 = moe_pos(rbfirst, tokpos[2 * r]), p1 = moe_pos(rbfirst, tokpos[2 * r + 1]);
        row_add_moe(row, MODP(F, 0, mr) + 10240, (const bf16*)(F.ws + WS_EO), p0, p1, gates[2 * r], gates[2 * r + 1], F.lane);
        row_store(row, xp, F.lane);
        const float rstd = row_rstd(row); const float* mod = MODP(F, 1, mr);
        row_norm_mod_store(row, rstd, F.in[I_NORMG] + 2 * D, mod, mod + 2048, (bf16*)(F.ws + WS_U) + (size_t)r * D, F.lane);
    }
}
__device__ __forceinline__ void p_final(Frame& F) {
    moe_tables(F, 1);
    const LAS int* rbfirst = (const LAS int*)(F.lds + TAB_OFF) + 168;
    const int gw = F.c * NWAVES + F.wave, NGW = F.G * NWAVES;
    const int* tokpos = (const int*)(F.ws + WS_TOKPOS); const float* gates = (const float*)(F.ws + WS_GATE);
    for (int r = gw; r < TL; r += NGW) {
        float* xp = F.out + (size_t)r * D;
        Row row; row_load(row, xp, F.lane);
        const int p0 = moe_pos(rbfirst, tokpos[2 * r]), p1 = moe_pos(rbfirst, tokpos[2 * r + 1]);
        row_add_moe(row, MODP(F, 1, r >> 12) + 10240, (const bf16*)(F.ws + WS_EO), p0, p1, gates[2 * r], gates[2 * r + 1], F.lane);
        const float rstd = row_rstd(row);
#pragma unroll
        for (int i = 0; i < 8; ++i) { const int c = 4 * F.lane + 256 * i; const f32x4 gv = *(const GAS f32x4*)(F.in[I_FINALG] + c); row.v[i] = row.v[i] * rstd * gv; }
        row_store(row, xp, F.lane);
    }
}

__device__ __forceinline__ void p_router(Frame& F, int l, int ntok) {
    constexpr int PITCH = 2050;
    LAS float* xt = (LAS float*)F.lds;
    LAS float* red = (LAS float*)F.lds;
    LAS float* lg = (LAS float*)(F.lds + 32768);
    const float* wg = F.in[I_MWG] + (size_t)l * 2048 * 4; const float* we = F.in[I_MWE] + (size_t)l * 2048 * 32;
    const float* g = F.in[I_NORMG] + (size_t)(l * 2 + 1) * D;
    int* list = (int*)(F.ws + WS_LIST); int* tokpos = (int*)(F.ws + WS_TOKPOS); float* gates = (float*)(F.ws + WS_GATE);
    const int ntile = ntok / 16;
    for (int tile = F.c; tile < ntile; tile += F.G) {
        const int t0 = tile * 16;
        __syncthreads();
#pragma unroll 1
        for (int q = 0; q < 2; ++q) { const int r = t0 + 2 * F.wave + q; const bool lat = r < TL;
            const float* xp = lat ? F.out + (size_t)r * D : (const float*)(F.ws + WS_XC) + (size_t)(r - TL) * D; const float* mod = MODP(F, l, lat ? (r >> 12) : 4);
            Row row; row_load(row, xp, F.lane); const float rstd = row_rstd(row);
            bf16* o = (bf16*)(F.ws + WS_U) + (size_t)r * D; LAS float* xr = xt + (2 * F.wave + q) * PITCH;
#pragma unroll
            for (int i = 0; i < 8; ++i) { const int c = 4 * F.lane + 256 * i;
                const f32x4 gv = *(const GAS f32x4*)(g + c), sv = *(const GAS f32x4*)(mod + 8192 + c), hv = *(const GAS f32x4*)(mod + 6144 + c);
                const f32x4 y = (row.v[i] * rstd * gv) * (sv + 1.0f) + hv;
                u32x2 w; w.x = pk2(y[0], y[1]); w.y = pk2(y[2], y[3]); *(GAS u32x2*)(o + c) = w;
                *(LAS f32x2*)(xr + c) = (f32x2){y[0], y[1]}; *(LAS f32x2*)(xr + c + 2) = (f32x2){y[2], y[3]}; } }
        __syncthreads();
        f32x4 a0 = {0.f, 0.f, 0.f, 0.f}, a1 = a0, a2 = a0;
        { const int tk = F.lane & 15, kq = F.lane >> 4, kb = 256 * F.wave + kq; const LAS float* ap = xt + tk * PITCH + kb;
          const bool v0 = tk < 4; const float* b0p = v0 ? wg + (size_t)kb * 4 + tk : we + (size_t)kb * 32 + (tk - 4);
          const float* b1p = we + (size_t)kb * 32 + 12 + tk;
          const bool v2 = tk < 4; const float* b2p = we + (size_t)kb * 32 + (v2 ? 28 + tk : 0);
          const int s0 = v0 ? 16 : 128;
#pragma unroll 8
          for (int ks = 0; ks < 64; ++ks) { const float av = ap[4 * ks]; const float w0 = b0p[(size_t)ks * s0], w1 = b1p[(size_t)ks * 128]; float w2 = b2p[(size_t)ks * 128]; w2 = v2 ? w2 : 0.f;
              a0 = __builtin_amdgcn_mfma_f32_16x16x4f32(av, w0, a0, 0, 0, 0); a1 = __builtin_amdgcn_mfma_f32_16x16x4f32(av, w1, a1, 0, 0, 0); a2 = __builtin_amdgcn_mfma_f32_16x16x4f32(av, w2, a2, 0, 0, 0); } }
        __syncthreads();
        { LAS float* rp = red + F.wave * 768;
#pragma unroll
          for (int j = 0; j < 4; ++j) { const int tk = 4 * (F.lane >> 4) + j; rp[tk * 48 + (F.lane & 15)] = a0[j]; rp[tk * 48 + 16 + (F.lane & 15)] = a1[j]; rp[tk * 48 + 32 + (F.lane & 15)] = a2[j]; } }
        __syncthreads();
        for (int i = F.tid; i < 768; i += NTHR) { float s = 0.f;
#pragma unroll
            for (int w = 0; w < 8; ++w) s += red[w * 768 + i];
            const int n = i % 48; s += n < 4 ? F.in[I_MBG][l * 4 + n] : (n < 36 ? F.in[I_MBE][l * 32 + n - 4] : 0.f); lg[i] = s; }
        __syncthreads();
        if (F.tid < 16) { const LAS float* q = lg + F.tid * 48; const int r = t0 + F.tid;
            int gi = 0; float gm = q[0];
#pragma unroll
            for (int k = 1; k < 4; ++k) if (q[k] > gm) { gm = q[k]; gi = k; }
            float gs = 0.f;
#pragma unroll
            for (int k = 0; k < 4; ++k) gs += __expf(q[k] - gm);
            const float ptop = 1.0f / gs;
            const LAS float* e = q + 4 + 8 * gi; int i0 = 0; float v0 = e[0];
#pragma unroll
            for (int k = 1; k < 8; ++k) if (e[k] > v0) { v0 = e[k]; i0 = k; }
            int i1 = -1; float v1 = -3.0e38f;
#pragma unroll
            for (int k = 0; k < 8; ++k) if (k != i0 && e[k] > v1) { v1 = e[k]; i1 = k; }
            const float x1 = __expf(v1 - v0), den = 1.0f / (1.0f + x1);
            const int e0 = gi * 8 + i0, e1 = gi * 8 + i1;
            const unsigned s0 = xb_add(F.ctl + CW_CNT + (l * 32 + e0) * 64, 1u), s1 = xb_add(F.ctl + CW_CNT + (l * 32 + e1) * 64, 1u);
            list[(size_t)e0 * TT + s0] = r; list[(size_t)e1 * TT + s1] = r;
            tokpos[2 * r] = (e0 << 20) | (int)s0; tokpos[2 * r + 1] = (e1 << 20) | (int)s1;
            gates[2 * r] = ptop * den; gates[2 * r + 1] = ptop * x1 * den; }
    }
}
constexpr int CV_KR = 0, CV_KRC = 16384, CV_ZERO = 17408, CV_V = 17920, CV_VB = 10272, CV_VJ = 640, CV_VC = 59008, CV_VCB = 544, CV_RED = 61184;
__device__ __forceinline__ float conv3(float zm, float z0, float zp, float w0, float w1, float w2, float cb) { return zm * w0 + z0 * w1 + zp * w2 + cb; }
template <int NV>
__device__ __forceinline__ void load_conv3(const bf16* zrow, int col0, int t0, int Lseq, float w0, float w1, float w2, float cb, float* out) {
    float z[8 * NV + 2];
    z[0] = t0 > 0 ? bf2f(zrow[col0 - 1]) : 0.f;
    z[8 * NV + 1] = (t0 + 8 * NV < Lseq) ? bf2f(zrow[col0 + 8 * NV]) : 0.f;
#pragma unroll
    for (int i = 0; i < NV; ++i) { const u32x4 w = *(const GAS u32x4*)(zrow + col0 + 8 * i);
        z[1 + 8 * i] = bflo(w.x); z[2 + 8 * i] = bfhi(w.x); z[3 + 8 * i] = bflo(w.y); z[4 + 8 * i] = bfhi(w.y); z[5 + 8 * i] = bflo(w.z); z[6 + 8 * i] = bfhi(w.z); z[7 + 8 * i] = bflo(w.w); z[8 + 8 * i] = bfhi(w.w); }
#pragma unroll
    for (int i = 0; i < 8 * NV; ++i) out[i] = conv3(z[i], z[i + 1], z[i + 2], w0, w1, w2, cb);
}
#define CV_MMA8(acc, d, bfr) do { \
    unsigned o_[7]; _Pragma("unroll") for (int m_ = 0; m_ < 7; ++m_) o_[m_] = __builtin_amdgcn_alignbit(d[m_ + 1], d[m_], 16); \
    _Pragma("unroll") for (int q_ = 0; q_ < 4; ++q_) { \
        u32x4 fe_ = {d[4 - q_], d[5 - q_], d[6 - q_], d[7 - q_]}; u32x4 fo_ = {o_[3 - q_], o_[4 - q_], o_[5 - q_], o_[6 - q_]}; \
        acc[2 * q_] = __builtin_amdgcn_mfma_f32_16x16x32_bf16(__builtin_bit_cast(bf16x8, fe_), bfr, acc[2 * q_], 0, 0, 0); \
        acc[2 * q_ + 1] = __builtin_amdgcn_mfma_f32_16x16x32_bf16(__builtin_bit_cast(bf16x8, fo_), bfr, acc[2 * q_ + 1], 0, 0, 0); } } while (0)

__device__ __forceinline__ void p_conv(Frame& F) {
    LAS unsigned char* lds = F.lds;
    const bf16* ZT = (const bf16*)(F.ws + WS_ZT); bf16* YXT = (bf16*)(F.ws + WS_YXT);
    const float* cw = F.in[I_HCW]; const float* cbp = F.in[I_HCB];
    const int tid = F.tid, lane = F.lane, w = F.wave, g = w & 1, q = w >> 1, r = lane & 15, h4 = lane >> 4, Isub = r >> 2, bb = r & 3;
    for (int i = tid; i < 128; i += NTHR) ((LAS unsigned*)(lds + CV_ZERO))[i] = 0u;
    for (int d = F.c; d < D; d += F.G) {
        __syncthreads();
        float nl = 0.f, nc = 0.f;
        { const bf16* kn = (const bf16*)(F.ws + WS_KRN) + (size_t)d * 2 * SL; LAS bf16* KR = (LAS bf16*)(lds + CV_KR);
          const u32x4 fw = *(const GAS u32x4*)(kn + 8 * tid), bw = *(const GAS u32x4*)(kn + SL + 8 * tid);
          const unsigned fwv[4] = {fw.x, fw.y, fw.z, fw.w}, bwv[4] = {bw.x, bw.y, bw.z, bw.w};
#pragma unroll
          for (int e = 0; e < 8; ++e) { const int j = 8 * tid + e; const unsigned short fv = (unsigned short)(fwv[e >> 1] >> (16 * (e & 1))), bv = (unsigned short)(bwv[e >> 1] >> (16 * (e & 1)));
              KR[SL - j] = fv; nl += fabsf(bf2f(fv));
              if (j > 0) { KR[SL + j] = bv; nl += fabsf(bf2f(bv)); } }
          if (tid == 0) KR[0] = 0;
          if (tid < 64) { const bf16* kc = (const bf16*)(F.ws + WS_KRC) + (size_t)d * 2 * CL; LAS bf16* KC = (LAS bf16*)(lds + CV_KRC); const int dirn = tid >> 5, j0 = 8 * (tid & 31);
              const u32x4 cwd = *(const GAS u32x4*)(kc + dirn * CL + j0); const unsigned cv4[4] = {cwd.x, cwd.y, cwd.z, cwd.w};
#pragma unroll
              for (int e = 0; e < 8; ++e) { const int j = j0 + e; const unsigned short v = (unsigned short)(cv4[e >> 1] >> (16 * (e & 1)));
                  if (dirn == 0) { KC[CL - j] = v; nc += fabsf(bf2f(v)); } else if (j > 0) { KC[CL + j] = v; nc += fabsf(bf2f(v)); } }
              if (tid == 0) KC[0] = 0; } }
        { const int chv = 4096 + d, chx = 2048 + d;
          const float v0 = cw[chv], v1 = cw[6144 + chv], v2 = cw[12288 + chv], vb = cbp[chv], x0 = cw[chx], x1 = cw[6144 + chx], x2 = cw[12288 + chx], xb = cbp[chx];
          { const int b = tid >> 7, t0 = (tid & 127) * 32, col0 = b * SL + t0; float zv[32], zx[32];
            load_conv3<4>(ZT + (size_t)chv * ZLD, col0, t0, SL, v0, v1, v2, vb, zv); load_conv3<4>(ZT + (size_t)chx * ZLD, col0, t0, SL, x0, x1, x2, xb, zx);
            LAS unsigned char* dst = lds + CV_V + b * CV_VB + (t0 >> 8) * CV_VJ + (t0 & 255) * 2;
#pragma unroll
            for (int i = 0; i < 4; ++i) { u32x4 o; o.x = pk2(zv[8 * i] * zx[8 * i], zv[8 * i + 1] * zx[8 * i + 1]); o.y = pk2(zv[8 * i + 2] * zx[8 * i + 2], zv[8 * i + 3] * zx[8 * i + 3]);
                o.z = pk2(zv[8 * i + 4] * zx[8 * i + 4], zv[8 * i + 5] * zx[8 * i + 5]); o.w = pk2(zv[8 * i + 6] * zx[8 * i + 6], zv[8 * i + 7] * zx[8 * i + 7]); *(LAS u32x4*)(dst + 16 * i) = o; } }
          if (tid < 128) { const int b = tid >> 5, t0 = (tid & 31) * 8, col0 = TL + b * CL + t0; float zv[8], zx[8];
            load_conv3<1>(ZT + (size_t)chv * ZLD, col0, t0, CL, v0, v1, v2, vb, zv); load_conv3<1>(ZT + (size_t)chx * ZLD, col0, t0, CL, x0, x1, x2, xb, zx);
            u32x4 o; o.x = pk2(zv[0] * zx[0], zv[1] * zx[1]); o.y = pk2(zv[2] * zx[2], zv[3] * zx[3]); o.z = pk2(zv[4] * zx[4], zv[5] * zx[5]); o.w = pk2(zv[6] * zx[6], zv[7] * zx[7]);
            *(LAS u32x4*)(lds + CV_VC + b * CV_VCB + t0 * 2) = o; } }
        nl = wave_sum(nl); nc = wave_sum(nc);
        if (lane == 0) { ((LAS float*)(lds + CV_RED))[w] = nl; ((LAS float*)(lds + CV_RED))[8 + w] = nc; }
        __syncthreads();
        float inv_l = 0.f, inv_c = ((LAS float*)(lds + CV_RED))[8];
#pragma unroll
        for (int i = 0; i < 8; ++i) inv_l += ((LAS float*)(lds + CV_RED))[i];
        inv_l = 1.0f / inv_l; inv_c = 1.0f / inv_c;
        const float skip = F.in[I_SKIP][d];
        const float c0 = cw[d], c1 = cw[6144 + d], c2 = cw[12288 + d], cb0 = cbp[d];
        {
            f32x4 acc[8];
#pragma unroll
            for (int i = 0; i < 8; ++i) acc[i] = (f32x4){0.f, 0.f, 0.f, 0.f};
#pragma unroll 1
            for (int dl = 4 * q - 15; dl <= 4 * q + 3; ++dl) {
                const int J = 4 * q + Isub - dl; const bool valid = (J >= 0) && (J <= 15);
                const LAS unsigned char* bp = valid ? lds + CV_V + bb * CV_VB + J * CV_VJ + h4 * 16 : lds + CV_ZERO + h4 * 16;
                const int xb = SL - 256 * dl - 128 * g - 8 * r + 8 * h4;
                const LAS unsigned char* ap = lds + CV_KR + (xb - 8) * 2;
#pragma unroll
                for (int kk = 0; kk < 8; ++kk) {
                    const u32x4 ca = *(const LAS u32x4*)(ap + 64 * kk), cbv = *(const LAS u32x4*)(ap + 64 * kk + 16);
                    const bf16x8 bfr = *(const LAS bf16x8*)(bp + 64 * kk);
                    const unsigned dd[8] = {ca.x, ca.y, ca.z, ca.w, cbv.x, cbv.y, cbv.z, cbv.w};
                    CV_MMA8(acc, dd, bfr);
                }
            }
            const int I = 4 * q + Isub, t0 = 256 * I + 128 * g + 32 * h4, col0 = bb * SL + t0;
            float x0c[32]; load_conv3<4>(ZT + (size_t)d * ZLD, col0, t0, SL, c0, c1, c2, cb0, x0c);
            const LAS unsigned char* vp = lds + CV_V + bb * CV_VB + I * CV_VJ + (128 * g + 32 * h4) * 2;
#pragma unroll
            for (int i = 0; i < 4; ++i) { const u32x4 vv = *(const LAS u32x4*)(vp + 16 * i); const unsigned vw[4] = {vv.x, vv.y, vv.z, vv.w}; unsigned ow[4];
#pragma unroll
                for (int p = 0; p < 4; ++p) { const int e0 = 8 * i + 2 * p, e1 = e0 + 1;
                    const float y0 = (acc[e0 & 7][e0 >> 3] * inv_l + skip * bflo(vw[p])) * x0c[e0], y1 = (acc[e1 & 7][e1 >> 3] * inv_l + skip * bfhi(vw[p])) * x0c[e1];
                    ow[p] = pk2(y0, y1); }
                *(GAS u32x4*)(YXT + (size_t)d * ZLD + col0 + 8 * i) = (u32x4){ow[0], ow[1], ow[2], ow[3]}; }
        }
        if (w < 2) {
            f32x4 acc[8];
#pragma unroll
            for (int i = 0; i < 8; ++i) acc[i] = (f32x4){0.f, 0.f, 0.f, 0.f};
            const bool valid = Isub == 0;
            const LAS unsigned char* bp = valid ? lds + CV_VC + bb * CV_VCB + h4 * 16 : lds + CV_ZERO + h4 * 16;
            const int xb = CL - 128 * g - 8 * r + 8 * h4;
            const LAS unsigned char* ap = lds + CV_KRC + (xb - 8) * 2;
#pragma unroll
            for (int kk = 0; kk < 8; ++kk) {
                const u32x4 ca = *(const LAS u32x4*)(ap + 64 * kk), cbv = *(const LAS u32x4*)(ap + 64 * kk + 16);
                const bf16x8 bfr = *(const LAS bf16x8*)(bp + 64 * kk);
                const unsigned dd[8] = {ca.x, ca.y, ca.z, ca.w, cbv.x, cbv.y, cbv.z, cbv.w};
                CV_MMA8(acc, dd, bfr);
            }
            if (valid) {
                const int t0 = 128 * g + 32 * h4, col0 = TL + bb * CL + t0;
                float x0c[32]; load_conv3<4>(ZT + (size_t)d * ZLD, col0, t0, CL, c0, c1, c2, cb0, x0c);
                const LAS unsigned char* vp = lds + CV_VC + bb * CV_VCB + t0 * 2;
#pragma unroll
                for (int i = 0; i < 4; ++i) { const u32x4 vv = *(const LAS u32x4*)(vp + 16 * i); const unsigned vw[4] = {vv.x, vv.y, vv.z, vv.w}; unsigned ow[4];
#pragma unroll
                    for (int p = 0; p < 4; ++p) { const int e0 = 8 * i + 2 * p, e1 = e0 + 1;
                        const float y0 = (acc[e0 & 7][e0 >> 3] * inv_c + skip * bflo(vw[p])) * x0c[e0], y1 = (acc[e1 & 7][e1 >> 3] * inv_c + skip * bfhi(vw[p])) * x0c[e1];
                        ow[p] = pk2(y0, y1); }
                    *(GAS u32x4*)(YXT + (size_t)d * ZLD + col0 + 8 * i) = (u32x4){ow[0], ow[1], ow[2], ow[3]}; }
            }
        }
    }
}

__device__ __forceinline__ void p_transpose_yx(Frame& F) {
    const bf16* src = (const bf16*)(F.ws + WS_YXT); bf16* dst = (bf16*)(F.ws + WS_YX);
    LAS unsigned short* scr = (LAS unsigned short*)(F.lds + F.wave * 8704);
    const int gw = F.c * NWAVES + F.wave, NGW = F.G * NWAVES, lane = F.lane;
    constexpr int NT_T = TT / 64, NTILES = (D / 64) * NT_T;
    for (int it = gw; it < NTILES; it += NGW) {
        const int cb = it / NT_T, tb = it - cb * NT_T, c0 = 64 * cb, tk0 = 64 * tb;
        u32x4 v[8];
#pragma unroll
        for (int i = 0; i < 8; ++i) v[i] = *(const GAS u32x4*)(src + (size_t)(c0 + 8 * i + (lane >> 3)) * ZLD + tk0 + 8 * (lane & 7));
#pragma unroll
        for (int i = 0; i < 8; ++i) { LAS unsigned* s = (LAS unsigned*)(scr + (8 * i + (lane >> 3)) * 68 + 8 * (lane & 7)); s[0] = v[i].x; s[1] = v[i].y; s[2] = v[i].z; s[3] = v[i].w; }
        LDS_WAIT(); asm volatile("" ::: "memory");
#pragma unroll
        for (int j = 0; j < 8; ++j) { const int tk = 8 * j + (lane >> 3), cc = 8 * (lane & 7); unsigned short e[8];
#pragma unroll
            for (int k = 0; k < 8; ++k) e[k] = scr[(cc + k) * 68 + tk];
            u32x4 o; o.x = e[0] | ((unsigned)e[1] << 16); o.y = e[2] | ((unsigned)e[3] << 16); o.z = e[4] | ((unsigned)e[5] << 16); o.w = e[6] | ((unsigned)e[7] << 16);
            *(GAS u32x4*)(dst + (size_t)(tk0 + tk) * D + c0 + cc) = o; }
        LDS_WAIT(); asm volatile("" ::: "memory");
    }
}
constexpr int S5_HS = 9216;
__device__ __forceinline__ size_t s5_row(int ti, int tau, int b, int dir) {
    if (ti < 8) { const int pos = 32 * ti + tau; return (size_t)(TL + b * CL + (dir ? CL - 1 - pos : pos)); }
    const int pos = 32 * (ti - 8) + tau; return (size_t)(b * SL + (dir ? SL - 1 - pos : pos));
}
__device__ __forceinline__ void p_s5(Frame& F) {
    if (F.wave >= 4) return;
    const int lane = F.lane, w = F.wave;
    const bf16* U = (const bf16*)(F.ws + WS_U);
    LAS unsigned char* Hs = F.lds + w * S5_HS;
    for (int sq = F.c * 4 + w; sq < 1024; sq += F.G * 4) {
        const int g = sq & 127, db = sq >> 7, dir = db >> 2, b = db & 3, pg = dir * 128 + g;
        const float step = __expf(F.in[I_SLOG][pg]);
        float lr, li;
        { const float ar = F.in[I_SARE][pg * 64 + lane], ai = F.in[I_SAIM][pg * 64 + lane]; const float er = expf(ar * step); float sn, cs; sincosf(ai * step, &sn, &cs); lr = er * cs; li = er * sn; }
        bf16x8 Bf[2][2];
#pragma unroll
        for (int ph = 0; ph < 2; ++ph) { const int p = 32 * ph + (lane & 31), hh = lane >> 5;
            const float ar = F.in[I_SARE][pg * 64 + p], ai = F.in[I_SAIM][pg * 64 + p]; const float er = expf(ar * step); float sn, cs; sincosf(ai * step, &sn, &cs);
            const float nr = er * cs - 1.0f, ni = er * sn, dn = 1.0f / (ar * ar + ai * ai); const float cr = (nr * ar + ni * ai) * dn, ci = (ni * ar - nr * ai) * dn;
            const float* br = F.in[I_SBRE] + ((size_t)pg * 64 + p) * 16 + 8 * hh; const float* bi = F.in[I_SBIM] + ((size_t)pg * 64 + p) * 16 + 8 * hh;
            unsigned wr_[4], wi_[4];
#pragma unroll
            for (int j = 0; j < 4; ++j) { const float r0 = br[2 * j], r1 = br[2 * j + 1], i0 = bi[2 * j], i1 = bi[2 * j + 1];
                wr_[j] = pk2(cr * r0 - ci * i0, cr * r1 - ci * i1); wi_[j] = pk2(cr * i0 + ci * r0, cr * i1 + ci * r1); }
            Bf[0][ph] = __builtin_bit_cast(bf16x8, (u32x4){wr_[0], wr_[1], wr_[2], wr_[3]}); Bf[1][ph] = __builtin_bit_cast(bf16x8, (u32x4){wi_[0], wi_[1], wi_[2], wi_[3]}); }
        bf16x8 Cf[4];
#pragma unroll
        for (int ks = 0; ks < 4; ++ks) { const int hp = lane & 15, p0 = 16 * ks + 4 * (lane >> 4);
            const float* crp = F.in[I_SCRE] + ((size_t)pg * 16 + hp) * 64 + p0; const float* cip = F.in[I_SCIM] + ((size_t)pg * 16 + hp) * 64 + p0;
            Cf[ks] = __builtin_bit_cast(bf16x8, (u32x4){pk2(crp[0], -cip[0]), pk2(crp[1], -cip[1]), pk2(crp[2], -cip[2]), pk2(crp[3], -cip[3])}); }
        bf16* Yp = (bf16*)(F.ws + (dir ? WS_YB : WS_YF));
        float hr = 0.f, hi = 0.f;
#define urow(ti_, tau_) s5_row((ti_), (tau_), b, dir)
        const int tau_a = lane & 31, coff = 16 * g + 8 * (lane >> 5);
        bf16x8 u0 = *(const GAS bf16x8*)(U + urow(0, tau_a) * D + coff), u1 = *(const GAS bf16x8*)(U + urow(1, tau_a) * D + coff);
#pragma unroll 1
        for (int ti = 0; ti < 136; ++ti) {
            const bf16x8 u2 = *(const GAS bf16x8*)(U + urow(ti + 2 < 136 ? ti + 2 : 135, tau_a) * D + coff);
            f32x16 z16;
#pragma unroll
            for (int i = 0; i < 16; ++i) z16[i] = 0.f;
            f32x16 aR0 = __builtin_amdgcn_mfma_f32_32x32x16_bf16(u0, Bf[0][0], z16, 0, 0, 0), aR1 = __builtin_amdgcn_mfma_f32_32x32x16_bf16(u0, Bf[0][1], z16, 0, 0, 0);
            f32x16 aI0 = __builtin_amdgcn_mfma_f32_32x32x16_bf16(u0, Bf[1][0], z16, 0, 0, 0), aI1 = __builtin_amdgcn_mfma_f32_32x32x16_bf16(u0, Bf[1][1], z16, 0, 0, 0);
            float bur[32], bui[32];
#pragma unroll
            for (int r = 0; r < 16; ++r) {
                const float fa = aR0[r], fb = aR1[r], fc = aI0[r], fd = aI1[r];
                auto sr = __builtin_amdgcn_permlane32_swap(__float_as_uint(fa), __float_as_uint(fb), false, false);
                auto si = __builtin_amdgcn_permlane32_swap(__float_as_uint(fc), __float_as_uint(fd), false, false);
                const unsigned sr0 = sr[0], sr1 = sr[1], si0 = si[0], si1 = si[1];
                const int tA = (r & 3) + 8 * (r >> 2);
                bur[tA] = __uint_as_float(sr0); bur[tA + 4] = __uint_as_float(sr1); bui[tA] = __uint_as_float(si0); bui[tA + 4] = __uint_as_float(si1); }
            const bool out_tile = ti >= 8;
#pragma unroll
            for (int tau = 0; tau < 32; ++tau) {
                const float t1 = __builtin_fmaf(lr, hr, bur[tau]), t2 = __builtin_fmaf(lr, hi, bui[tau]);
                const float nhr = __builtin_fmaf(-li, hi, t1), nhi = __builtin_fmaf(li, hr, t2);
                hr = nhr; hi = nhi;
                if (out_tile) *(LAS unsigned*)(Hs + tau * 288 + lane * 4) = pg8::cvt_pk_bf16(hr, hi);
            }
            if (out_tile) {
                asm volatile("s_waitcnt lgkmcnt(0)" ::: "memory");
#pragma unroll
                for (int mt = 0; mt < 2; ++mt) { f32x4 ay = {0.f, 0.f, 0.f, 0.f};
#pragma unroll
                    for (int ks = 0; ks < 4; ++ks) { const bf16x8 hf = *(const LAS bf16x8*)(Hs + (16 * mt + (lane & 15)) * 288 + (32 * ks + 8 * (lane >> 4)) * 2);
                        ay = __builtin_amdgcn_mfma_f32_16x16x32_bf16(Cf[ks], hf, ay, 0, 0, 0); }
                    u32x2 o; o.x = pk2(ay[0], ay[1]); o.y = pk2(ay[2], ay[3]);
                    *(GAS u32x2*)(Yp + urow(ti, 16 * mt + (lane & 15)) * D + 16 * g + 4 * (lane >> 4)) = o; }
                asm volatile("s_waitcnt lgkmcnt(0)" ::: "memory");
            }
            u0 = u1; u1 = u2;
        }
#undef urow
    }
}
__device__ __forceinline__ float gelu_tanh(float x) { const float u = 0.7978845608028654f * (x + 0.044715f * x * x * x); const float e = __expf(2.0f * u); const float th = 1.0f - 2.0f / (e + 1.0f); return 0.5f * x * (1.0f + th); }
__device__ __forceinline__ void p_s5_gelu(Frame& F) {
    const bf16* U = (const bf16*)(F.ws + WS_U); const bf16* YF = (const bf16*)(F.ws + WS_YF); const bf16* YB = (const bf16*)(F.ws + WS_YB); bf16* Gb = (bf16*)(F.ws + WS_G);
    const float* dsk = F.in[I_SD];
    const size_t n8 = (size_t)TL * D / 8, stride = (size_t)F.G * NTHR;
    for (size_t i = (size_t)F.c * NTHR + F.tid; i < n8; i += stride) {
        const u32x4 u = *(const GAS u32x4*)(U + 8 * i), a = *(const GAS u32x4*)(YF + 8 * i), b = *(const GAS u32x4*)(YB + 8 * i);
        const int c = (int)((8 * i) & 2047); const f32x4 d0 = *(const GAS f32x4*)(dsk + c), d1 = *(const GAS f32x4*)(dsk + c + 4);
        const unsigned uw[4] = {u.x, u.y, u.z, u.w}, aw[4] = {a.x, a.y, a.z, a.w}, bw[4] = {b.x, b.y, b.z, b.w}; const float dv[8] = {d0[0], d0[1], d0[2], d0[3], d1[0], d1[1], d1[2], d1[3]}; unsigned ow[4];
#pragma unroll
        for (int p = 0; p < 4; ++p) { const float y0 = dv[2 * p] * bflo(uw[p]) + bflo(aw[p]) + bflo(bw[p]), y1 = dv[2 * p + 1] * bfhi(uw[p]) + bfhi(aw[p]) + bfhi(bw[p]);
            ow[p] = pk2(gelu_tanh(y0), gelu_tanh(y1)); }
        *(GAS u32x4*)(Gb + 8 * i) = (u32x4){ow[0], ow[1], ow[2], ow[3]};
    }
}
#ifndef MK_N_LAUNCHES
#define MK_N_LAUNCHES 1
#endif
constexpr int N_PHASES = 17;

__device__ __forceinline__ void moe_rowtab(Frame& F, int nrb) {
    const LAS int* rb_e = (const LAS int*)(F.lds + TAB_OFF); const LAS int* rbfirst = rb_e + 168; const LAS int* cnt = rbfirst + 33;
    LAS unsigned* rowtab = (LAS unsigned*)(F.lds + ROWTAB_OFF); const int* list = (const int*)(F.ws + WS_LIST);
    for (int i = 0; i < 8; ++i) { const int L = i * F.G + F.c; if (L >= nrb * 8) break;
        const int rbi = L >> 3, e = rb_e[rbi], rbl = rbi - rbfirst[e];
        if (F.tid < 256) { const int slot = rbl * 256 + F.tid; const int tok = slot < cnt[e] ? list[(size_t)e * TT + slot] : 0; rowtab[i * 256 + F.tid] = (unsigned)tok * (unsigned)(D * 2); } }
    __syncthreads();
}

__global__ void __launch_bounds__(NTHR, 2) mega_fwd(Params P) {
    extern __shared__ __attribute__((aligned(16))) unsigned char lds_raw[];
    Frame F;
    F.lds = (LAS unsigned char*)lds_raw; F.ws = P.ws; F.ctl = (unsigned*)(P.ws + WS_CTL); F.in = P.in; F.out = P.out;
    F.tid = threadIdx.x; F.lane = F.tid & 63; F.wave = __builtin_amdgcn_readfirstlane(F.tid >> 6); F.G = gridDim.x; F.c = blockIdx.x;
    volatile LAS unsigned* MISC = (volatile LAS unsigned*)(F.lds + MISC_OFF);
    if (F.tid < 4) MISC[F.tid] = 0u;
    __syncthreads();
    XcdBarrier bar; bar.bar = F.ctl + CW_BAR; bar.x = 0; bar.st = MISC;
    if (MK_N_LAUNCHES == 1) bar = xcd_barrier_post(F.ctl + CW_BAR, MISC);
    const int lo = P.ph_lo, hi = P.ph_hi;
#define IN(k) (lo <= (k) && (k) < hi)
#define SEAM(k) do { if (IN(k) && IN((k) + 1)) xcd_barrier(bar); } while (0)
    const size_t TS2048 = (size_t)256 * 2048 * 2, TS1024 = (size_t)256 * 1024 * 2;

    if (IN(0)) { p0_prologue(F); } SEAM(0);
    if (IN(1)) { p_norm1_l0(F); } SEAM(1);
    if (IN(2)) {
        pg8::DenseOrder S; S.init(F.ws + WS_WIN, F.ws + WS_U, 6144, TT, 2048, F.G, F.c);
        pg8::EpiZT E{(bf16*)(F.ws + WS_ZT), ZLD, F.in[I_HBIN]};
        pg8::gemm_phase<pg8::EpiZT, pg8::DenseOrder, false>(F.lds, 2048, S, E, nullptr);
    } SEAM(2);
    if (IN(3)) { p_conv(F); } SEAM(3);
    if (IN(4)) { p_transpose_yx(F); } SEAM(4);
    if (IN(5)) {
        pg8::DenseOrder S; S.init(F.ws + WS_YX, F.ws + WS_WOUT, TT, 2048, 2048, F.G, F.c);
        pg8::EpiRes E{F.in[I_X], F.out, MODP(F, 0, 0) + 4096, F.in[I_CTX], (float*)(F.ws + WS_XC), MODP(F, 0, 4) + 4096, 12288, F.in[I_HBOUT]};
        pg8::gemm_phase<pg8::EpiRes, pg8::DenseOrder, false>(F.lds, 2048, S, E, nullptr);
    } SEAM(5);
#define MOE_PHASES(l, P_R, P_GU, P_DN, NTOK) \
    if (IN(P_R)) { p_router(F, (l), (NTOK)); } SEAM(P_R); \
    if (IN(P_GU)) { const int nrb = moe_tables(F, (l)); moe_rowtab(F, nrb); \
        pg8::MoeOrder S{(const char*)(F.ws + WS_U), (const char*)(F.ws + WS_WGU) + (size_t)(l) * 32 * 2048 * 2048 * 2, (const LAS int*)(F.lds + TAB_OFF), nrb, 8, F.G, F.c, 0, TS2048, (size_t)2048 * 2048 * 2, true}; \
        pg8::EpiGU E{(bf16*)(F.ws + WS_H), 1024}; \
        pg8::gemm_phase<pg8::EpiGU, pg8::MoeOrder, true>(F.lds, 2048, S, E, (const LAS unsigned*)(F.lds + ROWTAB_OFF)); } SEAM(P_GU); \
    if (IN(P_DN)) { const int nrb = moe_tables(F, (l)); \
        pg8::MoeOrder S{(const char*)(F.ws + WS_H), (const char*)(F.ws + WS_WD) + (size_t)(l) * 32 * 2048 * 1024 * 2, (const LAS int*)(F.lds + TAB_OFF), nrb, 8, F.G, F.c, TS1024, TS1024, (size_t)2048 * 1024 * 2, false}; \
        pg8::EpiBf E{(bf16*)(F.ws + WS_EO), 2048}; \
        pg8::gemm_phase<pg8::EpiBf, pg8::MoeOrder, false>(F.lds, 1024, S, E, nullptr); } SEAM(P_DN);
    MOE_PHASES(0, 6, 7, 8, TT)
    if (IN(9)) { p_comb_norm1_l1(F); } SEAM(9);
    if (IN(10)) { p_s5(F); } SEAM(10);
    if (IN(11)) { p_s5_gelu(F); } SEAM(11);
    if (IN(12)) {
        pg8::DenseOrder S; S.init(F.ws + WS_G, F.ws + WS_W12, TL, 4096, 2048, F.G, F.c);
        pg8::EpiGlu E{F.out, MODP(F, 1, 0) + 4096, 12288, F.in[I_SB1], F.in[I_SB2]};
        pg8::gemm_phase<pg8::EpiGlu, pg8::DenseOrder, false>(F.lds, 2048, S, E, nullptr);
    } SEAM(12);
    MOE_PHASES(1, 13, 14, 15, TL)
    if (IN(16)) { p_final(F); }
#undef IN
#undef SEAM
}

extern "C" void kernel_launch(void* const* d_in, const int* in_sizes, int n_in, void* d_out, int out_size, void* d_ws, size_t ws_size, hipStream_t stream) {
    static int grid = 0;
    if (grid == 0) {
        if (n_in != 40 || out_size != TL * D || ws_size < WS_END) { fprintf(stderr, "kernel_launch: unexpected shapes (n_in %d, out %d, ws %zu)\n", n_in, out_size, ws_size); grid = -1; return; }
        int dev = 0, cus = 0, per_cu = 0;
        if (hipGetDevice(&dev) != hipSuccess || hipDeviceGetAttribute(&cus, hipDeviceAttributeMultiprocessorCount, dev) != hipSuccess) { grid = -1; return; }
        if (hipFuncSetAttribute((const void*)mega_fwd, hipFuncAttributeMaxDynamicSharedMemorySize, LDS_BYTES) != hipSuccess) { fprintf(stderr, "kernel_launch: hipFuncSetAttribute failed\n"); grid = -1; return; }
        if (hipOccupancyMaxActiveBlocksPerMultiprocessor(&per_cu, (const void*)mega_fwd, NTHR, LDS_BYTES) != hipSuccess || per_cu < 1) { fprintf(stderr, "kernel_launch: occupancy query reports %d blocks per CU\n", per_cu); }
        (void)hipGetLastError();
        grid = cus;
    }
    if (grid < 0) return;
    (void)hipMemsetAsync((char*)d_ws + WS_CTL, 0, CTL_BYTES, stream);
    Params p{};
    for (int i = 0; i < 40; ++i) p.in[i] = (const float*)d_in[i];
    p.out = (float*)d_out; p.ws = (unsigned char*)d_ws;
#if MK_N_LAUNCHES == 1
    p.ph_lo = 0; p.ph_hi = N_PHASES;
    hipLaunchKernelGGL(mega_fwd, dim3(grid), dim3(NTHR), LDS_BYTES, stream, p);
#else
    for (int k = 0; k < N_PHASES; ++k) { p.ph_lo = k; p.ph_hi = k + 1; hipLaunchKernelGGL(mega_fwd, dim3(grid), dim3(NTHR), LDS_BYTES, stream, p); }
#endif
}
```

```cpp
#define MK_N_LAUNCHES 1
#include <hip/hip_runtime.h>
#include <cstdio>
#include <cstdint>

#define LAS __attribute__((address_space(3)))
#define GAS __attribute__((address_space(1)))
typedef unsigned short bf16;
typedef short bf16x8 __attribute__((ext_vector_type(8)));
typedef float f32x4 __attribute__((ext_vector_type(4)));
typedef float f32x2 __attribute__((ext_vector_type(2)));
typedef float f32x16 __attribute__((ext_vector_type(16)));
typedef unsigned u32x4 __attribute__((ext_vector_type(4)));
typedef unsigned u32x2 __attribute__((ext_vector_type(2)));

constexpr int D = 2048, NB = 4, SL = 4096, CL = 256, TL = NB * SL  , TC = NB * CL  , TT = TL + TC  ;
constexpr int NE = 32, DE = 1024, NRB_MAX = 168, ZLD = TT;
constexpr float EPS = 1e-6f;
constexpr int NWAVES = 8, NTHR = 512;

constexpr size_t MiB = 1u << 20;
constexpr size_t WS_CTL = 0, CTL_BYTES = 1 * MiB;
constexpr size_t WS_MOD = 1 * MiB;
constexpr size_t WS_LIST = 2 * MiB;
constexpr size_t WS_TOKPOS = 5 * MiB;
constexpr size_t WS_GATE = 5 * MiB + 512 * 1024;
constexpr size_t WS_KRN = 6 * MiB;
constexpr size_t WS_KRC = 38 * MiB;
constexpr size_t WS_WIN = 40 * MiB;
constexpr size_t WS_WOUT = 64 * MiB;
constexpr size_t WS_W12 = 72 * MiB;
constexpr size_t WS_WGU = 88 * MiB;
constexpr size_t WS_WD = 600 * MiB;
constexpr size_t WS_XC = 856 * MiB;
constexpr size_t WS_U = 864 * MiB;
constexpr size_t WS_ZT = 932 * MiB;
constexpr size_t WS_YXT = 1136 * MiB;
constexpr size_t WS_YX = 1204 * MiB;
constexpr size_t WS_H = 1272 * MiB;
constexpr size_t WS_EO = 1356 * MiB;
constexpr size_t WS_END = 1524 * MiB;
constexpr size_t WS_YF = WS_ZT, WS_YB = WS_ZT + 64 * MiB, WS_G = WS_ZT + 128 * MiB;

constexpr int CW_TMO = 0;
constexpr int CW_BAR = 4096;
constexpr int CW_CNT = 8192;

constexpr int LDS_BYTES = 147456;
constexpr int ROWTAB_OFF = 131072;
constexpr int TAB_OFF = 139264;
constexpr int MISC_OFF = 141312;

#define LDS_WAIT() asm volatile("s_waitcnt lgkmcnt(0)" ::: "memory")
#define VM_WAIT() asm volatile("s_waitcnt vmcnt(0)" ::: "memory")
__device__ __forceinline__ unsigned f2bf(float f) { unsigned u = __builtin_bit_cast(unsigned, f); return (u + 0x7fffu + ((u >> 16) & 1u)) >> 16; }
__device__ __forceinline__ unsigned pk2(float lo, float hi) { return f2bf(lo) | (f2bf(hi) << 16); }
__device__ __forceinline__ float bf2f(unsigned short b) { return __builtin_bit_cast(float, ((unsigned)b) << 16); }
__device__ __forceinline__ float bflo(unsigned w) { return __builtin_bit_cast(float, w << 16); }
__device__ __forceinline__ float bfhi(unsigned w) { return __builtin_bit_cast(float, w & 0xffff0000u); }
__device__ __forceinline__ float wave_sum(float v) {
#pragma unroll
    for (int o = 1; o < 64; o <<= 1) v += __shfl_xor(v, o);
    return v;
}
__device__ __forceinline__ float sigmoidf_(float x) { return 1.0f / (1.0f + __expf(-x)); }
__device__ __forceinline__ float siluf_(float x) { return x / (1.0f + __expf(-x)); }

#define XB_TMO      128
#define XB_XCNT(j)  (256  + 64 * (j))
#define XB_XSUB(j)  (1280 + 64 * (j))
#define XB_XGEN(j)  (2304 + 64 * (j))
#define XB_TOP      3328
#define XB_TOPGEN   3392
#define XCD_BAR_WORDS 3456
#define XB_SPIN_CAP (1u << 18)
__device__ __forceinline__ unsigned xb_ld(unsigned* p)              { return __hip_atomic_load(p, __ATOMIC_RELAXED, __HIP_MEMORY_SCOPE_AGENT); }
__device__ __forceinline__ unsigned xb_add(unsigned* p, unsigned v) { return __hip_atomic_fetch_add(p, v, __ATOMIC_RELAXED, __HIP_MEMORY_SCOPE_AGENT); }
__device__ __forceinline__ unsigned xb_xcc_id() { return (unsigned)__builtin_amdgcn_s_getreg((3 << 11) | 20) & 0xFu; }
#define XB_SPIN(cond, bar) do { unsigned _sp = 0; while (cond) { __builtin_amdgcn_s_sleep(1); \
    if ((++_sp & 255u) == 0u) { if (xb_ld(&(bar)[XB_TMO])) break; if (_sp > XB_SPIN_CAP) { atomicAdd(&(bar)[XB_TMO], 1u); break; } } } } while (0)
struct XcdBarrier { unsigned* bar; unsigned x; volatile LAS unsigned* st; };
__device__ __forceinline__ XcdBarrier xcd_barrier_post(unsigned* bar, volatile LAS unsigned* st) {
    XcdBarrier b; b.bar = bar; b.x = xb_xcc_id(); b.st = st;
    if (threadIdx.x == 0) (void)xb_add(&bar[XB_XCNT(b.x)], 1u);
    return b;
}
__device__ __forceinline__ void xcd_barrier_complete(unsigned* bar, unsigned x, unsigned& nloc, unsigned& nx) {
    const unsigned G = gridDim.x * gridDim.y * gridDim.z;
    unsigned sum, cnt, mine, sp = 0u;
    for (;;) {
        sum = 0u; cnt = 0u; mine = 0u;
#pragma unroll
        for (unsigned j = 0; j < 16; ++j) { const unsigned c = xb_ld(&bar[XB_XCNT(j)]); sum += c; cnt += (c > 0u) ? 1u : 0u; mine = (j == x) ? c : mine; }
        if (sum == G) break;
        __builtin_amdgcn_s_sleep(1);
        if ((++sp & 255u) == 0u) { if (xb_ld(&bar[XB_TMO])) break; if (sp > XB_SPIN_CAP) { atomicAdd(&bar[XB_TMO], 1u); break; } }
    }
    nloc = mine > 0u ? mine : 1u; nx = cnt > 0u ? cnt : 1u;
}
__device__ __forceinline__ void xcd_barrier(const XcdBarrier& b) {
    asm volatile("s_waitcnt vmcnt(0)" ::: "memory");
    __syncthreads();
    if (threadIdx.x == 0) {
        unsigned* bar = b.bar;
        __builtin_amdgcn_s_waitcnt(0);
        unsigned nloc = b.st[0], nx = b.st[1];
        if (nloc == 0u) { xcd_barrier_complete(bar, b.x, nloc, nx); b.st[0] = nloc; b.st[1] = nx; }
        const unsigned old = xb_add(&bar[XB_XSUB(b.x)], 1u);
        const unsigned gen = old / nloc;
        if (old + 1u == (gen + 1u) * nloc) {
            __builtin_amdgcn_fence(__ATOMIC_RELEASE, "agent");
            asm volatile("s_waitcnt vmcnt(0)" ::: "memory");
            const unsigned og = xb_add(&bar[XB_TOP], 1u);
            const unsigned tg = og / nx;
            if (og + 1u == (tg + 1u) * nx) xb_add(&bar[XB_TOPGEN], 1u);
            else XB_SPIN(xb_ld(&bar[XB_TOPGEN]) == tg, bar);
            __builtin_amdgcn_fence(__ATOMIC_ACQUIRE, "agent");
            xb_add(&bar[XB_XGEN(b.x)], 1u);
            asm volatile("s_waitcnt vmcnt(0)" ::: "memory");
        } else {
            XB_SPIN(xb_ld(&bar[XB_XGEN(b.x)]) == gen, bar);
            __builtin_amdgcn_fence(__ATOMIC_ACQUIRE, "agent");
            asm volatile("s_waitcnt vmcnt(0)" ::: "memory");
        }
    }
    __syncthreads();
}
namespace pg8 {
constexpr int BM = 256, BK = 64, HALF = 128, HTB = HALF * BK * 2, STAGE_BYTES = 8 * HTB, NXCD = 8, WGM = 8;
__device__ __forceinline__ int lds_byte(int r, int c) { const int st = (r >> 4) * 2 + (c >> 5), rr = r & 15, cc = c & 31, ob = rr * 64 + cc * 2; return st * 1024 + (ob ^ (((ob >> 9) & 1) << 5)); }
__device__ __forceinline__ void stage_rc(int b, int& R, int& C) { const int st = b / 1024, sb = b % 1024, swz = sb ^ (((sb >> 9) & 1) << 5); R = (st >> 1) * 16 + swz / 64; C = (st & 1) * 32 + (swz % 64) / 2; }
__device__ __forceinline__ int perm32(int rho) { const int n = rho >> 4, i = rho & 15; return 8 * (i >> 2) + 4 * n + (i & 3); }

struct Unit { const char* A; const char* B; int pm, pn, ui; };

struct DenseOrder {
    const char* A; const char* B; int nM, nN, nwg, G, c; size_t tstep;
    __device__ __forceinline__ void init(const void* A_, const void* B_, int M, int N, int K, int G_, int c_) { A = (const char*)A_; B = (const char*)B_; nM = M / BM; nN = N / BM; nwg = nM * nN; G = G_; c = c_; tstep = (size_t)BM * K * 2; }
    __device__ __forceinline__ bool next(int i, Unit& u) const {
        const long L = (long)i * G + c; if (L >= nwg) return false;
        int wgid = (int)L; { const int q = nwg / NXCD, r = nwg % NXCD, xcd = wgid % NXCD, off = wgid / NXCD; wgid = (xcd < r ? xcd * (q + 1) : r * (q + 1) + (xcd - r) * q) + off; }
        const int nig = WGM * nN, gid = wgid / nig, fm = gid * WGM, gsz = (nM - fm) < WGM ? (nM - fm) : WGM;
        u.pm = fm + ((wgid % nig) % gsz); u.pn = (wgid % nig) / gsz; u.ui = i;
        u.A = A + (size_t)u.pm * tstep; u.B = B + (size_t)u.pn * tstep; return true;
    }
};
struct MoeOrder {
    const char* A; const char* B; const LAS int* rb_e; int nrb, nN, G, c; size_t tstepA, tstepB, estepB; bool gather;
    __device__ __forceinline__ bool next(int i, Unit& u) const {
        const int L = i * G + c; if (L >= nrb * nN) return false;
        const int rbi = L / nN, pn = L - rbi * nN; const int e = rb_e[rbi];
        u.pm = rbi; u.pn = pn; u.ui = i; u.A = gather ? A : A + (size_t)rbi * tstepA; u.B = B + (size_t)e * estepB + (size_t)pn * tstepB; return true;
    }
};

__device__ __forceinline__ unsigned cvt_pk_bf16(float lo, float hi) { unsigned r; asm volatile("v_cvt_pk_bf16_f32 %0, %1, %2" : "=v"(r) : "v"(lo), "v"(hi)); return r; }

typedef f32x4 Acc[2][2][4][2];

struct EpiZT {
    static constexpr bool PERM = true;
    bf16* O; int ldc; const float* bias;
    __device__ __forceinline__ void operator()(const Acc& acc, const Unit& u, int wr, int wc, int fr, int fq) const {
        const int row0 = u.pm * BM + wr * 64 + fr, col0 = u.pn * BM + wc * 32 + 8 * fq;
#pragma unroll
        for (int ai = 0; ai < 2; ++ai)
#pragma unroll
            for (int m = 0; m < 4; ++m) { const int r = row0 + ai * HALF + m * 16; const float bv = bias[r]; bf16* rowp = O + (size_t)r * ldc + col0;
#pragma unroll
                for (int bj = 0; bj < 2; ++bj) { const f32x4 v0 = acc[ai][bj][m][0] + bv, v1 = acc[ai][bj][m][1] + bv;
                    u32x4 w; w.x = cvt_pk_bf16(v0[0], v0[1]); w.y = cvt_pk_bf16(v0[2], v0[3]); w.z = cvt_pk_bf16(v1[0], v1[1]); w.w = cvt_pk_bf16(v1[2], v1[3]);
                    *(u32x4*)(rowp + bj * HALF) = w; } }
    }
};
struct EpiBf {
    static constexpr bool PERM = true;
    bf16* O; int ldc;
    __device__ __forceinline__ void operator()(const Acc& acc, const Unit& u, int wr, int wc, int fr, int fq) const {
        const int row0 = u.pm * BM + wr * 64 + fr, col0 = u.pn * BM + wc * 32 + 8 * fq;
#pragma unroll
        for (int ai = 0; ai < 2; ++ai)
#pragma unroll
            for (int m = 0; m < 4; ++m) { bf16* rowp = O + (size_t)(row0 + ai * HALF + m * 16) * ldc + col0;
#pragma unroll
                for (int bj = 0; bj < 2; ++bj) { const f32x4 v0 = acc[ai][bj][m][0], v1 = acc[ai][bj][m][1];
                    u32x4 w; w.x = cvt_pk_bf16(v0[0], v0[1]); w.y = cvt_pk_bf16(v0[2], v0[3]); w.z = cvt_pk_bf16(v1[0], v1[1]); w.w = cvt_pk_bf16(v1[2], v1[3]);
                    *(u32x4*)(rowp + bj * HALF) = w; } }
    }
};
struct EpiGU {
    static constexpr bool PERM = true;
    bf16* O; int ldc;
    __device__ __forceinline__ void operator()(const Acc& acc, const Unit& u, int wr, int wc, int fr, int fq) const {
        const int row0 = u.pm * BM + wr * 64 + fr, col0 = u.pn * HALF + wc * 32 + 8 * fq;
#pragma unroll
        for (int ai = 0; ai < 2; ++ai)
#pragma unroll
            for (int m = 0; m < 4; ++m) { bf16* rowp = O + (size_t)(row0 + ai * HALF + m * 16) * ldc + col0;
                f32x4 h0, h1;
#pragma unroll
                for (int j = 0; j < 4; ++j) { h0[j] = siluf_(acc[ai][0][m][0][j]) * acc[ai][1][m][0][j]; h1[j] = siluf_(acc[ai][0][m][1][j]) * acc[ai][1][m][1][j]; }
                u32x4 w; w.x = cvt_pk_bf16(h0[0], h0[1]); w.y = cvt_pk_bf16(h0[2], h0[3]); w.z = cvt_pk_bf16(h1[0], h1[1]); w.w = cvt_pk_bf16(h1[2], h1[3]);
                *(u32x4*)rowp = w; }
    }
};
struct EpiRes {
    static constexpr bool PERM = false;
    const float* base_l; float* out_l; const float* gate_l;
    const float* base_c; float* out_c; const float* gate_c; int gstride; const float* bias;
    __device__ __forceinline__ void operator()(const Acc& acc, const Unit& u, int wr, int wc, int fr, int fq) const {
        const bool isc = u.pm >= TL / BM; const int prow = isc ? u.pm - TL / BM : u.pm;
        const float* base = isc ? base_c : base_l; float* out = isc ? out_c : out_l; const float* gate = isc ? gate_c : gate_l + (size_t)(u.pm / (SL / BM)) * gstride;
        const int row0 = prow * BM + wr * 64 + fr, col0 = u.pn * BM + wc * 32 + 4 * fq;
        f32x4 bv[2][2], gv[2][2];
#pragma unroll
        for (int bj = 0; bj < 2; ++bj)
#pragma unroll
            for (int n = 0; n < 2; ++n) { bv[bj][n] = *(const f32x4*)(bias + col0 + bj * HALF + n * 16); gv[bj][n] = *(const f32x4*)(gate + col0 + bj * HALF + n * 16); }
#pragma unroll
        for (int ai = 0; ai < 2; ++ai)
#pragma unroll
            for (int m = 0; m < 4; ++m) { const size_t off = (size_t)(row0 + ai * HALF + m * 16) * D + col0;
#pragma unroll
                for (int bj = 0; bj < 2; ++bj)
#pragma unroll
                    for (int n = 0; n < 2; ++n) { const f32x4 bs = *(const f32x4*)(base + off + bj * HALF + n * 16);
                        *(f32x4*)(out + off + bj * HALF + n * 16) = bs + gv[bj][n] * (acc[ai][bj][m][n] + bv[bj][n]); }
                asm volatile("" ::: "memory"); }
    }
};
struct EpiGlu {
    static constexpr bool PERM = false;
    float* x; const float* gate; int gstride; const float* b1; const float* b2;
    __device__ __forceinline__ void operator()(const Acc& acc, const Unit& u, int wr, int wc, int fr, int fq) const {
        const float* g = gate + (size_t)(u.pm / (SL / BM)) * gstride;
        const int row0 = u.pm * BM + wr * 64 + fr, col0 = u.pn * HALF + wc * 32 + 4 * fq;
        f32x4 b1v[2], b2v[2], gv[2];
#pragma unroll
        for (int n = 0; n < 2; ++n) { b1v[n] = *(const f32x4*)(b1 + col0 + n * 16); b2v[n] = *(const f32x4*)(b2 + col0 + n * 16); gv[n] = *(const f32x4*)(g + col0 + n * 16); }
#pragma unroll
        for (int ai = 0; ai < 2; ++ai)
#pragma unroll
            for (int m = 0; m < 4; ++m) { float* rowp = x + (size_t)(row0 + ai * HALF + m * 16) * D + col0;
#pragma unroll
                for (int n = 0; n < 2; ++n) { const f32x4 a = acc[ai][0][m][n] + b1v[n], b = acc[ai][1][m][n] + b2v[n]; f32x4 o;
#pragma unroll
                    for (int j = 0; j < 4; ++j) o[j] = a[j] * sigmoidf_(b[j]);
                    const f32x4 bs = *(const f32x4*)(rowp + n * 16); *(f32x4*)(rowp + n * 16) = bs + gv[n] * o; }
                asm volatile("" ::: "memory"); }
    }
};

template <class Epi, class Sched, bool GATHER>
__device__ __forceinline__ void gemm_phase(LAS unsigned char* lds, const int K, const Sched& S, const Epi& E, const LAS unsigned* rowtab) {
    const int tid = threadIdx.x, wid = __builtin_amdgcn_readfirstlane(tid >> 6), lane = tid & 63, wr = wid >> 2, wc = wid & 3, fr = lane & 15, fq = lane >> 4;
    const int nt = K / BK;
    unsigned voffB[2]; unsigned cv[2][2], nv[2][2]; int Rr[2], Cc[2];
    const size_t kstep = (size_t)(BK * 2);
    const size_t hstep = (size_t)HALF * K * 2;
#pragma unroll
    for (int i = 0; i < 2; ++i) { int R, C; stage_rc(tid * 16 + i * 8192, R, C); const int Rb = Epi::PERM ? ((R & ~31) + perm32(R & 31)) : R;
        Rr[i] = R; Cc[i] = C; voffB[i] = (unsigned)(Rb * K + C) * 2u;
        if constexpr (!GATHER) { cv[0][i] = (unsigned)(R * K + C) * 2u; cv[1][i] = cv[0][i] + (unsigned)hstep; } }
    const unsigned ldsw = (unsigned)wid * 1024u;
    const int aoff = lds_byte(wr * 64 + fr, fq * 8), boff = lds_byte(wc * 32 + fr, fq * 8);
#define PG8_SA(b, h) (((b) * 2 + (h)) * HTB)
#define PG8_SB(b, h) ((4 + (b) * 2 + (h)) * HTB)
#define PG8_STAGE(bufoff, gbase, voff) do { _Pragma("unroll") for (int _i = 0; _i < 2; ++_i) \
        __builtin_amdgcn_global_load_lds((const unsigned*)((const char*)(gbase) + (voff)[_i]), (LAS unsigned*)(lds + (bufoff) + ldsw + _i * 8192), 16, 0, 0); } while (0)
#define PG8_LDROWS(dst, uix) do { _Pragma("unroll") for (int _h = 0; _h < 2; ++_h) _Pragma("unroll") for (int _i = 0; _i < 2; ++_i) \
        dst[_h][_i] = rowtab[(uix) * 256 + _h * 128 + Rr[_i]] + (unsigned)(Cc[_i] * 2); } while (0)
#define PG8_LDA(dst, b, h) do { _Pragma("unroll") for (int m = 0; m < 4; ++m) _Pragma("unroll") for (int k = 0; k < 2; ++k) dst[m][k] = *(const LAS bf16x8*)(lds + PG8_SA(b, h) + aoff + m * 2048 + k * 1024); } while (0)
#define PG8_LDB(dst, b, h) do { _Pragma("unroll") for (int n = 0; n < 2; ++n) _Pragma("unroll") for (int k = 0; k < 2; ++k) dst[n][k] = *(const LAS bf16x8*)(lds + PG8_SB(b, h) + boff + n * 2048 + k * 1024); } while (0)
#define PG8_MMA(ai, bj, At, Bt) do { __builtin_amdgcn_s_setprio(1); _Pragma("unroll") for (int m = 0; m < 4; ++m) _Pragma("unroll") for (int n = 0; n < 2; ++n) _Pragma("unroll") for (int k = 0; k < 2; ++k) \
        acc[ai][bj][m][n] = __builtin_amdgcn_mfma_f32_16x16x32_bf16(Bt[n][k], At[m][k], acc[ai][bj][m][n], 0, 0, 0); __builtin_amdgcn_s_setprio(0); } while (0)
#define PG8_WAIT_V(n) asm volatile("s_waitcnt vmcnt(" #n ")" ::: "memory")
#define PG8_WAIT_L(n) asm volatile("s_waitcnt lgkmcnt(" #n ")" ::: "memory")
#define PG8_BAR __builtin_amdgcn_s_barrier()
#define PG8_SCHED __builtin_amdgcn_sched_barrier(0)
    Unit cur, nxt; int ui = 0;
    if (!S.next(0, cur)) return;
    Acc acc;
#pragma unroll
    for (int a = 0; a < 2; ++a)
#pragma unroll
        for (int b = 0; b < 2; ++b)
#pragma unroll
            for (int m = 0; m < 4; ++m)
#pragma unroll
                for (int n = 0; n < 2; ++n) acc[a][b][m][n] = (f32x4){0.f, 0.f, 0.f, 0.f};
    bf16x8 At[4][2], B0[2][2], B1[2][2];
    const char* cA = cur.A; const char* cB = cur.B;
    if constexpr (GATHER) { PG8_LDROWS(cv, cur.ui); PG8_WAIT_L(0); }
    PG8_STAGE(PG8_SB(0, 0), cB, voffB); PG8_STAGE(PG8_SB(0, 1), cB + hstep, voffB); PG8_STAGE(PG8_SA(0, 0), cA, cv[0]); PG8_STAGE(PG8_SA(0, 1), cA, cv[1]);
    if (wr == 1) PG8_BAR;
    PG8_WAIT_V(2); PG8_BAR;
    PG8_STAGE(PG8_SB(1, 0), cB + kstep, voffB); PG8_STAGE(PG8_SA(1, 0), cA + kstep, cv[0]); PG8_STAGE(PG8_SB(1, 1), cB + hstep + kstep, voffB);
    PG8_WAIT_V(6); PG8_BAR;
    for (;;) {
        const bool has_next = S.next(ui + 1, nxt);
        const char* nA = has_next ? nxt.A : cA; const char* nB = has_next ? nxt.B : cB;
        for (int t = 0; t < nt; t += 2) {
            const bool last = (t == nt - 2);
            const char* a1 = cA + (size_t)(t + 1) * kstep;
            const char* a2 = last ? nA : cA + (size_t)(t + 2) * kstep; const char* b2 = last ? nB : cB + (size_t)(t + 2) * kstep;
            const char* a3 = a2 + kstep; const char* b3 = b2 + kstep;
            if constexpr (GATHER) { if (last) { PG8_LDROWS(nv, has_next ? nxt.ui : cur.ui); } else {
#pragma unroll
                for (int h = 0; h < 2; ++h)
#pragma unroll
                    for (int i = 0; i < 2; ++i) nv[h][i] = cv[h][i]; } }
            else {
#pragma unroll
                for (int h = 0; h < 2; ++h)
#pragma unroll
                    for (int i = 0; i < 2; ++i) nv[h][i] = cv[h][i]; }
            PG8_LDB(B0, 0, 0); PG8_LDB(B1, 0, 1); PG8_SCHED; PG8_LDA(At, 0, 0); PG8_STAGE(PG8_SA(1, 1), a1, cv[1]);
            PG8_WAIT_V(8); PG8_WAIT_L(0); PG8_BAR; PG8_MMA(0, 0, At, B0); PG8_MMA(0, 1, At, B1); PG8_BAR; PG8_SCHED;
            PG8_LDA(At, 0, 1); PG8_STAGE(PG8_SB(0, 0), b2, voffB); PG8_STAGE(PG8_SB(0, 1), b2 + hstep, voffB); PG8_STAGE(PG8_SA(0, 0), a2, nv[0]);
            PG8_WAIT_V(8); PG8_WAIT_L(0); PG8_BAR; PG8_MMA(1, 0, At, B0); PG8_MMA(1, 1, At, B1); PG8_BAR; PG8_SCHED;
            PG8_LDB(B0, 1, 0); PG8_LDB(B1, 1, 1); PG8_SCHED; PG8_LDA(At, 1, 0); PG8_STAGE(PG8_SA(0, 1), a2, nv[1]);
            PG8_WAIT_V(8); PG8_WAIT_L(0); PG8_BAR; PG8_MMA(0, 0, At, B0); PG8_MMA(0, 1, At, B1); PG8_BAR; PG8_SCHED;
            PG8_LDA(At, 1, 1); PG8_STAGE(PG8_SB(1, 0), b3, voffB); PG8_STAGE(PG8_SB(1, 1), b3 + hstep, voffB); PG8_STAGE(PG8_SA(1, 0), a3, nv[0]);
            PG8_WAIT_V(8); PG8_WAIT_L(0); PG8_BAR; PG8_MMA(1, 0, At, B0); PG8_MMA(1, 1, At, B1); PG8_BAR; PG8_SCHED;
        }
        if (wr == 0) PG8_BAR;
        E(acc, cur, wr, wc, fr, fq);
        if (!has_next) break;
#pragma unroll
        for (int a = 0; a < 2; ++a)
#pragma unroll
            for (int b = 0; b < 2; ++b)
#pragma unroll
                for (int m = 0; m < 4; ++m)
#pragma unroll
                    for (int n = 0; n < 2; ++n) acc[a][b][m][n] = (f32x4){0.f, 0.f, 0.f, 0.f};
        cur = nxt; cA = nA; cB = nB; ++ui;
        if constexpr (GATHER) {
#pragma unroll
            for (int h = 0; h < 2; ++h)
#pragma unroll
                for (int i = 0; i < 2; ++i) cv[h][i] = nv[h][i]; }
        if (wr == 1) PG8_BAR;
    }
    PG8_WAIT_V(0);
    PG8_BAR;
#undef PG8_SA
#undef PG8_SB
#undef PG8_STAGE
#undef PG8_LDROWS
#undef PG8_LDA
#undef PG8_LDB
#undef PG8_MMA
#undef PG8_WAIT_V
#undef PG8_WAIT_L
#undef PG8_BAR
#undef PG8_SCHED
}
}
struct Params { const float* in[40]; float* out; unsigned char* ws; int ph_lo, ph_hi; };
enum { I_X = 0, I_C, I_CTX, I_CCTX, I_ADAW, I_ADAB, I_NORMG, I_FINALG, I_HWIN, I_HBIN, I_HCW, I_HCB, I_FW1, I_FB1, I_FW2, I_FB2, I_FW3, I_FREQ, I_SKIP, I_HWOUT, I_HBOUT,
       I_SARE, I_SAIM, I_SLOG, I_SBRE, I_SBIM, I_SCRE, I_SCIM, I_SD, I_SW1, I_SB1, I_SW2, I_SB2, I_MWG, I_MBG, I_MWE, I_MBE, I_MGATE, I_MUP, I_MDOWN };

struct Frame {
    LAS unsigned char* lds; unsigned* ctl; unsigned char* ws; const float* const* in; float* out;
    int tid, lane, wave, G, c;
};
#define MODP(F, l, r) ((const float*)((F).ws + WS_MOD) + ((size_t)(l) * 5 + (r)) * 12288)

__device__ __forceinline__ void p0_transpose_item(const float* W, int K, int N, bf16* WT, int k0, int n0, int drow0, LAS float* scr, int lane) {
    f32x4 v[8];
#pragma unroll
    for (int i = 0; i < 8; ++i) v[i] = *(const GAS f32x4*)(W + (size_t)(k0 + 8 * i + (lane >> 3)) * N + n0 + 4 * (lane & 7));
#pragma unroll
    for (int i = 0; i < 8; ++i) { LAS float* s = scr + (8 * i + (lane >> 3)) * 33 + 4 * (lane & 7); s[0] = v[i][0]; s[1] = v[i][1]; s[2] = v[i][2]; s[3] = v[i][3]; }
    LDS_WAIT(); asm volatile("" ::: "memory");
    const int c = lane & 7;
#pragma unroll
    for (int j = 0; j < 4; ++j) { const int n = (lane >> 3) + 8 * j; const LAS float* s = scr + (8 * c) * 33 + n;
        u32x4 o; o.x = pk2(s[0 * 33], s[1 * 33]); o.y = pk2(s[2 * 33], s[3 * 33]); o.z = pk2(s[4 * 33], s[5 * 33]); o.w = pk2(s[6 * 33], s[7 * 33]);
        *(GAS u32x4*)(WT + (size_t)(drow0 + n) * K + k0 + 8 * c) = o; }
    LDS_WAIT(); asm volatile("" ::: "memory");
}
__device__ __forceinline__ void p0_job(const float* W, int K, int N, bf16* WT, bool ilv, int ilv_off, int idx, LAS float* scr, int lane) {
    const int nblk = N / 32, kb = idx / nblk, nb = idx - kb * nblk, n0 = 32 * nb;
    const int drow0 = ilv ? ((n0 >> 7) * 256 + ilv_off + (n0 & 127)) : n0;
    p0_transpose_item(W, K, N, WT, 64 * kb, n0, drow0, scr, lane);
}

__device__ __forceinline__ void p0_prologue(Frame& F) {
    const float* const* in = F.in;
    {
        LAS float* sl = (LAS float*)F.lds;
        for (int i = F.tid; i < 2048 * 5; i += NTHR) { const int r = i / 2048, k = i - r * 2048; const float cv = r < 4 ? in[I_C][r * 2048 + k] : in[I_CCTX][k]; sl[k * 8 + r] = siluf_(cv); }
        __syncthreads();
        LAS float* red = (LAS float*)(F.lds + 65536);
        for (int it = F.c; it < 768; it += F.G) {
            const int l = it / 384, j = it - l * 384; const float* W = in[I_ADAW] + (size_t)l * 2048 * 12288 + 32 * j + (F.lane & 31);
            float a0 = 0.f, a1 = 0.f, a2 = 0.f, a3 = 0.f, a4 = 0.f;
            const int kbase = 256 * F.wave + (F.lane >> 5);
#pragma unroll 16
            for (int kk = 0; kk < 128; ++kk) { const int k = kbase + 2 * kk; const float w = W[(size_t)k * 12288];
                const f32x4 s = *(const LAS f32x4*)(sl + k * 8); const float s4 = sl[k * 8 + 4];
                a0 += s[0] * w; a1 += s[1] * w; a2 += s[2] * w; a3 += s[3] * w; a4 += s4 * w; }
            a0 += __shfl_xor(a0, 32); a1 += __shfl_xor(a1, 32); a2 += __shfl_xor(a2, 32); a3 += __shfl_xor(a3, 32); a4 += __shfl_xor(a4, 32);
            if (F.lane < 32) { LAS float* r = red + F.wave * 160 + F.lane; r[0] = a0; r[32] = a1; r[64] = a2; r[96] = a3; r[128] = a4; }
            __syncthreads();
            if (F.tid < 160) { float s = 0.f;
#pragma unroll
                for (int w = 0; w < 8; ++w) s += red[w * 160 + F.tid];
                const int r = F.tid >> 5, col = 32 * j + (F.tid & 31);
                ((float*)(F.ws + WS_MOD))[((size_t)l * 5 + r) * 12288 + col] = s + in[I_ADAB][l * 12288 + col]; }
            __syncthreads();
        }
    }
    {
        LAS float* zf = (LAS float*)F.lds;
        LAS float* h1 = (LAS float*)(F.lds + 20480);
        LAS float* h2T = (LAS float*)(F.lds + 57344);
        for (int it = F.c; it < 256; it += F.G) {
            const int pb = it >> 3, cb = it & 7, pbase = pb * 136;
            for (int i = F.tid; i < 136 * 33; i += NTHR) { const int p = i / 33, m = i - p * 33; const int gp = pbase + p; const int Lq = gp < SL ? SL : CL, j = gp < SL ? gp : gp - SL;
                float v;
                if (m == 0) v = (float)j / (float)(Lq - 1);
                else { const int mm = (m - 1) & 15; const float band = 1e-4f + (float)mm * ((15.0f - 1e-4f) / 15.0f); const float w = (6.283185307179586f / (float)Lq) * (float)j; const float a = band * w;
                    v = (m <= 16) ? cosf(a) : -sinf(a); }
                zf[i] = v; }
            __syncthreads();
            for (int i = F.tid; i < 136 * 64; i += NTHR) { const int p = i >> 6, o = i & 63; float s = in[I_FB1][o];
                for (int m = 0; m < 33; ++m) s += zf[p * 33 + m] * in[I_FW1][m * 64 + o];
                h1[i] = sinf(in[I_FREQ][o] * s); }
            __syncthreads();
            for (int i = F.tid; i < 136 * 64; i += NTHR) { const int p = i >> 6, o = i & 63; float s = in[I_FB2][o];
                for (int m = 0; m < 64; ++m) s += h1[p * 64 + m] * in[I_FW2][m * 64 + o];
                h2T[o * 136 + p] = sinf(in[I_FREQ][o] * s); }
            __syncthreads();
            const int cg = F.tid & 127, pg = F.tid >> 7, c0 = 512 * cb + 4 * cg, p0 = 34 * pg;
            f32x4 acc[34];
#pragma unroll
            for (int i = 0; i < 34; ++i) acc[i] = (f32x4){0.f, 0.f, 0.f, 0.f};
            for (int o = 0; o < 64; ++o) { const f32x4 w = *(const GAS f32x4*)(in[I_FW3] + (size_t)o * 4096 + c0);
#pragma unroll
                for (int i = 0; i < 17; ++i) { const f32x2 hv = *(const LAS f32x2*)(h2T + o * 136 + p0 + 2 * i); acc[2 * i] += w * hv[0]; acc[2 * i + 1] += w * hv[1]; } }
            const int dir = c0 >> 11, d0 = c0 & 2047;
            const float dstep = ((-15.350567286626973f) - (-3.0701134573253945f)) / 2047.0f;
            float delta[4];
#pragma unroll
            for (int q = 0; q < 4; ++q) delta[q] = fabsf(-3.0701134573253945f + (float)(d0 + q) * dstep);
#pragma unroll
            for (int i = 0; i < 17; ++i) { const int gp = pbase + p0 + 2 * i; const bool lat = gp < SL; const int Lq = lat ? SL : CL, j = lat ? gp : gp - SL;
                const float t0 = (float)j / (float)(Lq - 1), t1 = (float)(j + 1) / (float)(Lq - 1);
#pragma unroll
                for (int q = 0; q < 4; ++q) { const unsigned w = pk2(acc[2 * i][q] * __expf(-t0 * delta[q]), acc[2 * i + 1][q] * __expf(-t1 * delta[q]));
                    bf16* dst = lat ? (bf16*)(F.ws + WS_KRN) + ((size_t)(d0 + q) * 2 + dir) * SL + j : (bf16*)(F.ws + WS_KRC) + ((size_t)(d0 + q) * 2 + dir) * CL + j;
                    *(unsigned*)dst = w; } }
            __syncthreads();
        }
    }
    {
        LAS float* scr = (LAS float*)(F.lds + F.wave * 8448);
        const int gw = F.c * NWAVES + F.wave, NGW = F.G * NWAVES;
        constexpr int N_IN = 32 * 192, N_SQ = 32 * 64, N_E = 1024, N_HEAD = N_IN + 3 * N_SQ, NITEMS = N_HEAD + 64 * 3 * N_E;
        for (int it = gw; it < NITEMS; it += NGW) {
            int r = it;
            if (r < N_IN) { p0_job(in[I_HWIN], 2048, 6144, (bf16*)(F.ws + WS_WIN), false, 0, r, scr, F.lane); continue; } r -= N_IN;
            if (r < N_SQ) { p0_job(in[I_HWOUT], 2048, 2048, (bf16*)(F.ws + WS_WOUT), false, 0, r, scr, F.lane); continue; } r -= N_SQ;
            if (r < N_SQ) { p0_job(in[I_SW1], 2048, 2048, (bf16*)(F.ws + WS_W12), true, 0, r, scr, F.lane); continue; } r -= N_SQ;
            if (r < N_SQ) { p0_job(in[I_SW2], 2048, 2048, (bf16*)(F.ws + WS_W12), true, 128, r, scr, F.lane); continue; } r -= N_SQ;
            const int le = r / (3 * N_E), q = r - le * 3 * N_E, which = q / N_E, idx = q - which * N_E;
            if (which == 0) p0_job(in[I_MGATE] + (size_t)le * 2048 * 1024, 2048, 1024, (bf16*)(F.ws + WS_WGU) + (size_t)le * 2048 * 2048, true, 0, idx, scr, F.lane);
            else if (which == 1) p0_job(in[I_MUP] + (size_t)le * 2048 * 1024, 2048, 1024, (bf16*)(F.ws + WS_WGU) + (size_t)le * 2048 * 2048, true, 128, idx, scr, F.lane);
            else p0_job(in[I_MDOWN] + (size_t)le * 1024 * 2048, 1024, 2048, (bf16*)(F.ws + WS_WD) + (size_t)le * 2048 * 1024, false, 0, idx, scr, F.lane);
        }
    }
}
struct Row { f32x4 v[8]; };
__device__ __forceinline__ void row_load(Row& r, const float* p, int lane) {
#pragma unroll
    for (int i = 0; i < 8; ++i) r.v[i] = *(const GAS f32x4*)(p + 4 * lane + 256 * i);
}
__device__ __forceinline__ float row_rstd(const Row& r) {
    float s = 0.f;
#pragma unroll
    for (int i = 0; i < 8; ++i) s += (r.v[i][0] * r.v[i][0] + r.v[i][1] * r.v[i][1]) + (r.v[i][2] * r.v[i][2] + r.v[i][3] * r.v[i][3]);
    return 1.0f / sqrtf(wave_sum(s) * (1.0f / D) + EPS);
}
__device__ __forceinline__ void row_norm_mod_store(const Row& r, float rstd, const float* g, const float* sh, const float* sc, bf16* o, int lane) {
#pragma unroll
    for (int i = 0; i < 8; ++i) { const int c = 4 * lane + 256 * i;
        const f32x4 gv = *(const GAS f32x4*)(g + c), sv = *(const GAS f32x4*)(sc + c), hv = *(const GAS f32x4*)(sh + c);
        const f32x4 y = (r.v[i] * rstd * gv) * (sv + 1.0f) + hv;
        u32x2 w; w.x = pk2(y[0], y[1]); w.y = pk2(y[2], y[3]); *(GAS u32x2*)(o + c) = w; }
}
__device__ __forceinline__ int moe_pos(const LAS int* rbfirst, int packed) { return 256 * rbfirst[packed >> 20] + (packed & 0xfffff); }
__device__ __forceinline__ void row_add_moe(Row& r, const float* gt, const bf16* eo, int p0, int p1, float g0, float g1, int lane) {
#pragma unroll
    for (int i = 0; i < 8; ++i) { const int c = 4 * lane + 256 * i;
        const u32x2 a = *(const GAS u32x2*)(eo + (size_t)p0 * D + c), b = *(const GAS u32x2*)(eo + (size_t)p1 * D + c); const f32x4 gv = *(const GAS f32x4*)(gt + c);
        f32x4 m; m[0] = g0 * bflo(a.x) + g1 * bflo(b.x); m[1] = g0 * bfhi(a.x) + g1 * bfhi(b.x); m[2] = g0 * bflo(a.y) + g1 * bflo(b.y); m[3] = g0 * bfhi(a.y) + g1 * bfhi(b.y);
        r.v[i] += gv * m; }
}
__device__ __forceinline__ void row_store(const Row& r, float* p, int lane) {
#pragma unroll
    for (int i = 0; i < 8; ++i) *(GAS f32x4*)(p + 4 * lane + 256 * i) = r.v[i];
}
__device__ __forceinline__ int moe_tables(Frame& F, int l) {
    LAS int* rb_e = (LAS int*)(F.lds + TAB_OFF); LAS int* rbfirst = rb_e + 168; LAS int* cnt = rbfirst + 33;
    __syncthreads();
    if (F.tid < 32) cnt[F.tid] = (int)xb_ld(F.ctl + CW_CNT + (l * 32 + F.tid) * 64);
    __syncthreads();
    if (F.tid == 0) { int a = 0; for (int e = 0; e < 32; ++e) { rbfirst[e] = a; const int n = (cnt[e] + 255) >> 8; for (int k = 0; k < n; ++k) rb_e[a + k] = e; a += n; } rbfirst[32] = a; }
    __syncthreads();
    return rbfirst[32];
}

__device__ __forceinline__ void p_norm1_l0(Frame& F) {
    const int gw = F.c * NWAVES + F.wave, NGW = F.G * NWAVES;
    for (int r = gw; r < TT; r += NGW) {
        const bool lat = r < TL; const float* src = lat ? F.in[I_X] + (size_t)r * D : F.in[I_CTX] + (size_t)(r - TL) * D; const float* mod = MODP(F, 0, lat ? (r >> 12) : 4);
        Row row; row_load(row, src, F.lane); const float rstd = row_rstd(row);
        row_norm_mod_store(row, rstd, F.in[I_NORMG], mod, mod + 2048, (bf16*)(F.ws + WS_U) + (size_t)r * D, F.lane);
    }
}
__device__ __forceinline__ void p_comb_norm1_l1(Frame& F) {
    moe_tables(F, 0);
    const LAS int* rbfirst = (const LAS int*)(F.lds + TAB_OFF) + 168;
    const int gw = F.c * NWAVES + F.wave, NGW = F.G * NWAVES;
    const int* tokpos = (const int*)(F.ws + WS_TOKPOS); const float* gates = (const float*)(F.ws + WS_GATE);
    for (int r = gw; r < TT; r += NGW) {
        const bool lat = r < TL; float* xp = lat ? F.out + (size_t)r * D : (float*)(F.ws + WS_XC) + (size_t)(r - TL) * D; const int mr = lat ? (r >> 12) : 4;
        Row row; row_load(row, xp, F.lane);
        const int p0 = moe_pos(rbfirst, tokpos[2 * r]), p1 = moe_pos(rbfirst, tokpos[2 * r + 1]);
        row_add_moe(row, MODP(F, 0, mr) + 10240, (const bf16*)(F.ws + WS_EO), p0, p1, gates[2 * r], gates[2 * r + 1], F.lane);
        row_store(row, xp, F.lane);
        const float rstd = row_rstd(row); const float* mod = MODP(F, 1, mr);
        row_norm_mod_store(row, rstd, F.in[I_NORMG] + 2 * D, mod, mod + 2048, (bf16*)(F.ws + WS_U) + (size_t)r * D, F.lane);
    }
}
__device__ __forceinline__ void p_final(Frame& F) {
    moe_tables(F, 1);
    const LAS int* rbfirst = (const LAS int*)(F.lds + TAB_OFF) + 168;
    const int gw = F.c * NWAVES + F.wave, NGW = F.G * NWAVES;
    const int* tokpos = (const int*)(F.ws + WS_TOKPOS); const float* gates = (const float*)(F.ws + WS_GATE);
    for (int r = gw; r < TL; r += NGW) {
        float* xp = F.out + (size_t)r * D;
        Row row; row_load(row, xp, F.lane);
        const int p0 = moe_pos(rbfirst, tokpos[2 * r]), p1 = moe_pos(rbfirst, tokpos[2 * r + 1]);
        row_add_moe(row, MODP(F, 1, r >> 12) + 10240, (const bf16*)(F.ws + WS_EO), p0, p1, gates[2 * r], gates[2 * r + 1], F.lane);
        const float rstd = row_rstd(row);
#pragma unroll
        for (int i = 0; i < 8; ++i) { const int c = 4 * F.lane + 256 * i; const f32x4 gv = *(const GAS f32x4*)(F.in[I_FINALG] + c); row.v[i] = row.v[i] * rstd * gv; }
        row_store(row, xp, F.lane);
    }
}

__device__ __forceinline__ void p_router(Frame& F, int l, int ntok) {
    constexpr int PITCH = 2050;
    LAS float* xt = (LAS float*)F.lds;
    LAS float* red = (LAS float*)F.lds;
    LAS float* lg = (LAS float*)(F.lds + 32768);
    const float* wg = F.in[I_MWG] + (size_t)l * 2048 * 4; const float* we = F.in[I_MWE] + (size_t)l * 2048 * 32;
    const float* g = F.in[I_NORMG] + (size_t)(l * 2 + 1) * D;
    int* list = (int*)(F.ws + WS_LIST); int* tokpos = (int*)(F.ws + WS_TOKPOS); float* gates = (float*)(F.ws + WS_GATE);
    const int ntile = ntok / 16;
    for (int tile = F.c; tile < ntile; tile += F.G) {
        const int t0 = tile * 16;
        __syncthreads();
#pragma unroll 1
        for (int q = 0; q < 2; ++q) { const int r = t0 + 2 * F.wave + q; const bool lat = r < TL;
            const float* xp = lat ? F.out + (size_t)r * D : (const float*)(F.ws + WS_XC) + (size_t)(r - TL) * D; const float* mod = MODP(F, l, lat ? (r >> 12) : 4);
            Row row; row_load(row, xp, F.lane); const float rstd = row_rstd(row);
            bf16* o = (bf16*)(F.ws + WS_U) + (size_t)r * D; LAS float* xr = xt + (2 * F.wave + q) * PITCH;
#pragma unroll
            for (int i = 0; i < 8; ++i) { const int c = 4 * F.lane + 256 * i;
                const f32x4 gv = *(const GAS f32x4*)(g + c), sv = *(const GAS f32x4*)(mod + 8192 + c), hv = *(const GAS f32x4*)(mod + 6144 + c);
                const f32x4 y = (row.v[i] * rstd * gv) * (sv + 1.0f) + hv;
                u32x2 w; w.x = pk2(y[0], y[1]); w.y = pk2(y[2], y[3]); *(GAS u32x2*)(o + c) = w;
                *(LAS f32x2*)(xr + c) = (f32x2){y[0], y[1]}; *(LAS f32x2*)(xr + c + 2) = (f32x2){y[2], y[3]}; } }
        __syncthreads();
        f32x4 a0 = {0.f, 0.f, 0.f, 0.f}, a1 = a0, a2 = a0;
        { const int tk = F.lane & 15, kq = F.lane >> 4, kb = 256 * F.wave + kq; const LAS float* ap = xt + tk * PITCH + kb;
          const bool v0 = tk < 4; const float* b0p = v0 ? wg + (size_t)kb * 4 + tk : we + (size_t)kb * 32 + (tk - 4);
          const float* b1p = we + (size_t)kb * 32 + 12 + tk;
          const bool v2 = tk < 4; const float* b2p = we + (size_t)kb * 32 + (v2 ? 28 + tk : 0);
          const int s0 = v0 ? 16 : 128;
#pragma unroll 8
          for (int ks = 0; ks < 64; ++ks) { const float av = ap[4 * ks]; const float w0 = b0p[(size_t)ks * s0], w1 = b1p[(size_t)ks * 128]; float w2 = b2p[(size_t)ks * 128]; w2 = v2 ? w2 : 0.f;
              a0 = __builtin_amdgcn_mfma_f32_16x16x4f32(av, w0, a0, 0, 0, 0); a1 = __builtin_amdgcn_mfma_f32_16x16x4f32(av, w1, a1, 0, 0, 0); a2 = __builtin_amdgcn_mfma_f32_16x16x4f32(av, w2, a2, 0, 0, 0); } }
        __syncthreads();
        { LAS float* rp = red + F.wave * 768;
#pragma unroll
          for (int j = 0; j < 4; ++j) { const int tk = 4 * (F.lane >> 4) + j; rp[tk * 48 + (F.lane & 15)] = a0[j]; rp[tk * 48 + 16 + (F.lane & 15)] = a1[j]; rp[tk * 48 + 32 + (F.lane & 15)] = a2[j]; } }
        __syncthreads();
        for (int i = F.tid; i < 768; i += NTHR) { float s = 0.f;
#pragma unroll
            for (int w = 0; w < 8; ++w) s += red[w * 768 + i];
            const int n = i % 48; s += n < 4 ? F.in[I_MBG][l * 4 + n] : (n < 36 ? F.in[I_MBE][l * 32 + n - 4] : 0.f); lg[i] = s; }
        __syncthreads();
        if (F.tid < 16) { const LAS float* q = lg + F.tid * 48; const int r = t0 + F.tid;
            int gi = 0; float gm = q[0];
#pragma unroll
            for (int k = 1; k < 4; ++k) if (q[k] > gm) { gm = q[k]; gi = k; }
            float gs = 0.f;
#pragma unroll
            for (int k = 0; k < 4; ++k) gs += __expf(q[k] - gm);
            const float ptop = 1.0f / gs;
            const LAS float* e = q + 4 + 8 * gi; int i0 = 0; float v0 = e[0];
#pragma unroll
            for (int k = 1; k < 8; ++k) if (e[k] > v0) { v0 = e[k]; i0 = k; }
            int i1 = -1; float v1 = -3.0e38f;
#pragma unroll
            for (int k = 0; k < 8; ++k) if (k != i0 && e[k] > v1) { v1 = e[k]; i1 = k; }
            const float x1 = __expf(v1 - v0), den = 1.0f / (1.0f + x1);
            const int e0 = gi * 8 + i0, e1 = gi * 8 + i1;
            const unsigned s0 = xb_add(F.ctl + CW_CNT + (l * 32 + e0) * 64, 1u), s1 = xb_add(F.ctl + CW_CNT + (l * 32 + e1) * 64, 1u);
            list[(size_t)e0 * TT + s0] = r; list[(size_t)e1 * TT + s1] = r;
            tokpos[2 * r] = (e0 << 20) | (int)s0; tokpos[2 * r + 1] = (e1 << 20) | (int)s1;
            gates[2 * r] = ptop * den; gates[2 * r + 1] = ptop * x1 * den; }
    }
}
constexpr int CV_KR = 0, CV_KRC = 16384, CV_ZERO = 17408, CV_V = 17920, CV_VB = 10272, CV_VJ = 640, CV_VC = 59008, CV_VCB = 544, CV_RED = 61184;
__device__ __forceinline__ float conv3(float zm, float z0, float zp, float w0, float w1, float w2, float cb) { return zm * w0 + z0 * w1 + zp * w2 + cb; }
template <int NV>
__device__ __forceinline__ void load_conv3(const bf16* zrow, int col0, int t0, int Lseq, float w0, float w1, float w2, float cb, float* out) {
    float z[8 * NV + 2];
    z[0] = t0 > 0 ? bf2f(zrow[col0 - 1]) : 0.f;
    z[8 * NV + 1] = (t0 + 8 * NV < Lseq) ? bf2f(zrow[col0 + 8 * NV]) : 0.f;
#pragma unroll
    for (int i = 0; i < NV; ++i) { const u32x4 w = *(const GAS u32x4*)(zrow + col0 + 8 * i);
        z[1 + 8 * i] = bflo(w.x); z[2 + 8 * i] = bfhi(w.x); z[3 + 8 * i] = bflo(w.y); z[4 + 8 * i] = bfhi(w.y); z[5 + 8 * i] = bflo(w.z); z[6 + 8 * i] = bfhi(w.z); z[7 + 8 * i] = bflo(w.w); z[8 + 8 * i] = bfhi(w.w); }
#pragma unroll
    for (int i = 0; i < 8 * NV; ++i) out[i] = conv3(z[i], z[i + 1], z[i + 2], w0, w1, w2, cb);
}
#define CV_MMA8(acc, d, bfr) do { \
    unsigned o_[7]; _Pragma("unroll") for (int m_ = 0; m_ < 7; ++m_) o_[m_] = __builtin_amdgcn_alignbit(d[m_ + 1], d[m_], 16); \
    _Pragma("unroll") for (int q_ = 0; q_ < 4; ++q_) { \
        u32x4 fe_ = {d[4 - q_], d[5 - q_], d[6 - q_], d[7 - q_]}; u32x4 fo_ = {o_[3 - q_], o_[4 - q_], o_[5 - q_], o_[6 - q_]}; \
        acc[2 * q_] = __builtin_amdgcn_mfma_f32_16x16x32_bf16(__builtin_bit_cast(bf16x8, fe_), bfr, acc[2 * q_], 0, 0, 0); \
        acc[2 * q_ + 1] = __builtin_amdgcn_mfma_f32_16x16x32_bf16(__builtin_bit_cast(bf16x8, fo_), bfr, acc[2 * q_ + 1], 0, 0, 0); } } while (0)

__device__ __forceinline__ void p_conv(Frame& F) {
    LAS unsigned char* lds = F.lds;
    const bf16* ZT = (const bf16*)(F.ws + WS_ZT); bf16* YXT = (bf16*)(F.ws + WS_YXT);
    const float* cw = F.in[I_HCW]; const float* cbp = F.in[I_HCB];
    const int tid = F.tid, lane = F.lane, w = F.wave, g = w & 1, q = w >> 1, r = lane & 15, h4 = lane >> 4, Isub = r >> 2, bb = r & 3;
    for (int i = tid; i < 128; i += NTHR) ((LAS unsigned*)(lds + CV_ZERO))[i] = 0u;
    for (int d = F.c; d < D; d += F.G) {
        __syncthreads();
        float nl = 0.f, nc = 0.f;
        { const bf16* kn = (const bf16*)(F.ws + WS_KRN) + (size_t)d * 2 * SL; LAS bf16* KR = (LAS bf16*)(lds + CV_KR);
          const u32x4 fw = *(const GAS u32x4*)(kn + 8 * tid), bw = *(const GAS u32x4*)(kn + SL + 8 * tid);
          const unsigned fwv[4] = {fw.x, fw.y, fw.z, fw.w}, bwv[4] = {bw.x, bw.y, bw.z, bw.w};
#pragma unroll
          for (int e = 0; e < 8; ++e) { const int j = 8 * tid + e; const unsigned short fv = (unsigned short)(fwv[e >> 1] >> (16 * (e & 1))), bv = (unsigned short)(bwv[e >> 1] >> (16 * (e & 1)));
              KR[SL - j] = fv; nl += fabsf(bf2f(fv));
              if (j > 0) { KR[SL + j] = bv; nl += fabsf(bf2f(bv)); } }
          if (tid == 0) KR[0] = 0;
          if (tid < 64) { const bf16* kc = (const bf16*)(F.ws + WS_KRC) + (size_t)d * 2 * CL; LAS bf16* KC = (LAS bf16*)(lds + CV_KRC); const int dirn = tid >> 5, j0 = 8 * (tid & 31);
              const u32x4 cwd = *(const GAS u32x4*)(kc + dirn * CL + j0); const unsigned cv4[4] = {cwd.x, cwd.y, cwd.z, cwd.w};
#pragma unroll
              for (int e = 0; e < 8; ++e) { const int j = j0 + e; const unsigned short v = (unsigned short)(cv4[e >> 1] >> (16 * (e & 1)));
                  if (dirn == 0) { KC[CL - j] = v; nc += fabsf(bf2f(v)); } else if (j > 0) { KC[CL + j] = v; nc += fabsf(bf2f(v)); } }
              if (tid == 0) KC[0] = 0; } }
        { const int chv = 4096 + d, chx = 2048 + d;
          const float v0 = cw[chv], v1 = cw[6144 + chv], v2 = cw[12288 + chv], vb = cbp[chv], x0 = cw[chx], x1 = cw[6144 + chx], x2 = cw[12288 + chx], xb = cbp[chx];
          { const int b = tid >> 7, t0 = (tid & 127) * 32, col0 = b * SL + t0; float zv[32], zx[32];
            load_conv3<4>(ZT + (size_t)chv * ZLD, col0, t0, SL, v0, v1, v2, vb, zv); load_conv3<4>(ZT + (size_t)chx * ZLD, col0, t0, SL, x0, x1, x2, xb, zx);
            LAS unsigned char* dst = lds + CV_V + b * CV_VB + (t0 >> 8) * CV_VJ + (t0 & 255) * 2;
#pragma unroll
            for (int i = 0; i < 4; ++i) { u32x4 o; o.x = pk2(zv[8 * i] * zx[8 * i], zv[8 * i + 1] * zx[8 * i + 1]); o.y = pk2(zv[8 * i + 2] * zx[8 * i + 2], zv[8 * i + 3] * zx[8 * i + 3]);
                o.z = pk2(zv[8 * i + 4] * zx[8 * i + 4], zv[8 * i + 5] * zx[8 * i + 5]); o.w = pk2(zv[8 * i + 6] * zx[8 * i + 6], zv[8 * i + 7] * zx[8 * i + 7]); *(LAS u32x4*)(dst + 16 * i) = o; } }
          if (tid < 128) { const int b = tid >> 5, t0 = (tid & 31) * 8, col0 = TL + b * CL + t0; float zv[8], zx[8];
            load_conv3<1>(ZT + (size_t)chv * ZLD, col0, t0, CL, v0, v1, v2, vb, zv); load_conv3<1>(ZT + (size_t)chx * ZLD, col0, t0, CL, x0, x1, x2, xb, zx);
            u32x4 o; o.x = pk2(zv[0] * zx[0], zv[1] * zx[1]); o.y = pk2(zv[2] * zx[2], zv[3] * zx[3]); o.z = pk2(zv[4] * zx[4], zv[5] * zx[5]); o.w = pk2(zv[6] * zx[6], zv[7] * zx[7]);
            *(LAS u32x4*)(lds + CV_VC + b * CV_VCB + t0 * 2) = o; } }
        nl = wave_sum(nl); nc = wave_sum(nc);
        if (lane == 0) { ((LAS float*)(lds + CV_RED))[w] = nl; ((LAS float*)(lds + CV_RED))[8 + w] = nc; }
        __syncthreads();
        float inv_l = 0.f, inv_c = ((LAS float*)(lds + CV_RED))[8];
#pragma unroll
        for (int i = 0; i < 8; ++i) inv_l += ((LAS float*)(lds + CV_RED))[i];
        inv_l = 1.0f / inv_l; inv_c = 1.0f / inv_c;
        const float skip = F.in[I_SKIP][d];
        const float c0 = cw[d], c1 = cw[6144 + d], c2 = cw[12288 + d], cb0 = cbp[d];
        {
            f32x4 acc[8];
#pragma unroll
            for (int i = 0; i < 8; ++i) acc[i] = (f32x4){0.f, 0.f, 0.f, 0.f};
#pragma unroll 1
            for (int dl = 4 * q - 15; dl <= 4 * q + 3; ++dl) {
                const int J = 4 * q + Isub - dl; const bool valid = (J >= 0) && (J <= 15);
                const LAS unsigned char* bp = valid ? lds + CV_V + bb * CV_VB + J * CV_VJ + h4 * 16 : lds + CV_ZERO + h4 * 16;
                const int xb = SL - 256 * dl - 128 * g - 8 * r + 8 * h4;
                const LAS unsigned char* ap = lds + CV_KR + (xb - 8) * 2;
#pragma unroll
                for (int kk = 0; kk < 8; ++kk) {
                    const u32x4 ca = *(const LAS u32x4*)(ap + 64 * kk), cbv = *(const LAS u32x4*)(ap + 64 * kk + 16);
                    const bf16x8 bfr = *(const LAS bf16x8*)(bp + 64 * kk);
                    const unsigned dd[8] = {ca.x, ca.y, ca.z, ca.w, cbv.x, cbv.y, cbv.z, cbv.w};
                    CV_MMA8(acc, dd, bfr);
                }
            }
            const int I = 4 * q + Isub, t0 = 256 * I + 128 * g + 32 * h4, col0 = bb * SL + t0;
            float x0c[32]; load_conv3<4>(ZT + (size_t)d * ZLD, col0, t0, SL, c0, c1, c2, cb0, x0c);
            const LAS unsigned char* vp = lds + CV_V + bb * CV_VB + I * CV_VJ + (128 * g + 32 * h4) * 2;
#pragma unroll
            for (int i = 0; i < 4; ++i) { const u32x4 vv = *(const LAS u32x4*)(vp + 16 * i); const unsigned vw[4] = {vv.x, vv.y, vv.z, vv.w}; unsigned ow[4];
#pragma unroll
                for (int p = 0; p < 4; ++p) { const int e0 = 8 * i + 2 * p, e1 = e0 + 1;
                    const float y0 = (acc[e0 & 7][e0 >> 3] * inv_l + skip * bflo(vw[p])) * x0c[e0], y1 = (acc[e1 & 7][e1 >> 3] * inv_l + skip * bfhi(vw[p])) * x0c[e1];
                    ow[p] = pk2(y0, y1); }
                *(GAS u32x4*)(YXT + (size_t)d * ZLD + col0 + 8 * i) = (u32x4){ow[0], ow[1], ow[2], ow[3]}; }
        }
        if (w < 2) {
            f32x4 acc[8];
#pragma unroll
            for (int i = 0; i < 8; ++i) acc[i] = (f32x4){0.f, 0.f, 0.f, 0.f};
            const bool valid = Isub == 0;
            const LAS unsigned char* bp = valid ? lds + CV_VC + bb * CV_VCB + h4 * 16 : lds + CV_ZERO + h4 * 16;
            const int xb = CL - 128 * g - 8 * r + 8 * h4;
            const LAS unsigned char* ap = lds + CV_KRC + (xb - 8) * 2;
#pragma unroll
            for (int kk = 0; kk < 8; ++kk) {
                const u32x4 ca = *(const LAS u32x4*)(ap + 64 * kk), cbv = *(const LAS u32x4*)(ap + 64 * kk + 16);
                const bf16x8 bfr = *(const LAS bf16x8*)(bp + 64 * kk);
                const unsigned dd[8] = {ca.x, ca.y, ca.z, ca.w, cbv.x, cbv.y, cbv.z, cbv.w};
                CV_MMA8(acc, dd, bfr);
            }
            if (valid) {
                const int t0 = 128 * g + 32 * h4, col0 = TL + bb * CL + t0;
                float x0c[32]; load_conv3<4>(ZT + (size_t)d * ZLD, col0, t0, CL, c0, c1, c2, cb0, x0c);
                const LAS unsigned char* vp = lds + CV_VC + bb * CV_VCB + t0 * 2;
#pragma unroll
                for (int i = 0; i < 4; ++i) { const u32x4 vv = *(const LAS u32x4*)(vp + 16 * i); const unsigned vw[4] = {vv.x, vv.y, vv.z, vv.w}; unsigned ow[4];
#pragma unroll
                    for (int p = 0; p < 4; ++p) { const int e0 = 8 * i + 2 * p, e1 = e0 + 1;
                        const float y0 = (acc[e0 & 7][e0 >> 3] * inv_c + skip * bflo(vw[p])) * x0c[e0], y1 = (acc[e1 & 7][e1 >> 3] * inv_c + skip * bfhi(vw[p])) * x0c[e1];
                        ow[p] = pk2(y0, y1); }
                    *(GAS u32x4*)(YXT + (size_t)d * ZLD + col0 + 8 * i) = (u32x4){ow[0], ow[1], ow[2], ow[3]}; }
            }
        }
    }
}

__device__ __forceinline__ void p_transpose_yx(Frame& F) {
    const bf16* src = (const bf16*)(F.ws + WS_YXT); bf16* dst = (bf16*)(F.ws + WS_YX);
    LAS unsigned short* scr = (LAS unsigned short*)(F.lds + F.wave * 8704);
    const int gw = F.c * NWAVES + F.wave, NGW = F.G * NWAVES, lane = F.lane;
    constexpr int NT_T = TT / 64, NTILES = (D / 64) * NT_T;
    for (int it = gw; it < NTILES; it += NGW) {
        const int cb = it / NT_T, tb = it - cb * NT_T, c0 = 64 * cb, tk0 = 64 * tb;
        u32x4 v[8];
#pragma unroll
        for (int i = 0; i < 8; ++i) v[i] = *(const GAS u32x4*)(src + (size_t)(c0 + 8 * i + (lane >> 3)) * ZLD + tk0 + 8 * (lane & 7));
#pragma unroll
        for (int i = 0; i < 8; ++i) { LAS unsigned* s = (LAS unsigned*)(scr + (8 * i + (lane >> 3)) * 68 + 8 * (lane & 7)); s[0] = v[i].x; s[1] = v[i].y; s[2] = v[i].z; s[3] = v[i].w; }
        LDS_WAIT(); asm volatile("" ::: "memory");
#pragma unroll
        for (int j = 0; j < 8; ++j) { const int tk = 8 * j + (lane >> 3), cc = 8 * (lane & 7); unsigned short e[8];
#pragma unroll
            for (int k = 0; k < 8; ++k) e[k] = scr[(cc + k) * 68 + tk];
            u32x4 o; o.x = e[0] | ((unsigned)e[1] << 16); o.y = e[2] | ((unsigned)e[3] << 16); o.z = e[4] | ((unsigned)e[5] << 16); o.w = e[6] | ((unsigned)e[7] << 16);
            *(GAS u32x4*)(dst + (size_t)(tk0 + tk) * D + c0 + cc) = o; }
        LDS_WAIT(); asm volatile("" ::: "memory");
    }
}
constexpr int S5_HS = 9216;
__device__ __forceinline__ size_t s5_row(int ti, int tau, int b, int dir) {
    if (ti < 8) { const int pos = 32 * ti + tau; return (size_t)(TL + b * CL + (dir ? CL - 1 - pos : pos)); }
    const int pos = 32 * (ti - 8) + tau; return (size_t)(b * SL + (dir ? SL - 1 - pos : pos));
}
__device__ __forceinline__ void p_s5(Frame& F) {
    if (F.wave >= 4) return;
    const int lane = F.lane, w = F.wave;
    const bf16* U = (const bf16*)(F.ws + WS_U);
    LAS unsigned char* Hs = F.lds + w * S5_HS;
    for (int sq = F.c * 4 + w; sq < 1024; sq += F.G * 4) {
        const int g = sq & 127, db = sq >> 7, dir = db >> 2, b = db & 3, pg = dir * 128 + g;
        const float step = __expf(F.in[I_SLOG][pg]);
        float lr, li;
        { const float ar = F.in[I_SARE][pg * 64 + lane], ai = F.in[I_SAIM][pg * 64 + lane]; const float er = expf(ar * step); float sn, cs; sincosf(ai * step, &sn, &cs); lr = er * cs; li = er * sn; }
        bf16x8 Bf[2][2];
#pragma unroll
        for (int ph = 0; ph < 2; ++ph) { const int p = 32 * ph + (lane & 31), hh = lane >> 5;
            const float ar = F.in[I_SARE][pg * 64 + p], ai = F.in[I_SAIM][pg * 64 + p]; const float er = expf(ar * step); float sn, cs; sincosf(ai * step, &sn, &cs);
            const float nr = er * cs - 1.0f, ni = er * sn, dn = 1.0f / (ar * ar + ai * ai); const float cr = (nr * ar + ni * ai) * dn, ci = (ni * ar - nr * ai) * dn;
            const float* br = F.in[I_SBRE] + ((size_t)pg * 64 + p) * 16 + 8 * hh; const float* bi = F.in[I_SBIM] + ((size_t)pg * 64 + p) * 16 + 8 * hh;
            unsigned wr_[4], wi_[4];
#pragma unroll
            for (int j = 0; j < 4; ++j) { const float r0 = br[2 * j], r1 = br[2 * j + 1], i0 = bi[2 * j], i1 = bi[2 * j + 1];
                wr_[j] = pk2(cr * r0 - ci * i0, cr * r1 - ci * i1); wi_[j] = pk2(cr * i0 + ci * r0, cr * i1 + ci * r1); }
            Bf[0][ph] = __builtin_bit_cast(bf16x8, (u32x4){wr_[0], wr_[1], wr_[2], wr_[3]}); Bf[1][ph] = __builtin_bit_cast(bf16x8, (u32x4){wi_[0], wi_[1], wi_[2], wi_[3]}); }
        bf16x8 Cf[4];
#pragma unroll
        for (int ks = 0; ks < 4; ++ks) { const int hp = lane & 15, p0 = 16 * ks + 4 * (lane >> 4);
            const float* crp = F.in[I_SCRE] + ((size_t)pg * 16 + hp) * 64 + p0; const float* cip = F.in[I_SCIM] + ((size_t)pg * 16 + hp) * 64 + p0;
            Cf[ks] = __builtin_bit_cast(bf16x8, (u32x4){pk2(crp[0], -cip[0]), pk2(crp[1], -cip[1]), pk2(crp[2], -cip[2]), pk2(crp[3], -cip[3])}); }
        bf16* Yp = (bf16*)(F.ws + (dir ? WS_YB : WS_YF));
        float hr = 0.f, hi = 0.f;
#define urow(ti_, tau_) s5_row((ti_), (tau_), b, dir)
        const int tau_a = lane & 31, coff = 16 * g + 8 * (lane >> 5);
        bf16x8 u0 = *(const GAS bf16x8*)(U + urow(0, tau_a) * D + coff), u1 = *(const GAS bf16x8*)(U + urow(1, tau_a) * D + coff);
#pragma unroll 1
        for (int ti = 0; ti < 136; ++ti) {
            const bf16x8 u2 = *(const GAS bf16x8*)(U + urow(ti + 2 < 136 ? ti + 2 : 135, tau_a) * D + coff);
            f32x16 z16;
#pragma unroll
            for (int i = 0; i < 16; ++i) z16[i] = 0.f;
            f32x16 aR0 = __builtin_amdgcn_mfma_f32_32x32x16_bf16(u0, Bf[0][0], z16, 0, 0, 0), aR1 = __builtin_amdgcn_mfma_f32_32x32x16_bf16(u0, Bf[0][1], z16, 0, 0, 0);
            f32x16 aI0 = __builtin_amdgcn_mfma_f32_32x32x16_bf16(u0, Bf[1][0], z16, 0, 0, 0), aI1 = __builtin_amdgcn_mfma_f32_32x32x16_bf16(u0, Bf[1][1], z16, 0, 0, 0);
            float bur[32], bui[32];
#pragma unroll
            for (int r = 0; r < 16; ++r) {
                const float fa = aR0[r], fb = aR1[r], fc = aI0[r], fd = aI1[r];
                auto sr = __builtin_amdgcn_permlane32_swap(__float_as_uint(fa), __float_as_uint(fb), false, false);
                auto si = __builtin_amdgcn_permlane32_swap(__float_as_uint(fc), __float_as_uint(fd), false, false);
                const unsigned sr0 = sr[0], sr1 = sr[1], si0 = si[0], si1 = si[1];
                const int tA = (r & 3) + 8 * (r >> 2);
                bur[tA] = __uint_as_float(sr0); bur[tA + 4] = __uint_as_float(sr1); bui[tA] = __uint_as_float(si0); bui[tA + 4] = __uint_as_float(si1); }
            const bool out_tile = ti >= 8;
#pragma unroll
            for (int tau = 0; tau < 32; ++tau) {
                const float t1 = __builtin_fmaf(lr, hr, bur[tau]), t2 = __builtin_fmaf(lr, hi, bui[tau]);
                const float nhr = __builtin_fmaf(-li, hi, t1), nhi = __builtin_fmaf(li, hr, t2);
                hr = nhr; hi = nhi;
                if (out_tile) *(LAS unsigned*)(Hs + tau * 288 + lane * 4) = pg8::cvt_pk_bf16(hr, hi);
            }
            if (out_tile) {
                asm volatile("s_waitcnt lgkmcnt(0)" ::: "memory");
#pragma unroll
                for (int mt = 0; mt < 2; ++mt) { f32x4 ay = {0.f, 0.f, 0.f, 0.f};
#pragma unroll
                    for (int ks = 0; ks < 4; ++ks) { const bf16x8 hf = *(const LAS bf16x8*)(Hs + (16 * mt + (lane & 15)) * 288 + (32 * ks + 8 * (lane >> 4)) * 2);
                        ay = __builtin_amdgcn_mfma_f32_16x16x32_bf16(Cf[ks], hf, ay, 0, 0, 0); }
                    u32x2 o; o.x = pk2(ay[0], ay[1]); o.y = pk2(ay[2], ay[3]);
                    *(GAS u32x2*)(Yp + urow(ti, 16 * mt + (lane & 15)) * D + 16 * g + 4 * (lane >> 4)) = o; }
                asm volatile("s_waitcnt lgkmcnt(0)" ::: "memory");
            }
            u0 = u1; u1 = u2;
        }
#undef urow
    }
}
__device__ __forceinline__ float gelu_tanh(float x) { const float u = 0.7978845608028654f * (x + 0.044715f * x * x * x); const float e = __expf(2.0f * u); const float th = 1.0f - 2.0f / (e + 1.0f); return 0.5f * x * (1.0f + th); }
__device__ __forceinline__ void p_s5_gelu(Frame& F) {
    const bf16* U = (const bf16*)(F.ws + WS_U); const bf16* YF = (const bf16*)(F.ws + WS_YF); const bf16* YB = (const bf16*)(F.ws + WS_YB); bf16* Gb = (bf16*)(F.ws + WS_G);
    const float* dsk = F.in[I_SD];
    const size_t n8 = (size_t)TL * D / 8, stride = (size_t)F.G * NTHR;
    for (size_t i = (size_t)F.c * NTHR + F.tid; i < n8; i += stride) {
        const u32x4 u = *(const GAS u32x4*)(U + 8 * i), a = *(const GAS u32x4*)(YF + 8 * i), b = *(const GAS u32x4*)(YB + 8 * i);
        const int c = (int)((8 * i) & 2047); const f32x4 d0 = *(const GAS f32x4*)(dsk + c), d1 = *(const GAS f32x4*)(dsk + c + 4);
        const unsigned uw[4] = {u.x, u.y, u.z, u.w}, aw[4] = {a.x, a.y, a.z, a.w}, bw[4] = {b.x, b.y, b.z, b.w}; const float dv[8] = {d0[0], d0[1], d0[2], d0[3], d1[0], d1[1], d1[2], d1[3]}; unsigned ow[4];
#pragma unroll
        for (int p = 0; p < 4; ++p) { const float y0 = dv[2 * p] * bflo(uw[p]) + bflo(aw[p]) + bflo(bw[p]), y1 = dv[2 * p + 1] * bfhi(uw[p]) + bfhi(aw[p]) + bfhi(bw[p]);
            ow[p] = pk2(gelu_tanh(y0), gelu_tanh(y1)); }
        *(GAS u32x4*)(Gb + 8 * i) = (u32x4){ow[0], ow[1], ow[2], ow[3]};
    }
}
#ifndef MK_N_LAUNCHES
#define MK_N_LAUNCHES 1
#endif
constexpr int N_PHASES = 17;

__device__ __forceinline__ void moe_rowtab(Frame& F, int nrb) {
    const LAS int* rb_e = (const LAS int*)(F.lds + TAB_OFF); const LAS int* rbfirst = rb_e + 168; const LAS int* cnt = rbfirst + 33;
    LAS unsigned* rowtab = (LAS unsigned*)(F.lds + ROWTAB_OFF); const int* list = (const int*)(F.ws + WS_LIST);
    for (int i = 0; i < 8; ++i) { const int L = i * F.G + F.c; if (L >= nrb * 8) break;
        const int rbi = L >> 3, e = rb_e[rbi], rbl = rbi - rbfirst[e];
        if (F.tid < 256) { const int slot = rbl * 256 + F.tid; const int tok = slot < cnt[e] ? list[(size_t)e * TT + slot] : 0; rowtab[i * 256 + F.tid] = (unsigned)tok * (unsigned)(D * 2); } }
    __syncthreads();
}

__global__ void __launch_bounds__(NTHR, 2) mega_fwd(Params P) {
    extern __shared__ __attribute__((aligned(16))) unsigned char lds_raw[];
    Frame F;
    F.lds = (LAS unsigned char*)lds_raw; F.ws = P.ws; F.ctl = (unsigned*)(P.ws + WS_CTL); F.in = P.in; F.out = P.out;
    F.tid = threadIdx.x; F.lane = F.tid & 63; F.wave = __builtin_amdgcn_readfirstlane(F.tid >> 6); F.G = gridDim.x; F.c = blockIdx.x;
    volatile LAS unsigned* MISC = (volatile LAS unsigned*)(F.lds + MISC_OFF);
    if (F.tid < 4) MISC[F.tid] = 0u;
    __syncthreads();
    XcdBarrier bar; bar.bar = F.ctl + CW_BAR; bar.x = 0; bar.st = MISC;
    if (MK_N_LAUNCHES == 1) bar = xcd_barrier_post(F.ctl + CW_BAR, MISC);
    const int lo = P.ph_lo, hi = P.ph_hi;
#define IN(k) (lo <= (k) && (k) < hi)
#define SEAM(k) do { if (IN(k) && IN((k) + 1)) xcd_barrier(bar); } while (0)
    const size_t TS2048 = (size_t)256 * 2048 * 2, TS1024 = (size_t)256 * 1024 * 2;

    if (IN(0)) { p0_prologue(F); } SEAM(0);
    if (IN(1)) { p_norm1_l0(F); } SEAM(1);
    if (IN(2)) {
        pg8::DenseOrder S; S.init(F.ws + WS_WIN, F.ws + WS_U, 6144, TT, 2048, F.G, F.c);
        pg8::EpiZT E{(bf16*)(F.ws + WS_ZT), ZLD, F.in[I_HBIN]};
        pg8::gemm_phase<pg8::EpiZT, pg8::DenseOrder, false>(F.lds, 2048, S, E, nullptr);
    } SEAM(2);
    if (IN(3)) { p_conv(F); } SEAM(3);
    if (IN(4)) { p_transpose_yx(F); } SEAM(4);
    if (IN(5)) {
        pg8::DenseOrder S; S.init(F.ws + WS_YX, F.ws + WS_WOUT, TT, 2048, 2048, F.G, F.c);
        pg8::EpiRes E{F.in[I_X], F.out, MODP(F, 0, 0) + 4096, F.in[I_CTX], (float*)(F.ws + WS_XC), MODP(F, 0, 4) + 4096, 12288, F.in[I_HBOUT]};
        pg8::gemm_phase<pg8::EpiRes, pg8::DenseOrder, false>(F.lds, 2048, S, E, nullptr);
    } SEAM(5);
#define MOE_PHASES(l, P_R, P_GU, P_DN, NTOK) \
    if (IN(P_R)) { p_router(F, (l), (NTOK)); } SEAM(P_R); \
    if (IN(P_GU)) { const int nrb = moe_tables(F, (l)); moe_rowtab(F, nrb); \
        pg8::MoeOrder S{(const char*)(F.ws + WS_U), (const char*)(F.ws + WS_WGU) + (size_t)(l) * 32 * 2048 * 2048 * 2, (const LAS int*)(F.lds + TAB_OFF), nrb, 8, F.G, F.c, 0, TS2048, (size_t)2048 * 2048 * 2, true}; \
        pg8::EpiGU E{(bf16*)(F.ws + WS_H), 1024}; \
        pg8::gemm_phase<pg8::EpiGU, pg8::MoeOrder, true>(F.lds, 2048, S, E, (const LAS unsigned*)(F.lds + ROWTAB_OFF)); } SEAM(P_GU); \
    if (IN(P_DN)) { const int nrb = moe_tables(F, (l)); \
        pg8::MoeOrder S{(const char*)(F.ws + WS_H), (const char*)(F.ws + WS_WD) + (size_t)(l) * 32 * 2048 * 1024 * 2, (const LAS int*)(F.lds + TAB_OFF), nrb, 8, F.G, F.c, TS1024, TS1024, (size_t)2048 * 1024 * 2, false}; \
        pg8::EpiBf E{(bf16*)(F.ws + WS_EO), 2048}; \
        pg8::gemm_phase<pg8::EpiBf, pg8::MoeOrder, false>(F.lds, 1024, S, E, nullptr); } SEAM(P_DN);
    MOE_PHASES(0, 6, 7, 8, TT)
    if (IN(9)) { p_comb_norm1_l1(F); } SEAM(9);
    if (IN(10)) { p_s5(F); } SEAM(10);
    if (IN(11)) { p_s5_gelu(F); } SEAM(11);
    if (IN(12)) {
        pg8::DenseOrder S; S.init(F.ws + WS_G, F.ws + WS_W12, TL, 4096, 2048, F.G, F.c);
        pg8::EpiGlu E{F.out, MODP(F, 1, 0) + 4096, 12288, F.in[I_SB1], F.in[I_SB2]};
        pg8::gemm_phase<pg8::EpiGlu, pg8::DenseOrder, false>(F.lds, 2048, S, E, nullptr);
    } SEAM(12);
    MOE_PHASES(1, 13, 14, 15, TL)
    if (IN(16)) { p_final(F); }
#undef IN
#undef SEAM
}

extern "C" void kernel_launch(void* const* d_in, const int* in_sizes, int n_in, void* d_out, int out_size, void* d_ws, size_t ws_size, hipStream_t stream) {
    static int grid = 0;
    if (grid == 0) {
        if (n_in != 40 || out_size != TL * D || ws_size < WS_END) { fprintf(stderr, "kernel_launch: unexpected shapes (n_in %d, out %d, ws %zu)\n", n_in, out_size, ws_size); grid = -1; return; }
        int dev = 0, cus = 0, per_cu = 0;
        if (hipGetDevice(&dev) != hipSuccess || hipDeviceGetAttribute(&cus, hipDeviceAttributeMultiprocessorCount, dev) != hipSuccess) { grid = -1; return; }
        if (hipFuncSetAttribute((const void*)mega_fwd, hipFuncAttributeMaxDynamicSharedMemorySize, LDS_BYTES) != hipSuccess) { fprintf(stderr, "kernel_launch: hipFuncSetAttribute failed\n"); grid = -1; return; }
        if (hipOccupancyMaxActiveBlocksPerMultiprocessor(&per_cu, (const void*)mega_fwd, NTHR, LDS_BYTES) != hipSuccess || per_cu < 1) { fprintf(stderr, "kernel_launch: occupancy query reports %d blocks per CU\n", per_cu); }
        (void)hipGetLastError();
        grid = cus;
    }
    if (grid < 0) return;
    (void)hipMemsetAsync((char*)d_ws + WS_CTL, 0, CTL_BYTES, stream);
    Params p{};
    for (int i = 0; i < 40; ++i) p.in[i] = (const float*)d_in[i];
    p.out = (float*)d_out; p.ws = (unsigned char*)d_ws;
#if MK_N_LAUNCHES == 1
    p.ph_lo = 0; p.ph_hi = N_PHASES;
    hipLaunchKernelGGL(mega_fwd, dim3(grid), dim3(NTHR), LDS_BYTES, stream, p);
#else
    for (int k = 0; k < N_PHASES; ++k) { p.ph_lo = k; p.ph_hi = k + 1; hipLaunchKernelGGL(mega_fwd, dim3(grid), dim3(NTHR), LDS_BYTES, stream, p); }
#endif
}
```

```cpp
#define MK_N_LAUNCHES 1
#include <hip/hip_runtime.h>
#include <cstdio>
#include <cstdint>

#define LAS __attribute__((address_space(3)))
#define GAS __attribute__((address_space(1)))
typedef unsigned short bf16;
typedef short bf16x8 __attribute__((ext_vector_type(8)));
typedef float f32x4 __attribute__((ext_vector_type(4)));
typedef float f32x2 __attribute__((ext_vector_type(2)));
typedef float f32x16 __attribute__((ext_vector_type(16)));
typedef unsigned u32x4 __attribute__((ext_vector_type(4)));
typedef unsigned u32x2 __attribute__((ext_vector_type(2)));

constexpr int D = 2048, NB = 4, SL = 4096, CL = 256, TL = NB * SL  , TC = NB * CL  , TT = TL + TC  ;
constexpr int NE = 32, DE = 1024, NRB_MAX = 168, ZLD = TT;
constexpr float EPS = 1e-6f;
constexpr int NWAVES = 8, NTHR = 512;

constexpr size_t MiB = 1u << 20;
constexpr size_t WS_CTL = 0, CTL_BYTES = 1 * MiB;
constexpr size_t WS_MOD = 1 * MiB;
constexpr size_t WS_LIST = 2 * MiB;
constexpr size_t WS_TOKPOS = 5 * MiB;
constexpr size_t WS_GATE = 5 * MiB + 512 * 1024;
constexpr size_t WS_KRN = 6 * MiB;
constexpr size_t WS_KRC = 38 * MiB;
constexpr size_t WS_WIN = 40 * MiB;
constexpr size_t WS_WOUT = 64 * MiB;
constexpr size_t WS_W12 = 72 * MiB;
constexpr size_t WS_WGU = 88 * MiB;
constexpr size_t WS_WD = 600 * MiB;
constexpr size_t WS_XC = 856 * MiB;
constexpr size_t WS_U = 864 * MiB;
constexpr size_t WS_ZT = 932 * MiB;
constexpr size_t WS_YXT = 1136 * MiB;
constexpr size_t WS_YX = 1204 * MiB;
constexpr size_t WS_H = 1272 * MiB;
constexpr size_t WS_EO = 1356 * MiB;
constexpr size_t WS_END = 1524 * MiB;
constexpr size_t WS_YF = WS_ZT, WS_YB = WS_ZT + 64 * MiB, WS_G = WS_ZT + 128 * MiB;

constexpr int CW_TMO = 0;
constexpr int CW_BAR = 4096;
constexpr int CW_CNT = 8192;

constexpr int LDS_BYTES = 147456;
constexpr int ROWTAB_OFF = 131072;
constexpr int TAB_OFF = 139264;
constexpr int MISC_OFF = 141312;

#define LDS_WAIT() asm volatile("s_waitcnt lgkmcnt(0)" ::: "memory")
#define VM_WAIT() asm volatile("s_waitcnt vmcnt(0)" ::: "memory")
__device__ __forceinline__ unsigned f2bf(float f) { unsigned u = __builtin_bit_cast(unsigned, f); return (u + 0x7fffu + ((u >> 16) & 1u)) >> 16; }
__device__ __forceinline__ unsigned pk2(float lo, float hi) { return f2bf(lo) | (f2bf(hi) << 16); }
__device__ __forceinline__ float bf2f(unsigned short b) { return __builtin_bit_cast(float, ((unsigned)b) << 16); }
__device__ __forceinline__ float bflo(unsigned w) { return __builtin_bit_cast(float, w << 16); }
__device__ __forceinline__ float bfhi(unsigned w) { return __builtin_bit_cast(float, w & 0xffff0000u); }
__device__ __forceinline__ float wave_sum(float v) {
#pragma unroll
    for (int o = 1; o < 64; o <<= 1) v += __shfl_xor(v, o);
    return v;
}
__device__ __forceinline__ float sigmoidf_(float x) { return 1.0f / (1.0f + __expf(-x)); }
__device__ __forceinline__ float siluf_(float x) { return x / (1.0f + __expf(-x)); }

#define XB_TMO      128
#define XB_XCNT(j)  (256  + 64 * (j))
#define XB_XSUB(j)  (1280 + 64 * (j))
#define XB_XGEN(j)  (2304 + 64 * (j))
#define XB_TOP      3328
#define XB_TOPGEN   3392
#define XCD_BAR_WORDS 3456
#define XB_SPIN_CAP (1u << 18)
__device__ __forceinline__ unsigned xb_ld(unsigned* p)              { return __hip_atomic_load(p, __ATOMIC_RELAXED, __HIP_MEMORY_SCOPE_AGENT); }
__device__ __forceinline__ unsigned xb_add(unsigned* p, unsigned v) { return __hip_atomic_fetch_add(p, v, __ATOMIC_RELAXED, __HIP_MEMORY_SCOPE_AGENT); }
__device__ __forceinline__ unsigned xb_xcc_id() { return (unsigned)__builtin_amdgcn_s_getreg((3 << 11) | 20) & 0xFu; }
#define XB_SPIN(cond, bar) do { unsigned _sp = 0; while (cond) { __builtin_amdgcn_s_sleep(1); \
    if ((++_sp & 255u) == 0u) { if (xb_ld(&(bar)[XB_TMO])) break; if (_sp > XB_SPIN_CAP) { atomicAdd(&(bar)[XB_TMO], 1u); break; } } } } while (0)
struct XcdBarrier { unsigned* bar; unsigned x; volatile LAS unsigned* st; };
__device__ __forceinline__ XcdBarrier xcd_barrier_post(unsigned* bar, volatile LAS unsigned* st) {
    XcdBarrier b; b.bar = bar; b.x = xb_xcc_id(); b.st = st;
    if (threadIdx.x == 0) (void)xb_add(&bar[XB_XCNT(b.x)], 1u);
    return b;
}
__device__ __forceinline__ void xcd_barrier_complete(unsigned* bar, unsigned x, unsigned& nloc, unsigned& nx) {
    const unsigned G = gridDim.x * gridDim.y * gridDim.z;
    unsigned sum, cnt, mine, sp = 0u;
    for (;;) {
        sum = 0u; cnt = 0u; mine = 0u;
#pragma unroll
        for (unsigned j = 0; j < 16; ++j) { const unsigned c = xb_ld(&bar[XB_XCNT(j)]); sum += c; cnt += (c > 0u) ? 1u : 0u; mine = (j == x) ? c : mine; }
        if (sum == G) break;
        __builtin_amdgcn_s_sleep(1);
        if ((++sp & 255u) == 0u) { if (xb_ld(&bar[XB_TMO])) break; if (sp > XB_SPIN_CAP) { atomicAdd(&bar[XB_TMO], 1u); break; } }
    }
    nloc = mine > 0u ? mine : 1u; nx = cnt > 0u ? cnt : 1u;
}
__device__ __forceinline__ void xcd_barrier(const XcdBarrier& b) {
    asm volatile("s_waitcnt vmcnt(0)" ::: "memory");
    __syncthreads();
    if (threadIdx.x == 0) {
        unsigned* bar = b.bar;
        __builtin_amdgcn_s_waitcnt(0);
        unsigned nloc = b.st[0], nx = b.st[1];
        if (nloc == 0u) { xcd_barrier_complete(bar, b.x, nloc, nx); b.st[0] = nloc; b.st[1] = nx; }
        const unsigned old = xb_add(&bar[XB_XSUB(b.x)], 1u);
        const unsigned gen = old / nloc;
        if (old + 1u == (gen + 1u) * nloc) {
            __builtin_amdgcn_fence(__ATOMIC_RELEASE, "agent");
            asm volatile("s_waitcnt vmcnt(0)" ::: "memory");
            const unsigned og = xb_add(&bar[XB_TOP], 1u);
            const unsigned tg = og / nx;
            if (og + 1u == (tg + 1u) * nx) xb_add(&bar[XB_TOPGEN], 1u);
            else XB_SPIN(xb_ld(&bar[XB_TOPGEN]) == tg, bar);
            __builtin_amdgcn_fence(__ATOMIC_ACQUIRE, "agent");
            xb_add(&bar[XB_XGEN(b.x)], 1u);
            asm volatile("s_waitcnt vmcnt(0)" ::: "memory");
        } else {
            XB_SPIN(xb_ld(&bar[XB_XGEN(b.x)]) == gen, bar);
            __builtin_amdgcn_fence(__ATOMIC_ACQUIRE, "agent");
            asm volatile("s_waitcnt vmcnt(0)" ::: "memory");
        }
    }
    __syncthreads();
}
namespace pg8 {
constexpr int BM = 256, BK = 64, HALF = 128, HTB = HALF * BK * 2, STAGE_BYTES = 8 * HTB, NXCD = 8, WGM = 8;
__device__ __forceinline__ int lds_byte(int r, int c) { const int st = (r >> 4) * 2 + (c >> 5), rr = r & 15, cc = c & 31, ob = rr * 64 + cc * 2; return st * 1024 + (ob ^ (((ob >> 9) & 1) << 5)); }
__device__ __forceinline__ void stage_rc(int b, int& R, int& C) { const int st = b / 1024, sb = b % 1024, swz = sb ^ (((sb >> 9) & 1) << 5); R = (st >> 1) * 16 + swz / 64; C = (st & 1) * 32 + (swz % 64) / 2; }
__device__ __forceinline__ int perm32(int rho) { const int n = rho >> 4, i = rho & 15; return 8 * (i >> 2) + 4 * n + (i & 3); }

struct Unit { const char* A; const char* B; int pm, pn, ui; };

struct DenseOrder {
    const char* A; const char* B; int nM, nN, nwg, G, c; size_t tstep;
    __device__ __forceinline__ void init(const void* A_, const void* B_, int M, int N, int K, int G_, int c_) { A = (const char*)A_; B = (const char*)B_; nM = M / BM; nN = N / BM; nwg = nM * nN; G = G_; c = c_; tstep = (size_t)BM * K * 2; }
    __device__ __forceinline__ bool next(int i, Unit& u) const {
        const long L = (long)i * G + c; if (L >= nwg) return false;
        int wgid = (int)L; { const int q = nwg / NXCD, r = nwg % NXCD, xcd = wgid % NXCD, off = wgid / NXCD; wgid = (xcd < r ? xcd * (q + 1) : r * (q + 1) + (xcd - r) * q) + off; }
        const int nig = WGM * nN, gid = wgid / nig, fm = gid * WGM, gsz = (nM - fm) < WGM ? (nM - fm) : WGM;
        u.pm = fm + ((wgid % nig) % gsz); u.pn = (wgid % nig) / gsz; u.ui = i;
        u.A = A + (size_t)u.pm * tstep; u.B = B + (size_t)u.pn * tstep; return true;
    }
};
struct MoeOrder {
    const char* A; const char* B; const LAS int* rb_e; int nrb, nN, G, c; size_t tstepA, tstepB, estepB; bool gather;
    __device__ __forceinline__ bool next(int i, Unit& u) const {
        const int L = i * G + c; if (L >= nrb * nN) return false;
        const int rbi = L / nN, pn = L - rbi * nN; const int e = rb_e[rbi];
        u.pm = rbi; u.pn = pn; u.ui = i; u.A = gather ? A : A + (size_t)rbi * tstepA; u.B = B + (size_t)e * estepB + (size_t)pn * tstepB; return true;
    }
};

__device__ __forceinline__ unsigned cvt_pk_bf16(float lo, float hi) { unsigned r; asm volatile("v_cvt_pk_bf16_f32 %0, %1, %2" : "=v"(r) : "v"(lo), "v"(hi)); return r; }

typedef f32x4 Acc[2][2][4][2];

struct EpiZT {
    static constexpr bool PERM = true;
    bf16* O; int ldc; const float* bias;
    __device__ __forceinline__ void operator()(const Acc& acc, const Unit& u, int wr, int wc, int fr, int fq) const {
        const int row0 = u.pm * BM + wr * 64 + fr, col0 = u.pn * BM + wc * 32 + 8 * fq;
#pragma unroll
        for (int ai = 0; ai < 2; ++ai)
#pragma unroll
            for (int m = 0; m < 4; ++m) { const int r = row0 + ai * HALF + m * 16; const float bv = bias[r]; bf16* rowp = O + (size_t)r * ldc + col0;
#pragma unroll
                for (int bj = 0; bj < 2; ++bj) { const f32x4 v0 = acc[ai][bj][m][0] + bv, v1 = acc[ai][bj][m][1] + bv;
                    u32x4 w; w.x = cvt_pk_bf16(v0[0], v0[1]); w.y = cvt_pk_bf16(v0[2], v0[3]); w.z = cvt_pk_bf16(v1[0], v1[1]); w.w = cvt_pk_bf16(v1[2], v1[3]);
                    *(u32x4*)(rowp + bj * HALF) = w; } }
    }
};
struct EpiBf {
    static constexpr bool PERM = true;
    bf16* O; int ldc;
    __device__ __forceinline__ void operator()(const Acc& acc, const Unit& u, int wr, int wc, int fr, int fq) const {
        const int row0 = u.pm * BM + wr * 64 + fr, col0 = u.pn * BM + wc * 32 + 8 * fq;
#pragma unroll
        for (int ai = 0; ai < 2; ++ai)
#pragma unroll
            for (int m = 0; m < 4; ++m) { bf16* rowp = O + (size_t)(row0 + ai * HALF + m * 16) * ldc + col0;
#pragma unroll
                for (int bj = 0; bj < 2; ++bj) { const f32x4 v0 = acc[ai][bj][m][0], v1 = acc[ai][bj][m][1];
                    u32x4 w; w.x = cvt_pk_bf16(v0[0], v0[1]); w.y = cvt_pk_bf16(v0[2], v0[3]); w.z = cvt_pk_bf16(v1[0], v1[1]); w.w = cvt_pk_bf16(v1[2], v1[3]);
                    *(u32x4*)(rowp + bj * HALF) = w; } }
    }
};
struct EpiGU {
    static constexpr bool PERM = true;
    bf16* O; int ldc;
    __device__ __forceinline__ void operator()(const Acc& acc, const Unit& u, int wr, int wc, int fr, int fq) const {
        const int row0 = u.pm * BM + wr * 64 + fr, col0 = u.pn * HALF + wc * 32 + 8 * fq;
#pragma unroll
        for (int ai = 0; ai < 2; ++ai)
#pragma unroll
            for (int m = 0; m < 4; ++m) { bf16* rowp = O + (size_t)(row0 + ai * HALF + m * 16) * ldc + col0;
                f32x4 h0, h1;
#pragma unroll
                for (int j = 0; j < 4; ++j) { h0[j] = siluf_(acc[ai][0][m][0][j]) * acc[ai][1][m][0][j]; h1[j] = siluf_(acc[ai][0][m][1][j]) * acc[ai][1][m][1][j]; }
                u32x4 w; w.x = cvt_pk_bf16(h0[0], h0[1]); w.y = cvt_pk_bf16(h0[2], h0[3]); w.z = cvt_pk_bf16(h1[0], h1[1]); w.w = cvt_pk_bf16(h1[2], h1[3]);
                *(u32x4*)rowp = w; }
    }
};
struct EpiRes {
    static constexpr bool PERM = false;
    const float* base_l; float* out_l; const float* gate_l;
    const float* base_c; float* out_c; const float* gate_c; int gstride; const float* bias;
    __device__ __forceinline__ void operator()(const Acc& acc, const Unit& u, int wr, int wc, int fr, int fq) const {
        const bool isc = u.pm >= TL / BM; const int prow = isc ? u.pm - TL / BM : u.pm;
        const float* base = isc ? base_c : base_l; float* out = isc ? out_c : out_l; const float* gate = isc ? gate_c : gate_l + (size_t)(u.pm / (SL / BM)) * gstride;
        const int row0 = prow * BM + wr * 64 + fr, col0 = u.pn * BM + wc * 32 + 4 * fq;
        f32x4 bv[2][2], gv[2][2];
#pragma unroll
        for (int bj = 0; bj < 2; ++bj)
#pragma unroll
            for (int n = 0; n < 2; ++n) { bv[bj][n] = *(const f32x4*)(bias + col0 + bj * HALF + n * 16); gv[bj][n] = *(const f32x4*)(gate + col0 + bj * HALF + n * 16); }
#pragma unroll
        for (int ai = 0; ai < 2; ++ai)
#pragma unroll
            for (int m = 0; m < 4; ++m) { const size_t off = (size_t)(row0 + ai * HALF + m * 16) * D + col0;
#pragma unroll
                for (int bj = 0; bj < 2; ++bj)
#pragma unroll
                    for (int n = 0; n < 2; ++n) { const f32x4 bs = *(const f32x4*)(base + off + bj * HALF + n * 16);
                        *(f32x4*)(out + off + bj * HALF + n * 16) = bs + gv[bj][n] * (acc[ai][bj][m][n] + bv[bj][n]); }
                asm volatile("" ::: "memory"); }
    }
};
struct EpiGlu {
    static constexpr bool PERM = false;
    float* x; const float* gate; int gstride; const float* b1; const float* b2;
    __device__ __forceinline__ void operator()(const Acc& acc, const Unit& u, int wr, int wc, int fr, int fq) const {
        const float* g = gate + (size_t)(u.pm / (SL / BM)) * gstride;
        const int row0 = u.pm * BM + wr * 64 + fr, col0 = u.pn * HALF + wc * 32 + 4 * fq;
        f32x4 b1v[2], b2v[2], gv[2];
#pragma unroll
        for (int n = 0; n < 2; ++n) { b1v[n] = *(const f32x4*)(b1 + col0 + n * 16); b2v[n] = *(const f32x4*)(b2 + col0 + n * 16); gv[n] = *(const f32x4*)(g + col0 + n * 16); }
#pragma unroll
        for (int ai = 0; ai < 2; ++ai)
#pragma unroll
            for (int m = 0; m < 4; ++m) { float* rowp = x + (size_t)(row0 + ai * HALF + m * 16) * D + col0;
#pragma unroll
                for (int n = 0; n < 2; ++n) { const f32x4 a = acc[ai][0][m][n] + b1v[n], b = acc[ai][1][m][n] + b2v[n]; f32x4 o;
#pragma unroll
                    for (int j = 0; j < 4; ++j) o[j] = a[j] * sigmoidf_(b[j]);
                    const f32x4 bs = *(const f32x4*)(rowp + n * 16); *(f32x4*)(rowp + n * 16) = bs + gv[n] * o; }
                asm volatile("" ::: "memory"); }
    }
};

template <class Epi, class Sched, bool GATHER>
__device__ __forceinline__ void gemm_phase(LAS unsigned char* lds, const int K, const Sched& S, const Epi& E, const LAS unsigned* rowtab) {
    const int tid = threadIdx.x, wid = __builtin_amdgcn_readfirstlane(tid >> 6), lane = tid & 63, wr = wid >> 2, wc = wid & 3, fr = lane & 15, fq = lane >> 4;
    const int nt = K / BK;
    unsigned voffB[2]; unsigned cv[2][2], nv[2][2]; int Rr[2], Cc[2];
    const size_t kstep = (size_t)(BK * 2);
    const size_t hstep = (size_t)HALF * K * 2;
#pragma unroll
    for (int i = 0; i < 2; ++i) { int R, C; stage_rc(tid * 16 + i * 8192, R, C); const int Rb = Epi::PERM ? ((R & ~31) + perm32(R & 31)) : R;
        Rr[i] = R; Cc[i] = C; voffB[i] = (unsigned)(Rb * K + C) * 2u;
        if constexpr (!GATHER) { cv[0][i] = (unsigned)(R * K + C) * 2u; cv[1][i] = cv[0][i] + (unsigned)hstep; } }
    const unsigned ldsw = (unsigned)wid * 1024u;
    const int aoff = lds_byte(wr * 64 + fr, fq * 8), boff = lds_byte(wc * 32 + fr, fq * 8);
#define PG8_SA(b, h) (((b) * 2 + (h)) * HTB)
#define PG8_SB(b, h) ((4 + (b) * 2 + (h)) * HTB)
#define PG8_STAGE(bufoff, gbase, voff) do { _Pragma("unroll") for (int _i = 0; _i < 2; ++_i) \
        __builtin_amdgcn_global_load_lds((const unsigned*)((const char*)(gbase) + (voff)[_i]), (LAS unsigned*)(lds + (bufoff) + ldsw + _i * 8192), 16, 0, 0); } while (0)
#define PG8_LDROWS(dst, uix) do { _Pragma("unroll") for (int _h = 0; _h < 2; ++_h) _Pragma("unroll") for (int _i = 0; _i < 2; ++_i) \
        dst[_h][_i] = rowtab[(uix) * 256 + _h * 128 + Rr[_i]] + (unsigned)(Cc[_i] * 2); } while (0)
#define PG8_LDA(dst, b, h) do { _Pragma("unroll") for (int m = 0; m < 4; ++m) _Pragma("unroll") for (int k = 0; k < 2; ++k) dst[m][k] = *(const LAS bf16x8*)(lds + PG8_SA(b, h) + aoff + m * 2048 + k * 1024); } while (0)
#define PG8_LDB(dst, b, h) do { _Pragma("unroll") for (int n = 0; n < 2; ++n) _Pragma("unroll") for (int k = 0; k < 2; ++k) dst[n][k] = *(const LAS bf16x8*)(lds + PG8_SB(b, h) + boff + n * 2048 + k * 1024); } while (0)
#define PG8_MMA(ai, bj, At, Bt) do { __builtin_amdgcn_s_setprio(1); _Pragma("unroll") for (int m = 0; m < 4; ++m) _Pragma("unroll") for (int n = 0; n < 2; ++n) _Pragma("unroll") for (int k = 0; k < 2; ++k) \
        acc[ai][bj][m][n] = __builtin_amdgcn_mfma_f32_16x16x32_bf16(Bt[n][k], At[m][k], acc[ai][bj][m][n], 0, 0, 0); __builtin_amdgcn_s_setprio(0); } while (0)
#define PG8_WAIT_V(n) asm volatile("s_waitcnt vmcnt(" #n ")" ::: "memory")
#define PG8_WAIT_L(n) asm volatile("s_waitcnt lgkmcnt(" #n ")" ::: "memory")
#define PG8_BAR __builtin_amdgcn_s_barrier()
#define PG8_SCHED __builtin_amdgcn_sched_barrier(0)
    Unit cur, nxt; int ui = 0;
    if (!S.next(0, cur)) return;
    Acc acc;
#pragma unroll
    for (int a = 0; a < 2; ++a)
#pragma unroll
        for (int b = 0; b < 2; ++b)
#pragma unroll
            for (int m = 0; m < 4; ++m)
#pragma unroll
                for (int n = 0; n < 2; ++n) acc[a][b][m][n] = (f32x4){0.f, 0.f, 0.f, 0.f};
    bf16x8 At[4][2], B0[2][2], B1[2][2];
    const char* cA = cur.A; const char* cB = cur.B;
    if constexpr (GATHER) { PG8_LDROWS(cv, cur.ui); PG8_WAIT_L(0); }
    PG8_STAGE(PG8_SB(0, 0), cB, voffB); PG8_STAGE(PG8_SB(0, 1), cB + hstep, voffB); PG8_STAGE(PG8_SA(0, 0), cA, cv[0]); PG8_STAGE(PG8_SA(0, 1), cA, cv[1]);
    if (wr == 1) PG8_BAR;
    PG8_WAIT_V(2); PG8_BAR;
    PG8_STAGE(PG8_SB(1, 0), cB + kstep, voffB); PG8_STAGE(PG8_SA(1, 0), cA + kstep, cv[0]); PG8_STAGE(PG8_SB(1, 1), cB + hstep + kstep, voffB);
    PG8_WAIT_V(6); PG8_BAR;
    for (;;) {
        const bool has_next = S.next(ui + 1, nxt);
        const char* nA = has_next ? nxt.A : cA; const char* nB = has_next ? nxt.B : cB;
        for (int t = 0; t < nt; t += 2) {
            const bool last = (t == nt - 2);
            const char* a1 = cA + (size_t)(t + 1) * kstep;
            const char* a2 = last ? nA : cA + (size_t)(t + 2) * kstep; const char* b2 = last ? nB : cB + (size_t)(t + 2) * kstep;
            const char* a3 = a2 + kstep; const char* b3 = b2 + kstep;
            if constexpr (GATHER) { if (last) { PG8_LDROWS(nv, has_next ? nxt.ui : cur.ui); } else {
#pragma unroll
                for (int h = 0; h < 2; ++h)
#pragma unroll
                    for (int i = 0; i < 2; ++i) nv[h][i] = cv[h][i]; } }
            else {
#pragma unroll
                for (int h = 0; h < 2; ++h)
#pragma unroll
                    for (int i = 0; i < 2; ++i) nv[h][i] = cv[h][i]; }
            PG8_LDB(B0, 0, 0); PG8_LDB(B1, 0, 1); PG8_SCHED; PG8_LDA(At, 0, 0); PG8_STAGE(PG8_SA(1, 1), a1, cv[1]);
            PG8_WAIT_V(8); PG8_WAIT_L(0); PG8_BAR; PG8_MMA(0, 0, At, B0); PG8_MMA(0, 1, At, B1); PG8_BAR; PG8_SCHED;
            PG8_LDA(At, 0, 1); PG8_STAGE(PG8_SB(0, 0), b2, voffB); PG8_STAGE(PG8_SB(0, 1), b2 + hstep, voffB); PG8_STAGE(PG8_SA(0, 0), a2, nv[0]);
            PG8_WAIT_V(8); PG8_WAIT_L(0); PG8_BAR; PG8_MMA(1, 0, At, B0); PG8_MMA(1, 1, At, B1); PG8_BAR; PG8_SCHED;
            PG8_LDB(B0, 1, 0); PG8_LDB(B1, 1, 1); PG8_SCHED; PG8_LDA(At, 1, 0); PG8_STAGE(PG8_SA(0, 1), a2, nv[1]);
            PG8_WAIT_V(8); PG8_WAIT_L(0); PG8_BAR; PG8_MMA(0, 0, At, B0); PG8_MMA(0, 1, At, B1); PG8_BAR; PG8_SCHED;
            PG8_LDA(At, 1, 1); PG8_STAGE(PG8_SB(1, 0), b3, voffB); PG8_STAGE(PG8_SB(1, 1), b3 + hstep, voffB); PG8_STAGE(PG8_SA(1, 0), a3, nv[0]);
            PG8_WAIT_V(8); PG8_WAIT_L(0); PG8_BAR; PG8_MMA(1, 0, At, B0); PG8_MMA(1, 1, At, B1); PG8_BAR; PG8_SCHED;
        }
        if (wr == 0) PG8_BAR;
        E(acc, cur, wr, wc, fr, fq);
        if (!has_next) break;
#pragma unroll
        for (int a = 0; a < 2; ++a)
#pragma unroll
            for (int b = 0; b < 2; ++b)
#pragma unroll
                for (int m = 0; m < 4; ++m)
#pragma unroll
                    for (int n = 0; n < 2; ++n) acc[a][b][m][n] = (f32x4){0.f, 0.f, 0.f, 0.f};
        cur = nxt; cA = nA; cB = nB; ++ui;
        if constexpr (GATHER) {
#pragma unroll
            for (int h = 0; h < 2; ++h)
#pragma unroll
                for (int i = 0; i < 2; ++i) cv[h][i] = nv[h][i]; }
        if (wr == 1) PG8_BAR;
    }
    PG8_WAIT_V(0);
    PG8_BAR;
#undef PG8_SA
#undef PG8_SB
#undef PG8_STAGE
#undef PG8_LDROWS
#undef PG8_LDA
#undef PG8_LDB
#undef PG8_MMA
#undef PG8_WAIT_V
#undef PG8_WAIT_L
#undef PG8_BAR
#undef PG8_SCHED
}
}
struct Params { const float* in[40]; float* out; unsigned char* ws; int ph_lo, ph_hi; };
enum { I_X = 0, I_C, I_CTX, I_CCTX, I_ADAW, I_ADAB, I_NORMG, I_FINALG, I_HWIN, I_HBIN, I_HCW, I_HCB, I_FW1, I_FB1, I_FW2, I_FB2, I_FW3, I_FREQ, I_SKIP, I_HWOUT, I_HBOUT,
       I_SARE, I_SAIM, I_SLOG, I_SBRE, I_SBIM, I_SCRE, I_SCIM, I_SD, I_SW1, I_SB1, I_SW2, I_SB2, I_MWG, I_MBG, I_MWE, I_MBE, I_MGATE, I_MUP, I_MDOWN };

struct Frame {
    LAS unsigned char* lds; unsigned* ctl; unsigned char* ws; const float* const* in; float* out;
    int tid, lane, wave, G, c;
};
#define MODP(F, l, r) ((const float*)((F).ws + WS_MOD) + ((size_t)(l) * 5 + (r)) * 12288)

struct TItem { const float* src; bf16* dst; int N, K; };
__device__ __forceinline__ void p0_item_load(f32x4 (&v)[8], const TItem& t, int lane) {
#pragma unroll
    for (int i = 0; i < 8; ++i) v[i] = *(const GAS f32x4*)(t.src + (size_t)(8 * i + (lane >> 3)) * t.N + 4 * (lane & 7));
}
__device__ __forceinline__ void p0_item_store(const f32x4 (&v)[8], const TItem& t, LAS float* scr, int lane) {
#pragma unroll
    for (int i = 0; i < 8; ++i) { LAS float* s = scr + (8 * i + (lane >> 3)) * 33 + 4 * (lane & 7); s[0] = v[i][0]; s[1] = v[i][1]; s[2] = v[i][2]; s[3] = v[i][3]; }
    LDS_WAIT(); asm volatile("" ::: "memory");
    const int c = lane & 7;
#pragma unroll
    for (int j = 0; j < 4; ++j) { const int n = (lane >> 3) + 8 * j; const LAS float* s = scr + (8 * c) * 33 + n;
        u32x4 o; o.x = pk2(s[0 * 33], s[1 * 33]); o.y = pk2(s[2 * 33], s[3 * 33]); o.z = pk2(s[4 * 33], s[5 * 33]); o.w = pk2(s[6 * 33], s[7 * 33]);
        *(GAS u32x4*)(t.dst + (size_t)n * t.K + 8 * c) = o; }
    LDS_WAIT(); asm volatile("" ::: "memory");
}
__device__ __forceinline__ TItem p0_job(const float* W, int K, int N, bf16* WT, bool ilv, int ilv_off, int idx) {
    const int nblk = N / 32, kb = idx / nblk, nb = idx - kb * nblk, n0 = 32 * nb, k0 = 64 * kb;
    const int drow0 = ilv ? ((n0 >> 7) * 256 + ilv_off + (n0 & 127)) : n0;
    TItem t; t.src = W + (size_t)k0 * N + n0; t.dst = WT + (size_t)drow0 * K + k0; t.N = N; t.K = K; return t;
}
__device__ __forceinline__ TItem p0_decode(const float* const* in, unsigned char* ws, int it) {
    constexpr int N_IN = 32 * 192, N_SQ = 32 * 64, N_E = 1024;
    int r = it;
    if (r < N_IN) return p0_job(in[I_HWIN], 2048, 6144, (bf16*)(ws + WS_WIN), false, 0, r); r -= N_IN;
    if (r < N_SQ) return p0_job(in[I_HWOUT], 2048, 2048, (bf16*)(ws + WS_WOUT), false, 0, r); r -= N_SQ;
    if (r < N_SQ) return p0_job(in[I_SW1], 2048, 2048, (bf16*)(ws + WS_W12), true, 0, r); r -= N_SQ;
    if (r < N_SQ) return p0_job(in[I_SW2], 2048, 2048, (bf16*)(ws + WS_W12), true, 128, r); r -= N_SQ;
    const int le = r / (3 * N_E), q = r - le * 3 * N_E, which = q / N_E, idx = q - which * N_E;
    if (which == 0) return p0_job(in[I_MGATE] + (size_t)le * 2048 * 1024, 2048, 1024, (bf16*)(ws + WS_WGU) + (size_t)le * 2048 * 2048, true, 0, idx);
    if (which == 1) return p0_job(in[I_MUP] + (size_t)le * 2048 * 1024, 2048, 1024, (bf16*)(ws + WS_WGU) + (size_t)le * 2048 * 2048, true, 128, idx);
    return p0_job(in[I_MDOWN] + (size_t)le * 1024 * 2048, 1024, 2048, (bf16*)(ws + WS_WD) + (size_t)le * 2048 * 1024, false, 0, idx);
}

__device__ __forceinline__ void p0_prologue(Frame& F) {
    const float* const* in = F.in;
    {
        LAS float* sl = (LAS float*)F.lds;
        for (int i = F.tid; i < 2048 * 5; i += NTHR) { const int r = i / 2048, k = i - r * 2048; const float cv = r < 4 ? in[I_C][r * 2048 + k] : in[I_CCTX][k]; sl[k * 8 + r] = siluf_(cv); }
        __syncthreads();
        LAS float* red = (LAS float*)(F.lds + 65536);
        for (int it = F.c; it < 768; it += F.G) {
            const int l = it / 384, j = it - l * 384; const float* W = in[I_ADAW] + (size_t)l * 2048 * 12288 + 32 * j + (F.lane & 31);
            float a0 = 0.f, a1 = 0.f, a2 = 0.f, a3 = 0.f, a4 = 0.f;
            const int kbase = 256 * F.wave + (F.lane >> 5);
#pragma unroll 32
            for (int kk = 0; kk < 128; ++kk) { const int k = kbase + 2 * kk; const float w = W[(size_t)k * 12288];
                const f32x4 s = *(const LAS f32x4*)(sl + k * 8); const float s4 = sl[k * 8 + 4];
                a0 += s[0] * w; a1 += s[1] * w; a2 += s[2] * w; a3 += s[3] * w; a4 += s4 * w; }
            a0 += __shfl_xor(a0, 32); a1 += __shfl_xor(a1, 32); a2 += __shfl_xor(a2, 32); a3 += __shfl_xor(a3, 32); a4 += __shfl_xor(a4, 32);
            if (F.lane < 32) { LAS float* r = red + F.wave * 160 + F.lane; r[0] = a0; r[32] = a1; r[64] = a2; r[96] = a3; r[128] = a4; }
            __syncthreads();
            if (F.tid < 160) { float s = 0.f;
#pragma unroll
                for (int w = 0; w < 8; ++w) s += red[w * 160 + F.tid];
                const int r = F.tid >> 5, col = 32 * j + (F.tid & 31);
                ((float*)(F.ws + WS_MOD))[((size_t)l * 5 + r) * 12288 + col] = s + in[I_ADAB][l * 12288 + col]; }
            __syncthreads();
        }
    }
    {
        LAS float* zf = (LAS float*)F.lds;
        LAS float* h1 = (LAS float*)(F.lds + 20480);
        LAS float* h2T = (LAS float*)(F.lds + 57344);
        LAS float* w1s = (LAS float*)(F.lds + 94208);
        LAS float* w2s = (LAS float*)(F.lds + 102656);
        LAS float* vs = (LAS float*)(F.lds + 119040);
        for (int i = F.tid; i < 33 * 64; i += NTHR) w1s[i] = in[I_FW1][i];
        for (int i = F.tid; i < 64 * 64; i += NTHR) w2s[i] = in[I_FW2][i];
        if (F.tid < 64) { vs[F.tid] = in[I_FB1][F.tid]; vs[64 + F.tid] = in[I_FB2][F.tid]; vs[128 + F.tid] = in[I_FREQ][F.tid]; }
        for (int it = F.c; it < 256; it += F.G) {
            const int pb = it >> 3, cb = it & 7, pbase = pb * 136;
            for (int i = F.tid; i < 136 * 33; i += NTHR) { const int p = i / 33, m = i - p * 33; const int gp = pbase + p; const int Lq = gp < SL ? SL : CL, j = gp < SL ? gp : gp - SL;
                float v;
                if (m == 0) v = (float)j / (float)(Lq - 1);
                else { const int mm = (m - 1) & 15; const float band = 1e-4f + (float)mm * ((15.0f - 1e-4f) / 15.0f); const float w = (6.283185307179586f / (float)Lq) * (float)j; const float a = band * w;
                    v = (m <= 16) ? cosf(a) : -sinf(a); }
                zf[i] = v; }
            __syncthreads();
            for (int i = F.tid; i < 136 * 64; i += NTHR) { const int p = i >> 6, o = i & 63; float s = vs[o];
#pragma unroll
                for (int m = 0; m < 33; ++m) s += zf[p * 33 + m] * w1s[m * 64 + o];
                h1[i] = sinf(vs[128 + o] * s); }
            __syncthreads();
            for (int i = F.tid; i < 136 * 64; i += NTHR) { const int p = i >> 6, o = i & 63; float s = vs[64 + o];
#pragma unroll 16
                for (int m = 0; m < 64; ++m) s += h1[p * 64 + m] * w2s[m * 64 + o];
                h2T[o * 136 + p] = sinf(vs[128 + o] * s); }
            __syncthreads();
            const int cg = F.tid & 127, pg = F.tid >> 7, c0 = 512 * cb + 4 * cg, p0 = 34 * pg;
            f32x4 acc[34];
#pragma unroll
            for (int i = 0; i < 34; ++i) acc[i] = (f32x4){0.f, 0.f, 0.f, 0.f};
            const float* w3 = in[I_FW3] + c0;
            f32x4 wq[2];
#pragma unroll
            for (int k = 0; k < 2; ++k) wq[k] = *(const GAS f32x4*)(w3 + (size_t)k * 4096);
#pragma unroll 1
            for (int o0 = 0; o0 < 64; o0 += 2) {
                f32x4 wn[2];
#pragma unroll
                for (int k = 0; k < 2; ++k) { const int on = o0 + 2 + k; wn[k] = *(const GAS f32x4*)(w3 + (size_t)(on < 64 ? on : 63) * 4096); }
#pragma unroll
                for (int k = 0; k < 2; ++k) {
#pragma unroll
                    for (int i = 0; i < 17; ++i) { const f32x2 hv = *(const LAS f32x2*)(h2T + (o0 + k) * 136 + p0 + 2 * i); acc[2 * i] += wq[k] * hv[0]; acc[2 * i + 1] += wq[k] * hv[1]; } }
#pragma unroll
                for (int k = 0; k < 2; ++k) wq[k] = wn[k];
            }
            const int dir = c0 >> 11, d0 = c0 & 2047;
            const float dstep = ((-15.350567286626973f) - (-3.0701134573253945f)) / 2047.0f;
            float delta[4];
#pragma unroll
            for (int q = 0; q < 4; ++q) delta[q] = fabsf(-3.0701134573253945f + (float)(d0 + q) * dstep);
#pragma unroll
            for (int i = 0; i < 17; ++i) { const int gp = pbase + p0 + 2 * i; const bool lat = gp < SL; const int Lq = lat ? SL : CL, j = lat ? gp : gp - SL;
                const float t0 = (float)j / (float)(Lq - 1), t1 = (float)(j + 1) / (float)(Lq - 1);
#pragma unroll
                for (int q = 0; q < 4; ++q) { const unsigned w = pk2(acc[2 * i][q] * __expf(-t0 * delta[q]), acc[2 * i + 1][q] * __expf(-t1 * delta[q]));
                    bf16* dst = lat ? (bf16*)(F.ws + WS_KRN) + ((size_t)(d0 + q) * 2 + dir) * SL + j : (bf16*)(F.ws + WS_KRC) + ((size_t)(d0 + q) * 2 + dir) * CL + j;
                    *(unsigned*)dst = w; } }
            __syncthreads();
        }
    }
}
constexpr int CVT_N_HEAD = 32 * 192 + 3 * 32 * 64, CVT_N_L0 = CVT_N_HEAD + 32 * 3 * 1024, CVT_NITEMS = CVT_N_HEAD + 64 * 3 * 1024;
__device__ __forceinline__ void cvt_weights(Frame& F, int lo, int hi, int wi, int nw, LAS float* scr) {
    const float* const* in = F.in;
    f32x4 va[8], vb[8];
    int it = lo + wi;
    TItem ta = p0_decode(in, F.ws, it < hi ? it : hi - 1), tb;
    p0_item_load(va, ta, F.lane);
#pragma unroll 1
    for (; it < hi; it += 2 * nw) {
        const int ib = it + nw, ia = it + 2 * nw;
        tb = p0_decode(in, F.ws, ib < hi ? ib : hi - 1); p0_item_load(vb, tb, F.lane);
        p0_item_store(va, ta, scr, F.lane);
        ta = p0_decode(in, F.ws, ia < hi ? ia : hi - 1); p0_item_load(va, ta, F.lane);
        if (ib < hi) p0_item_store(vb, tb, scr, F.lane);
    }
}
__device__ __forceinline__ void p0_weights(Frame& F) {
    cvt_weights(F, 0, CVT_N_L0, F.c * NWAVES + F.wave, F.G * NWAVES, (LAS float*)(F.lds + F.wave * 8448));
}
struct Row { f32x4 v[8]; };
__device__ __forceinline__ void row_load(Row& r, const float* p, int lane) {
#pragma unroll
    for (int i = 0; i < 8; ++i) r.v[i] = *(const GAS f32x4*)(p + 4 * lane + 256 * i);
}
__device__ __forceinline__ float row_rstd(const Row& r) {
    float s = 0.f;
#pragma unroll
    for (int i = 0; i < 8; ++i) s += (r.v[i][0] * r.v[i][0] + r.v[i][1] * r.v[i][1]) + (r.v[i][2] * r.v[i][2] + r.v[i][3] * r.v[i][3]);
    return 1.0f / sqrtf(wave_sum(s) * (1.0f / D) + EPS);
}
__device__ __forceinline__ void row_norm_mod_store(const Row& r, float rstd, const float* g, const float* sh, const float* sc, bf16* o, int lane) {
#pragma unroll
    for (int i = 0; i < 8; ++i) { const int c = 4 * lane + 256 * i;
        const f32x4 gv = *(const GAS f32x4*)(g + c), sv = *(const GAS f32x4*)(sc + c), hv = *(const GAS f32x4*)(sh + c);
        const f32x4 y = (r.v[i] * rstd * gv) * (sv + 1.0f) + hv;
        u32x2 w; w.x = pk2(y[0], y[1]); w.y = pk2(y[2], y[3]); *(GAS u32x2*)(o + c) = w; }
}
__device__ __forceinline__ int moe_pos(const LAS int* rbfirst, int packed) { return 256 * rbfirst[packed >> 20] + (packed & 0xfffff); }
__device__ __forceinline__ void row_add_moe(Row& r, const float* gt, const bf16* eo, int p0, int p1, float g0, float g1, int lane) {
#pragma unroll
    for (int i = 0; i < 8; ++i) { const int c = 4 * lane + 256 * i;
        const u32x2 a = *(const GAS u32x2*)(eo + (size_t)p0 * D + c), b = *(const GAS u32x2*)(eo + (size_t)p1 * D + c); const f32x4 gv = *(const GAS f32x4*)(gt + c);
        f32x4 m; m[0] = g0 * bflo(a.x) + g1 * bflo(b.x); m[1] = g0 * bfhi(a.x) + g1 * bfhi(b.x); m[2] = g0 * bflo(a.y) + g1 * bflo(b.y); m[3] = g0 * bfhi(a.y) + g1 * bfhi(b.y);
        r.v[i] += gv * m; }
}
__device__ __forceinline__ void row_store(const Row& r, float* p, int lane) {
#pragma unroll
    for (int i = 0; i < 8; ++i) *(GAS f32x4*)(p + 4 * lane + 256 * i) = r.v[i];
}
__device__ __forceinline__ int moe_tables(Frame& F, int l) {
    LAS int* rb_e = (LAS int*)(F.lds + TAB_OFF); LAS int* rbfirst = rb_e + 168; LAS int* cnt = rbfirst + 33;
    __syncthreads();
    if (F.tid < 32) cnt[F.tid] = (int)xb_ld(F.ctl + CW_CNT + (l * 32 + F.tid) * 64);
    __syncthreads();
    if (F.tid == 0) { int a = 0; for (int e = 0; e < 32; ++e) { rbfirst[e] = a; const int n = (cnt[e] + 255) >> 8; for (int k = 0; k < n; ++k) rb_e[a + k] = e; a += n; } rbfirst[32] = a; }
    __syncthreads();
    return rbfirst[32];
}

__device__ __forceinline__ void p_norm1_l0(Frame& F) {
    const int gw = F.c * NWAVES + F.wave, NGW = F.G * NWAVES;
    for (int r = gw; r < TT; r += NGW) {
        const bool lat = r < TL; const float* src = lat ? F.in[I_X] + (size_t)r * D : F.in[I_CTX] + (size_t)(r - TL) * D; const float* mod = MODP(F, 0, lat ? (r >> 12) : 4);
        Row row; row_load(row, src, F.lane); const float rstd = row_rstd(row);
        row_norm_mod_store(row, rstd, F.in[I_NORMG], mod, mod + 2048, (bf16*)(F.ws + WS_U) + (size_t)r * D, F.lane);
    }
}
__device__ __forceinline__ void p_comb_norm1_l1(Frame& F) {
    moe_tables(F, 0);
    const LAS int* rbfirst = (const LAS int*)(F.lds + TAB_OFF) + 168;
    const int gw = F.c * NWAVES + F.wave, NGW = F.G * NWAVES;
    const int* tokpos = (const int*)(F.ws + WS_TOKPOS); const float* gates = (const float*)(F.ws + WS_GATE);
    for (int r = gw; r < TT; r += NGW) {
        const bool lat = r < TL; float* xp = lat ? F.out + (size_t)r * D : (float*)(F.ws + WS_XC) + (size_t)(r - TL) * D; const int mr = lat ? (r >> 12) : 4;
        Row row; row_load(row, xp, F.lane);
        const int p0 = moe_pos(rbfirst, tokpos[2 * r]), p1 = moe_pos(rbfirst, tokpos[2 * r + 1]);
        row_add_moe(row, MODP(F, 0, mr) + 10240, (const bf16*)(F.ws + WS_EO), p0, p1, gates[2 * r], gates[2 * r + 1], F.lane);
        row_store(row, xp, F.lane);
        const float rstd = row_rstd(row); const float* mod = MODP(F, 1, mr);
        row_norm_mod_store(row, rstd, F.in[I_NORMG] + 2 * D, mod, mod + 2048, (bf16*)(F.ws + WS_U) + (size_t)r * D, F.lane);
    }
}
__device__ __forceinline__ void p_final(Frame& F) {
    moe_tables(F, 1);
    const LAS int* rbfirst = (const LAS int*)(F.lds + TAB_OFF) + 168;
    const int gw = F.c * NWAVES + F.wave, NGW = F.G * NWAVES;
    const int* tokpos = (const int*)(F.ws + WS_TOKPOS); const float* gates = (const float*)(F.ws + WS_GATE);
    for (int r = gw; r < TL; r += NGW) {
        float* xp = F.out + (size_t)r * D;
        Row row; row_load(row, xp, F.lane);
        const int p0 = moe_pos(rbfirst, tokpos[2 * r]), p1 = moe_pos(rbfirst, tokpos[2 * r + 1]);
        row_add_moe(row, MODP(F, 1, r >> 12) + 10240, (const bf16*)(F.ws + WS_EO), p0, p1, gates[2 * r], gates[2 * r + 1], F.lane);
        const float rstd = row_rstd(row);
#pragma unroll
        for (int i = 0; i < 8; ++i) { const int c = 4 * F.lane + 256 * i; const f32x4 gv = *(const GAS f32x4*)(F.in[I_FINALG] + c); row.v[i] = row.v[i] * rstd * gv; }
        row_store(row, xp, F.lane);
    }
}

__device__ __forceinline__ void p_router(Frame& F, int l, int ntok) {
    constexpr int PITCH = 2050;
    LAS float* xt = (LAS float*)F.lds;
    LAS float* red = (LAS float*)F.lds;
    LAS float* lg = (LAS float*)(F.lds + 32768);
    const float* wg = F.in[I_MWG] + (size_t)l * 2048 * 4; const float* we = F.in[I_MWE] + (size_t)l * 2048 * 32;
    const float* g = F.in[I_NORMG] + (size_t)(l * 2 + 1) * D;
    int* list = (int*)(F.ws + WS_LIST); int* tokpos = (int*)(F.ws + WS_TOKPOS); float* gates = (float*)(F.ws + WS_GATE);
    const int ntile = ntok / 16;
    for (int tile = F.c; tile < ntile; tile += F.G) {
        const int t0 = tile * 16;
        __syncthreads();
#pragma unroll 1
        for (int q = 0; q < 2; ++q) { const int r = t0 + 2 * F.wave + q; const bool lat = r < TL;
            const float* xp = lat ? F.out + (size_t)r * D : (const float*)(F.ws + WS_XC) + (size_t)(r - TL) * D; const float* mod = MODP(F, l, lat ? (r >> 12) : 4);
            Row row; row_load(row, xp, F.lane); const float rstd = row_rstd(row);
            bf16* o = (bf16*)(F.ws + WS_U) + (size_t)r * D; LAS float* xr = xt + (2 * F.wave + q) * PITCH;
#pragma unroll
            for (int i = 0; i < 8; ++i) { const int c = 4 * F.lane + 256 * i;
                const f32x4 gv = *(const GAS f32x4*)(g + c), sv = *(const GAS f32x4*)(mod + 8192 + c), hv = *(const GAS f32x4*)(mod + 6144 + c);
                const f32x4 y = (row.v[i] * rstd * gv) * (sv + 1.0f) + hv;
                u32x2 w; w.x = pk2(y[0], y[1]); w.y = pk2(y[2], y[3]); *(GAS u32x2*)(o + c) = w;
                *(LAS f32x2*)(xr + c) = (f32x2){y[0], y[1]}; *(LAS f32x2*)(xr + c + 2) = (f32x2){y[2], y[3]}; } }
        __syncthreads();
        f32x4 a0 = {0.f, 0.f, 0.f, 0.f}, a1 = a0, a2 = a0;
        { const int tk = F.lane & 15, kq = F.lane >> 4, kb = 256 * F.wave + kq; const LAS float* ap = xt + tk * PITCH + kb;
          const bool v0 = tk < 4; const float* b0p = v0 ? wg + (size_t)kb * 4 + tk : we + (size_t)kb * 32 + (tk - 4);
          const float* b1p = we + (size_t)kb * 32 + 12 + tk;
          const bool v2 = tk < 4; const float* b2p = we + (size_t)kb * 32 + (v2 ? 28 + tk : 0);
          const int s0 = v0 ? 16 : 128;
#pragma unroll 8
          for (int ks = 0; ks < 64; ++ks) { const float av = ap[4 * ks]; const float w0 = b0p[(size_t)ks * s0], w1 = b1p[(size_t)ks * 128]; float w2 = b2p[(size_t)ks * 128]; w2 = v2 ? w2 : 0.f;
              a0 = __builtin_amdgcn_mfma_f32_16x16x4f32(av, w0, a0, 0, 0, 0); a1 = __builtin_amdgcn_mfma_f32_16x16x4f32(av, w1, a1, 0, 0, 0); a2 = __builtin_amdgcn_mfma_f32_16x16x4f32(av, w2, a2, 0, 0, 0); } }
        __syncthreads();
        { LAS float* rp = red + F.wave * 768;
#pragma unroll
          for (int j = 0; j < 4; ++j) { const int tk = 4 * (F.lane >> 4) + j; rp[tk * 48 + (F.lane & 15)] = a0[j]; rp[tk * 48 + 16 + (F.lane & 15)] = a1[j]; rp[tk * 48 + 32 + (F.lane & 15)] = a2[j]; } }
        __syncthreads();
        for (int i = F.tid; i < 768; i += NTHR) { float s = 0.f;
#pragma unroll
            for (int w = 0; w < 8; ++w) s += red[w * 768 + i];
            const int n = i % 48; s += n < 4 ? F.in[I_MBG][l * 4 + n] : (n < 36 ? F.in[I_MBE][l * 32 + n - 4] : 0.f); lg[i] = s; }
        __syncthreads();
        if (F.tid < 16) { const LAS float* q = lg + F.tid * 48; const int r = t0 + F.tid;
            int gi = 0; float gm = q[0];
#pragma unroll
            for (int k = 1; k < 4; ++k) if (q[k] > gm) { gm = q[k]; gi = k; }
            float gs = 0.f;
#pragma unroll
            for (int k = 0; k < 4; ++k) gs += __expf(q[k] - gm);
            const float ptop = 1.0f / gs;
            const LAS float* e = q + 4 + 8 * gi; int i0 = 0; float v0 = e[0];
#pragma unroll
            for (int k = 1; k < 8; ++k) if (e[k] > v0) { v0 = e[k]; i0 = k; }
            int i1 = -1; float v1 = -3.0e38f;
#pragma unroll
            for (int k = 0; k < 8; ++k) if (k != i0 && e[k] > v1) { v1 = e[k]; i1 = k; }
            const float x1 = __expf(v1 - v0), den = 1.0f / (1.0f + x1);
            const int e0 = gi * 8 + i0, e1 = gi * 8 + i1;
            const unsigned s0 = xb_add(F.ctl + CW_CNT + (l * 32 + e0) * 64, 1u), s1 = xb_add(F.ctl + CW_CNT + (l * 32 + e1) * 64, 1u);
            list[(size_t)e0 * TT + s0] = r; list[(size_t)e1 * TT + s1] = r;
            tokpos[2 * r] = (e0 << 20) | (int)s0; tokpos[2 * r + 1] = (e1 << 20) | (int)s1;
            gates[2 * r] = ptop * den; gates[2 * r + 1] = ptop * x1 * den; }
    }
}
constexpr int CV_KR = 0, CV_KRC = 16384, CV_ZERO = 17408, CV_V = 17920, CV_VB = 10272, CV_VJ = 640, CV_VC = 59008, CV_VCB = 544, CV_RED = 61184;
__device__ __forceinline__ float conv3(float zm, float z0, float zp, float w0, float w1, float w2, float cb) { return zm * w0 + z0 * w1 + zp * w2 + cb; }
template <int NV> struct ZChunk { u32x4 v[NV]; unsigned short hl, hr; };
template <int NV>
__device__ __forceinline__ void zchunk_load(ZChunk<NV>& z, const bf16* zrow, int col0, int t0, int Lseq) {
#pragma unroll
    for (int i = 0; i < NV; ++i) z.v[i] = *(const GAS u32x4*)(zrow + col0 + 8 * i);
    z.hl = zrow[t0 > 0 ? col0 - 1 : col0];
    z.hr = zrow[(t0 + 8 * NV < Lseq) ? col0 + 8 * NV : col0];
}
template <int NV>
__device__ __forceinline__ void zchunk_conv3(const ZChunk<NV>& zc, int t0, int Lseq, float w0, float w1, float w2, float cb, float* out) {
    float z[8 * NV + 2];
    z[0] = t0 > 0 ? bf2f(zc.hl) : 0.f;
    z[8 * NV + 1] = (t0 + 8 * NV < Lseq) ? bf2f(zc.hr) : 0.f;
#pragma unroll
    for (int i = 0; i < NV; ++i) { const u32x4 w = zc.v[i];
        z[1 + 8 * i] = bflo(w.x); z[2 + 8 * i] = bfhi(w.x); z[3 + 8 * i] = bflo(w.y); z[4 + 8 * i] = bfhi(w.y); z[5 + 8 * i] = bflo(w.z); z[6 + 8 * i] = bfhi(w.z); z[7 + 8 * i] = bflo(w.w); z[8 + 8 * i] = bfhi(w.w); }
#pragma unroll
    for (int i = 0; i < 8 * NV; ++i) out[i] = conv3(z[i], z[i + 1], z[i + 2], w0, w1, w2, cb);
}
#define CV_MMA8(acc, d, bfr) do { \
    unsigned o_[7]; _Pragma("unroll") for (int m_ = 0; m_ < 7; ++m_) o_[m_] = __builtin_amdgcn_alignbit(d[m_ + 1], d[m_], 16); \
    _Pragma("unroll") for (int q_ = 0; q_ < 4; ++q_) { \
        u32x4 fe_ = {d[4 - q_], d[5 - q_], d[6 - q_], d[7 - q_]}; u32x4 fo_ = {o_[3 - q_], o_[4 - q_], o_[5 - q_], o_[6 - q_]}; \
        acc[2 * q_] = __builtin_amdgcn_mfma_f32_16x16x32_bf16(__builtin_bit_cast(bf16x8, fe_), bfr, acc[2 * q_], 0, 0, 0); \
        acc[2 * q_ + 1] = __builtin_amdgcn_mfma_f32_16x16x32_bf16(__builtin_bit_cast(bf16x8, fo_), bfr, acc[2 * q_ + 1], 0, 0, 0); } } while (0)

struct ConvPre { u32x4 kf, kb, kc; ZChunk<4> zv, zx; ZChunk<1> cv, cx; };
__device__ __forceinline__ void conv_issue(ConvPre& P, Frame& F, int d) {
    const int tid = F.tid; const bf16* ZT = (const bf16*)(F.ws + WS_ZT);
    const bf16* kn = (const bf16*)(F.ws + WS_KRN) + (size_t)d * 2 * SL; const bf16* kc = (const bf16*)(F.ws + WS_KRC) + (size_t)d * 2 * CL;
    P.kf = *(const GAS u32x4*)(kn + 8 * tid); P.kb = *(const GAS u32x4*)(kn + SL + 8 * tid);
    P.kc = *(const GAS u32x4*)(kc + ((tid >> 5) & 1) * CL + 8 * (tid & 31));
    { const int b = tid >> 7, t0 = (tid & 127) * 32, col0 = b * SL + t0;
      zchunk_load<4>(P.zv, ZT + (size_t)(4096 + d) * ZLD, col0, t0, SL); zchunk_load<4>(P.zx, ZT + (size_t)(2048 + d) * ZLD, col0, t0, SL); }
    { const int b = (tid >> 5) & 3, t0 = (tid & 31) * 8, col0 = TL + b * CL + t0;
      zchunk_load<1>(P.cv, ZT + (size_t)(4096 + d) * ZLD, col0, t0, CL); zchunk_load<1>(P.cx, ZT + (size_t)(2048 + d) * ZLD, col0, t0, CL); }
}

__device__ __forceinline__ void p_conv(Frame& F) {
    LAS unsigned char* lds = F.lds;
    const bf16* ZT = (const bf16*)(F.ws + WS_ZT); bf16* YXT = (bf16*)(F.ws + WS_YXT);
    const float* cw = F.in[I_HCW]; const float* cbp = F.in[I_HCB];
    const int tid = F.tid, lane = F.lane, w = F.wave, g = w & 1, q = w >> 1, r = lane & 15, h4 = lane >> 4, Isub = r >> 2, bb = r & 3;
    for (int i = tid; i < 128; i += NTHR) ((LAS unsigned*)(lds + CV_ZERO))[i] = 0u;
    ConvPre P;
    if (F.c < D) conv_issue(P, F, F.c);
#pragma unroll 1
    for (int d = F.c; d < D; d += F.G) {
        __syncthreads();
        float nl = 0.f, nc = 0.f;
        { LAS bf16* KR = (LAS bf16*)(lds + CV_KR);
          const unsigned fwv[4] = {P.kf.x, P.kf.y, P.kf.z, P.kf.w}, bwv[4] = {P.kb.x, P.kb.y, P.kb.z, P.kb.w};
#pragma unroll
          for (int e = 0; e < 8; ++e) { const int j = 8 * tid + e; const unsigned short fv = (unsigned short)(fwv[e >> 1] >> (16 * (e & 1))), bv = (unsigned short)(bwv[e >> 1] >> (16 * (e & 1)));
              KR[SL - j] = fv; nl += fabsf(bf2f(fv));
              if (j > 0) { KR[SL + j] = bv; nl += fabsf(bf2f(bv)); } }
          if (tid == 0) KR[0] = 0;
          if (tid < 64) { LAS bf16* KC = (LAS bf16*)(lds + CV_KRC); const int dirn = tid >> 5, j0 = 8 * (tid & 31);
              const unsigned cv4[4] = {P.kc.x, P.kc.y, P.kc.z, P.kc.w};
#pragma unroll
              for (int e = 0; e < 8; ++e) { const int j = j0 + e; const unsigned short v = (unsigned short)(cv4[e >> 1] >> (16 * (e & 1)));
                  if (dirn == 0) { KC[CL - j] = v; nc += fabsf(bf2f(v)); } else if (j > 0) { KC[CL + j] = v; nc += fabsf(bf2f(v)); } }
              if (tid == 0) KC[0] = 0; } }
        { const int chv = 4096 + d, chx = 2048 + d;
          const float v0 = cw[chv], v1 = cw[6144 + chv], v2 = cw[12288 + chv], vb = cbp[chv], x0 = cw[chx], x1 = cw[6144 + chx], x2 = cw[12288 + chx], xb = cbp[chx];
          { const int b = tid >> 7, t0 = (tid & 127) * 32; float zv[32], zx[32];
            zchunk_conv3<4>(P.zv, t0, SL, v0, v1, v2, vb, zv); zchunk_conv3<4>(P.zx, t0, SL, x0, x1, x2, xb, zx);
            LAS unsigned char* dst = lds + CV_V + b * CV_VB + (t0 >> 8) * CV_VJ + (t0 & 255) * 2;
#pragma unroll
            for (int i = 0; i < 4; ++i) { u32x4 o; o.x = pk2(zv[8 * i] * zx[8 * i], zv[8 * i + 1] * zx[8 * i + 1]); o.y = pk2(zv[8 * i + 2] * zx[8 * i + 2], zv[8 * i + 3] * zx[8 * i + 3]);
                o.z = pk2(zv[8 * i + 4] * zx[8 * i + 4], zv[8 * i + 5] * zx[8 * i + 5]); o.w = pk2(zv[8 * i + 6] * zx[8 * i + 6], zv[8 * i + 7] * zx[8 * i + 7]); *(LAS u32x4*)(dst + 16 * i) = o; } }
          { const int b = (tid >> 5) & 3, t0 = (tid & 31) * 8; float zv[8], zx[8];
            zchunk_conv3<1>(P.cv, t0, CL, v0, v1, v2, vb, zv); zchunk_conv3<1>(P.cx, t0, CL, x0, x1, x2, xb, zx);
            u32x4 o; o.x = pk2(zv[0] * zx[0], zv[1] * zx[1]); o.y = pk2(zv[2] * zx[2], zv[3] * zx[3]); o.z = pk2(zv[4] * zx[4], zv[5] * zx[5]); o.w = pk2(zv[6] * zx[6], zv[7] * zx[7]);
            if (tid < 128) *(LAS u32x4*)(lds + CV_VC + b * CV_VCB + t0 * 2) = o; } }
        nl = wave_sum(nl); nc = wave_sum(nc);
        if (lane == 0) { ((LAS float*)(lds + CV_RED))[w] = nl; ((LAS float*)(lds + CV_RED))[8 + w] = nc; }
        __syncthreads();
        const int I_ep = 4 * q + Isub, t0l = 256 * I_ep + 128 * g + 32 * h4, col0l = bb * SL + t0l, t0c = 128 * g + 32 * h4, col0c = TL + bb * CL + t0c;
        ZChunk<4> xl_, xc_;
        zchunk_load<4>(xl_, ZT + (size_t)d * ZLD, col0l, t0l, SL);
        { const int dn = d + F.G; conv_issue(P, F, dn < D ? dn : d); }
        float inv_l = 0.f, inv_c = ((LAS float*)(lds + CV_RED))[8];
#pragma unroll
        for (int i = 0; i < 8; ++i) inv_l += ((LAS float*)(lds + CV_RED))[i];
        inv_l = 1.0f / inv_l; inv_c = 1.0f / inv_c;
        const float skip = F.in[I_SKIP][d];
        const float c0 = cw[d], c1 = cw[6144 + d], c2 = cw[12288 + d], cb0 = cbp[d];
        {
            f32x4 acc[8];
#pragma unroll
            for (int i = 0; i < 8; ++i) acc[i] = (f32x4){0.f, 0.f, 0.f, 0.f};
#define CV_BASES(dl_, ap_, bp_) do { const int J_ = 4 * q + Isub - (dl_); const bool v_ = (J_ >= 0) && (J_ <= 15); \
                bp_ = v_ ? lds + CV_V + bb * CV_VB + J_ * CV_VJ + h4 * 16 : lds + CV_ZERO + h4 * 16; \
                ap_ = lds + CV_KR + (SL - 256 * (dl_) - 128 * g - 8 * r + 8 * h4 - 8) * 2; } while (0)
            const LAS unsigned char *ap, *bp, *apn, *bpn;
            CV_BASES(4 * q - 15, ap, bp);
            u32x4 ca = *(const LAS u32x4*)(ap), cbv = *(const LAS u32x4*)(ap + 16); bf16x8 bfr = *(const LAS bf16x8*)(bp);
#pragma unroll 1
            for (int dl = 4 * q - 15; dl <= 4 * q + 3; ++dl) {
                { const int dn_ = dl < 4 * q + 3 ? dl + 1 : dl; CV_BASES(dn_, apn, bpn); }
#pragma unroll
                for (int kk = 0; kk < 8; ++kk) {
                    const LAS unsigned char* an_ = kk < 7 ? ap + 64 * (kk + 1) : apn; const LAS unsigned char* bn_ = kk < 7 ? bp + 64 * (kk + 1) : bpn;
                    const u32x4 can = *(const LAS u32x4*)(an_), cbn = *(const LAS u32x4*)(an_ + 16); const bf16x8 bfn = *(const LAS bf16x8*)(bn_);
                    __builtin_amdgcn_sched_barrier(0);
                    const unsigned dd[8] = {ca.x, ca.y, ca.z, ca.w, cbv.x, cbv.y, cbv.z, cbv.w};
                    CV_MMA8(acc, dd, bfr);
                    __builtin_amdgcn_sched_barrier(0);
                    ca = can; cbv = cbn; bfr = bfn;
                }
                ap = apn; bp = bpn;
            }
#undef CV_BASES
            float x0c[32]; zchunk_conv3<4>(xl_, t0l, SL, c0, c1, c2, cb0, x0c);
            const LAS unsigned char* vp = lds + CV_V + bb * CV_VB + I_ep * CV_VJ + (128 * g + 32 * h4) * 2;
#pragma unroll
            for (int i = 0; i < 4; ++i) { const u32x4 vv = *(const LAS u32x4*)(vp + 16 * i); const unsigned vw[4] = {vv.x, vv.y, vv.z, vv.w}; unsigned ow[4];
#pragma unroll
                for (int p = 0; p < 4; ++p) { const int e0 = 8 * i + 2 * p, e1 = e0 + 1;
                    const float y0 = (acc[e0 & 7][e0 >> 3] * inv_l + skip * bflo(vw[p])) * x0c[e0], y1 = (acc[e1 & 7][e1 >> 3] * inv_l + skip * bfhi(vw[p])) * x0c[e1];
                    ow[p] = pk2(y0, y1); }
                *(GAS u32x4*)(YXT + (size_t)d * ZLD + col0l + 8 * i) = (u32x4){ow[0], ow[1], ow[2], ow[3]}; }
        }
        zchunk_load<4>(xc_, ZT + (size_t)d * ZLD, col0c, t0c, CL);
        if (w < 2) {
            f32x4 acc[8];
#pragma unroll
            for (int i = 0; i < 8; ++i) acc[i] = (f32x4){0.f, 0.f, 0.f, 0.f};
            const bool valid = Isub == 0;
            const LAS unsigned char* bp = valid ? lds + CV_VC + bb * CV_VCB + h4 * 16 : lds + CV_ZERO + h4 * 16;
            const int xb = CL - 128 * g - 8 * r + 8 * h4;
            const LAS unsigned char* ap = lds + CV_KRC + (xb - 8) * 2;
#pragma unroll
            for (int kk = 0; kk < 8; ++kk) {
                const u32x4 ca = *(const LAS u32x4*)(ap + 64 * kk), cbv = *(const LAS u32x4*)(ap + 64 * kk + 16);
                const bf16x8 bfr = *(const LAS bf16x8*)(bp + 64 * kk);
                const unsigned dd[8] = {ca.x, ca.y, ca.z, ca.w, cbv.x, cbv.y, cbv.z, cbv.w};
                CV_MMA8(acc, dd, bfr);
            }
            float x0c[32]; zchunk_conv3<4>(xc_, t0c, CL, c0, c1, c2, cb0, x0c);
            const LAS unsigned char* vp = lds + CV_VC + bb * CV_VCB + t0c * 2;
            u32x4 outv[4];
#pragma unroll
            for (int i = 0; i < 4; ++i) { const u32x4 vv = *(const LAS u32x4*)(vp + 16 * i); const unsigned vw[4] = {vv.x, vv.y, vv.z, vv.w}; unsigned ow[4];
#pragma unroll
                for (int p = 0; p < 4; ++p) { const int e0 = 8 * i + 2 * p, e1 = e0 + 1;
                    const float y0 = (acc[e0 & 7][e0 >> 3] * inv_c + skip * bflo(vw[p])) * x0c[e0], y1 = (acc[e1 & 7][e1 >> 3] * inv_c + skip * bfhi(vw[p])) * x0c[e1];
                    ow[p] = pk2(y0, y1); }
                outv[i] = (u32x4){ow[0], ow[1], ow[2], ow[3]}; }
            if (valid) {
#pragma unroll
                for (int i = 0; i < 4; ++i) *(GAS u32x4*)(YXT + (size_t)d * ZLD + col0c + 8 * i) = outv[i]; }
        }
    }
}

__device__ __forceinline__ void p_transpose_yx(Frame& F) {
    const bf16* src = (const bf16*)(F.ws + WS_YXT); bf16* dst = (bf16*)(F.ws + WS_YX);
    LAS unsigned short* scr = (LAS unsigned short*)(F.lds + F.wave * 8704);
    const int gw = F.c * NWAVES + F.wave, NGW = F.G * NWAVES, lane = F.lane;
    constexpr int NT_T = TT / 64, NTILES = (D / 64) * NT_T;
    for (int it = gw; it < NTILES; it += NGW) {
        const int cb = it / NT_T, tb = it - cb * NT_T, c0 = 64 * cb, tk0 = 64 * tb;
        u32x4 v[8];
#pragma unroll
        for (int i = 0; i < 8; ++i) v[i] = *(const GAS u32x4*)(src + (size_t)(c0 + 8 * i + (lane >> 3)) * ZLD + tk0 + 8 * (lane & 7));
#pragma unroll
        for (int i = 0; i < 8; ++i) { LAS unsigned* s = (LAS unsigned*)(scr + (8 * i + (lane >> 3)) * 68 + 8 * (lane & 7)); s[0] = v[i].x; s[1] = v[i].y; s[2] = v[i].z; s[3] = v[i].w; }
        LDS_WAIT(); asm volatile("" ::: "memory");
#pragma unroll
        for (int j = 0; j < 8; ++j) { const int tk = 8 * j + (lane >> 3), cc = 8 * (lane & 7); unsigned short e[8];
#pragma unroll
            for (int k = 0; k < 8; ++k) e[k] = scr[(cc + k) * 68 + tk];
            u32x4 o; o.x = e[0] | ((unsigned)e[1] << 16); o.y = e[2] | ((unsigned)e[3] << 16); o.z = e[4] | ((unsigned)e[5] << 16); o.w = e[6] | ((unsigned)e[7] << 16);
            *(GAS u32x4*)(dst + (size_t)(tk0 + tk) * D + c0 + cc) = o; }
        LDS_WAIT(); asm volatile("" ::: "memory");
    }
}
constexpr int S5_HS = 9216;
__device__ __forceinline__ size_t s5_row(int ti, int tau, int b, int dir) {
    if (ti < 8) { const int pos = 32 * ti + tau; return (size_t)(TL + b * CL + (dir ? CL - 1 - pos : pos)); }
    const int pos = 32 * (ti - 8) + tau; return (size_t)(b * SL + (dir ? SL - 1 - pos : pos));
}
__device__ __forceinline__ void p_s5(Frame& F) {
    if (F.wave >= 4) {
        cvt_weights(F, CVT_N_L0, CVT_NITEMS, F.c * 4 + (F.wave - 4), F.G * 4, (LAS float*)(F.lds + 4 * S5_HS + (F.wave - 4) * 8448)); return; }
    const int lane = F.lane, w = F.wave;
    const bf16* U = (const bf16*)(F.ws + WS_U);
    LAS unsigned char* Hs = F.lds + w * S5_HS;
    for (int sq = F.c * 4 + w; sq < 1024; sq += F.G * 4) {
        const int g = sq & 127, db = sq >> 7, dir = db >> 2, b = db & 3, pg = dir * 128 + g;
        const float step = __expf(F.in[I_SLOG][pg]);
        float lr, li;
        { const float ar = F.in[I_SARE][pg * 64 + lane], ai = F.in[I_SAIM][pg * 64 + lane]; const float er = expf(ar * step); float sn, cs; sincosf(ai * step, &sn, &cs); lr = er * cs; li = er * sn; }
        bf16x8 Bf[2][2];
#pragma unroll
        for (int ph = 0; ph < 2; ++ph) { const int p = 32 * ph + (lane & 31), hh = lane >> 5;
            const float ar = F.in[I_SARE][pg * 64 + p], ai = F.in[I_SAIM][pg * 64 + p]; const float er = expf(ar * step); float sn, cs; sincosf(ai * step, &sn, &cs);
            const float nr = er * cs - 1.0f, ni = er * sn, dn = 1.0f / (ar * ar + ai * ai); const float cr = (nr * ar + ni * ai) * dn, ci = (ni * ar - nr * ai) * dn;
            const float* br = F.in[I_SBRE] + ((size_t)pg * 64 + p) * 16 + 8 * hh; const float* bi = F.in[I_SBIM] + ((size_t)pg * 64 + p) * 16 + 8 * hh;
            unsigned wr_[4], wi_[4];
#pragma unroll
            for (int j = 0; j < 4; ++j) { const float r0 = br[2 * j], r1 = br[2 * j + 1], i0 = bi[2 * j], i1 = bi[2 * j + 1];
                wr_[j] = pk2(cr * r0 - ci * i0, cr * r1 - ci * i1); wi_[j] = pk2(cr * i0 + ci * r0, cr * i1 + ci * r1); }
            Bf[0][ph] = __builtin_bit_cast(bf16x8, (u32x4){wr_[0], wr_[1], wr_[2], wr_[3]}); Bf[1][ph] = __builtin_bit_cast(bf16x8, (u32x4){wi_[0], wi_[1], wi_[2], wi_[3]}); }
        bf16x8 Cf[4];
#pragma unroll
        for (int ks = 0; ks < 4; ++ks) { const int hp = lane & 15, p0 = 16 * ks + 4 * (lane >> 4);
            const float* crp = F.in[I_SCRE] + ((size_t)pg * 16 + hp) * 64 + p0; const float* cip = F.in[I_SCIM] + ((size_t)pg * 16 + hp) * 64 + p0;
            Cf[ks] = __builtin_bit_cast(bf16x8, (u32x4){pk2(crp[0], -cip[0]), pk2(crp[1], -cip[1]), pk2(crp[2], -cip[2]), pk2(crp[3], -cip[3])}); }
        bf16* Yp = (bf16*)(F.ws + (dir ? WS_YB : WS_YF));
        float hr = 0.f, hi = 0.f;
#define urow(ti_, tau_) s5_row((ti_), (tau_), b, dir)
        const int tau_a = lane & 31, coff = 16 * g + 8 * (lane >> 5);
        bf16x8 u0 = *(const GAS bf16x8*)(U + urow(0, tau_a) * D + coff), u1 = *(const GAS bf16x8*)(U + urow(1, tau_a) * D + coff);
#pragma unroll 1
        for (int ti = 0; ti < 136; ++ti) {
            const bf16x8 u2 = *(const GAS bf16x8*)(U + urow(ti + 2 < 136 ? ti + 2 : 135, tau_a) * D + coff);
            f32x16 z16;
#pragma unroll
            for (int i = 0; i < 16; ++i) z16[i] = 0.f;
            f32x16 aR0 = __builtin_amdgcn_mfma_f32_32x32x16_bf16(u0, Bf[0][0], z16, 0, 0, 0), aR1 = __builtin_amdgcn_mfma_f32_32x32x16_bf16(u0, Bf[0][1], z16, 0, 0, 0);
            f32x16 aI0 = __builtin_amdgcn_mfma_f32_32x32x16_bf16(u0, Bf[1][0], z16, 0, 0, 0), aI1 = __builtin_amdgcn_mfma_f32_32x32x16_bf16(u0, Bf[1][1], z16, 0, 0, 0);
            float bur[32], bui[32];
#pragma unroll
            for (int r = 0; r < 16; ++r) {
                const float fa = aR0[r], fb = aR1[r], fc = aI0[r], fd = aI1[r];
                auto sr = __builtin_amdgcn_permlane32_swap(__float_as_uint(fa), __float_as_uint(fb), false, false);
                auto si = __builtin_amdgcn_permlane32_swap(__float_as_uint(fc), __float_as_uint(fd), false, false);
                const unsigned sr0 = sr[0], sr1 = sr[1], si0 = si[0], si1 = si[1];
                const int tA = (r & 3) + 8 * (r >> 2);
                bur[tA] = __uint_as_float(sr0); bur[tA + 4] = __uint_as_float(sr1); bui[tA] = __uint_as_float(si0); bui[tA + 4] = __uint_as_float(si1); }
            const bool out_tile = ti >= 8;
#pragma unroll
            for (int tau = 0; tau < 32; ++tau) {
                const float t1 = __builtin_fmaf(lr, hr, bur[tau]), t2 = __builtin_fmaf(lr, hi, bui[tau]);
                const float nhr = __builtin_fmaf(-li, hi, t1), nhi = __builtin_fmaf(li, hr, t2);
                hr = nhr; hi = nhi;
                if (out_tile) *(LAS unsigned*)(Hs + tau * 288 + lane * 4) = pg8::cvt_pk_bf16(hr, hi);
            }
            if (out_tile) {
                asm volatile("s_waitcnt lgkmcnt(0)" ::: "memory");
#pragma unroll
                for (int mt = 0; mt < 2; ++mt) { f32x4 ay = {0.f, 0.f, 0.f, 0.f};
#pragma unroll
                    for (int ks = 0; ks < 4; ++ks) { const bf16x8 hf = *(const LAS bf16x8*)(Hs + (16 * mt + (lane & 15)) * 288 + (32 * ks + 8 * (lane >> 4)) * 2);
                        ay = __builtin_amdgcn_mfma_f32_16x16x32_bf16(Cf[ks], hf, ay, 0, 0, 0); }
                    u32x2 o; o.x = pk2(ay[0], ay[1]); o.y = pk2(ay[2], ay[3]);
                    *(GAS u32x2*)(Yp + urow(ti, 16 * mt + (lane & 15)) * D + 16 * g + 4 * (lane >> 4)) = o; }
                asm volatile("s_waitcnt lgkmcnt(0)" ::: "memory");
            }
            u0 = u1; u1 = u2;
        }
#undef urow
    }
}
__device__ __forceinline__ float gelu_tanh(float x) { const float u = 0.7978845608028654f * (x + 0.044715f * x * x * x); const float e = __expf(2.0f * u); const float th = 1.0f - 2.0f / (e + 1.0f); return 0.5f * x * (1.0f + th); }
__device__ __forceinline__ void p_s5_gelu(Frame& F) {
    const bf16* U = (const bf16*)(F.ws + WS_U); const bf16* YF = (const bf16*)(F.ws + WS_YF); const bf16* YB = (const bf16*)(F.ws + WS_YB); bf16* Gb = (bf16*)(F.ws + WS_G);
    const float* dsk = F.in[I_SD];
    const size_t n8 = (size_t)TL * D / 8, stride = (size_t)F.G * NTHR;
    for (size_t i = (size_t)F.c * NTHR + F.tid; i < n8; i += stride) {
        const u32x4 u = *(const GAS u32x4*)(U + 8 * i), a = *(const GAS u32x4*)(YF + 8 * i), b = *(const GAS u32x4*)(YB + 8 * i);
        const int c = (int)((8 * i) & 2047); const f32x4 d0 = *(const GAS f32x4*)(dsk + c), d1 = *(const GAS f32x4*)(dsk + c + 4);
        const unsigned uw[4] = {u.x, u.y, u.z, u.w}, aw[4] = {a.x, a.y, a.z, a.w}, bw[4] = {b.x, b.y, b.z, b.w}; const float dv[8] = {d0[0], d0[1], d0[2], d0[3], d1[0], d1[1], d1[2], d1[3]}; unsigned ow[4];
#pragma unroll
        for (int p = 0; p < 4; ++p) { const float y0 = dv[2 * p] * bflo(uw[p]) + bflo(aw[p]) + bflo(bw[p]), y1 = dv[2 * p + 1] * bfhi(uw[p]) + bfhi(aw[p]) + bfhi(bw[p]);
            ow[p] = pk2(gelu_tanh(y0), gelu_tanh(y1)); }
        *(GAS u32x4*)(Gb + 8 * i) = (u32x4){ow[0], ow[1], ow[2], ow[3]};
    }
}
#ifndef MK_N_LAUNCHES
#define MK_N_LAUNCHES 1
#endif
constexpr int N_PHASES = 17;

__device__ __forceinline__ void moe_rowtab(Frame& F, int nrb) {
    const LAS int* rb_e = (const LAS int*)(F.lds + TAB_OFF); const LAS int* rbfirst = rb_e + 168; const LAS int* cnt = rbfirst + 33;
    LAS unsigned* rowtab = (LAS unsigned*)(F.lds + ROWTAB_OFF); const int* list = (const int*)(F.ws + WS_LIST);
    for (int i = 0; i < 8; ++i) { const int L = i * F.G + F.c; if (L >= nrb * 8) break;
        const int rbi = L >> 3, e = rb_e[rbi], rbl = rbi - rbfirst[e];
        if (F.tid < 256) { const int slot = rbl * 256 + F.tid; const int tok = slot < cnt[e] ? list[(size_t)e * TT + slot] : 0; rowtab[i * 256 + F.tid] = (unsigned)tok * (unsigned)(D * 2); } }
    __syncthreads();
}

__global__ void __launch_bounds__(NTHR, 2) mega_fwd(Params P) {
    extern __shared__ __attribute__((aligned(16))) unsigned char lds_raw[];
    Frame F;
    F.lds = (LAS unsigned char*)lds_raw; F.ws = P.ws; F.ctl = (unsigned*)(P.ws + WS_CTL); F.in = P.in; F.out = P.out;
    F.tid = threadIdx.x; F.lane = F.tid & 63; F.wave = __builtin_amdgcn_readfirstlane(F.tid >> 6); F.G = gridDim.x; F.c = blockIdx.x;
    volatile LAS unsigned* MISC = (volatile LAS unsigned*)(F.lds + MISC_OFF);
    if (F.tid < 4) MISC[F.tid] = 0u;
    __syncthreads();
    XcdBarrier bar; bar.bar = F.ctl + CW_BAR; bar.x = 0; bar.st = MISC;
    if (MK_N_LAUNCHES == 1) bar = xcd_barrier_post(F.ctl + CW_BAR, MISC);
    const int lo = P.ph_lo, hi = P.ph_hi;
#define IN(k) (lo <= (k) && (k) < hi)
#define SEAM(k) do { if (IN(k) && IN((k) + 1)) xcd_barrier(bar); } while (0)
#ifndef PROBE_REP
#define PROBE_REP -1
#endif
    const size_t TS2048 = (size_t)256 * 2048 * 2, TS1024 = (size_t)256 * 1024 * 2;

#define RUN(k, ...) if (IN(k)) { __VA_ARGS__ if (PROBE_REP == (k)) { xcd_barrier(bar); __VA_ARGS__ } } SEAM(k);
#ifdef PROBE_A
    RUN(0, p0_prologue(F); __syncthreads(); p0_prologue(F); p0_weights(F);)
#else
    RUN(0, p0_prologue(F); p0_weights(F);)
#endif
    RUN(1, p_norm1_l0(F);)
    RUN(2, {
        pg8::DenseOrder S; S.init(F.ws + WS_WIN, F.ws + WS_U, 6144, TT, 2048, F.G, F.c);
        pg8::EpiZT E{(bf16*)(F.ws + WS_ZT), ZLD, F.in[I_HBIN]};
        pg8::gemm_phase<pg8::EpiZT, pg8::DenseOrder, false>(F.lds, 2048, S, E, nullptr); })
    RUN(3, p_conv(F);)
    RUN(4, p_transpose_yx(F);)
    RUN(5, {
        pg8::DenseOrder S; S.init(F.ws + WS_YX, F.ws + WS_WOUT, TT, 2048, 2048, F.G, F.c);
        pg8::EpiRes E{F.in[I_X], F.out, MODP(F, 0, 0) + 4096, F.in[I_CTX], (float*)(F.ws + WS_XC), MODP(F, 0, 4) + 4096, 12288, F.in[I_HBOUT]};
        pg8::gemm_phase<pg8::EpiRes, pg8::DenseOrder, false>(F.lds, 2048, S, E, nullptr); })
#define MOE_PHASES(l, P_R, P_GU, P_DN, NTOK) \
    RUN(P_R, p_router(F, (l), (NTOK));) \
    RUN(P_GU, { const int nrb = moe_tables(F, (l)); moe_rowtab(F, nrb); \
        pg8::MoeOrder S{(const char*)(F.ws + WS_U), (const char*)(F.ws + WS_WGU) + (size_t)(l) * 32 * 2048 * 2048 * 2, (const LAS int*)(F.lds + TAB_OFF), nrb, 8, F.G, F.c, 0, TS2048, (size_t)2048 * 2048 * 2, true}; \
        pg8::EpiGU E{(bf16*)(F.ws + WS_H), 1024}; \
        pg8::gemm_phase<pg8::EpiGU, pg8::MoeOrder, true>(F.lds, 2048, S, E, (const LAS unsigned*)(F.lds + ROWTAB_OFF)); }) \
    RUN(P_DN, { const int nrb = moe_tables(F, (l)); \
        pg8::MoeOrder S{(const char*)(F.ws + WS_H), (const char*)(F.ws + WS_WD) + (size_t)(l) * 32 * 2048 * 1024 * 2, (const LAS int*)(F.lds + TAB_OFF), nrb, 8, F.G, F.c, TS1024, TS1024, (size_t)2048 * 1024 * 2, false}; \
        pg8::EpiBf E{(bf16*)(F.ws + WS_EO), 2048}; \
        pg8::gemm_phase<pg8::EpiBf, pg8::MoeOrder, false>(F.lds, 1024, S, E, nullptr); })
    MOE_PHASES(0, 6, 7, 8, TT)
    RUN(9, p_comb_norm1_l1(F);)
    RUN(10, p_s5(F);)
    RUN(11, p_s5_gelu(F);)
    RUN(12, {
        pg8::DenseOrder S; S.init(F.ws + WS_G, F.ws + WS_W12, TL, 4096, 2048, F.G, F.c);
        pg8::EpiGlu E{F.out, MODP(F, 1, 0) + 4096, 12288, F.in[I_SB1], F.in[I_SB2]};
        pg8::gemm_phase<pg8::EpiGlu, pg8::DenseOrder, false>(F.lds, 2048, S, E, nullptr); })
    MOE_PHASES(1, 13, 14, 15, TL)
    if (IN(16)) { p_final(F); }
#undef IN
#undef SEAM
}

extern "C" void kernel_launch(void* const* d_in, const int* in_sizes, int n_in, void* d_out, int out_size, void* d_ws, size_t ws_size, hipStream_t stream) {
    static int grid = 0;
    if (grid == 0) {
        if (n_in != 40 || out_size != TL * D || ws_size < WS_END) { fprintf(stderr, "kernel_launch: unexpected shapes (n_in %d, out %d, ws %zu)\n", n_in, out_size, ws_size); grid = -1; return; }
        int dev = 0, cus = 0, per_cu = 0;
        if (hipGetDevice(&dev) != hipSuccess || hipDeviceGetAttribute(&cus, hipDeviceAttributeMultiprocessorCount, dev) != hipSuccess) { grid = -1; return; }
        if (hipFuncSetAttribute((const void*)mega_fwd, hipFuncAttributeMaxDynamicSharedMemorySize, LDS_BYTES) != hipSuccess) { fprintf(stderr, "kernel_launch: hipFuncSetAttribute failed\n"); grid = -1; return; }
        if (hipOccupancyMaxActiveBlocksPerMultiprocessor(&per_cu, (const void*)mega_fwd, NTHR, LDS_BYTES) != hipSuccess || per_cu < 1) { fprintf(stderr, "kernel_launch: occupancy query reports %d blocks per CU\n", per_cu); }
        (void)hipGetLastError();
        grid = cus;
    }
    if (grid < 0) return;
    (void)hipMemsetAsync((char*)d_ws + WS_CTL, 0, CTL_BYTES, stream);
    Params p{};
    for (int i = 0; i < 40; ++i) p.in[i] = (const float*)d_in[i];
    p.out = (float*)d_out; p.ws = (unsigned char*)d_ws;
#if MK_N_LAUNCHES == 1
    p.ph_lo = 0; p.ph_hi = N_PHASES;
    hipLaunchKernelGGL(mega_fwd, dim3(grid), dim3(NTHR), LDS_BYTES, stream, p);
#else
    for (int k = 0; k < N_PHASES; ++k) { p.ph_lo = k; p.ph_hi = k + 1; hipLaunchKernelGGL(mega_fwd, dim3(grid), dim3(NTHR), LDS_BYTES, stream, p); }
#endif
}
```

```cpp
#define MK_N_LAUNCHES 1
#include <hip/hip_runtime.h>
#include <cstdio>
#include <cstdint>

#define LAS __attribute__((address_space(3)))
#define GAS __attribute__((address_space(1)))
typedef unsigned short bf16;
typedef short bf16x8 __attribute__((ext_vector_type(8)));
typedef float f32x4 __attribute__((ext_vector_type(4)));
typedef float f32x2 __attribute__((ext_vector_type(2)));
typedef float f32x16 __attribute__((ext_vector_type(16)));
typedef unsigned u32x4 __attribute__((ext_vector_type(4)));
typedef unsigned u32x2 __attribute__((ext_vector_type(2)));

constexpr int D = 2048, NB = 4, SL = 4096, CL = 256, TL = NB * SL  , TC = NB * CL  , TT = TL + TC  ;
constexpr int NE = 32, DE = 1024, NRB_MAX = 168, ZLD = TT;
constexpr float EPS = 1e-6f;
constexpr int NWAVES = 8, NTHR = 512;

constexpr size_t MiB = 1u << 20;
constexpr size_t WS_CTL = 0, CTL_BYTES = 1 * MiB;
constexpr size_t WS_MOD = 1 * MiB;
constexpr size_t WS_LIST = 2 * MiB;
constexpr size_t WS_TOKPOS = 5 * MiB;
constexpr size_t WS_GATE = 5 * MiB + 512 * 1024;
constexpr size_t WS_KRN = 6 * MiB;
constexpr size_t WS_KRC = 38 * MiB;
constexpr size_t WS_WIN = 40 * MiB;
constexpr size_t WS_WOUT = 64 * MiB;
constexpr size_t WS_W12 = 72 * MiB;
constexpr size_t WS_WGU = 88 * MiB;
constexpr size_t WS_WD = 600 * MiB;
constexpr size_t WS_XC = 856 * MiB;
constexpr size_t WS_U = 864 * MiB;
constexpr size_t WS_ZT = 932 * MiB;
constexpr size_t WS_YXT = 1136 * MiB;
constexpr size_t WS_YX = 1204 * MiB;
constexpr size_t WS_H = 1272 * MiB;
constexpr size_t WS_EO = 1356 * MiB;
constexpr size_t WS_END = 1524 * MiB;
constexpr size_t WS_YF = WS_ZT, WS_YB = WS_ZT + 64 * MiB, WS_G = WS_ZT + 128 * MiB;

constexpr int CW_TMO = 0;
constexpr int CW_BAR = 4096;
constexpr int CW_CVTQ = 3968;
constexpr int CW_CNT = 8192;

constexpr int LDS_BYTES = 147456;
constexpr int ROWTAB_OFF = 131072;
constexpr int TAB_OFF = 139264;
constexpr int MISC_OFF = 141312;

#define LDS_WAIT() asm volatile("s_waitcnt lgkmcnt(0)" ::: "memory")
#define VM_WAIT() asm volatile("s_waitcnt vmcnt(0)" ::: "memory")
__device__ __forceinline__ unsigned f2bf(float f) { unsigned u = __builtin_bit_cast(unsigned, f); return (u + 0x7fffu + ((u >> 16) & 1u)) >> 16; }
__device__ __forceinline__ unsigned pk2(float lo, float hi) { return f2bf(lo) | (f2bf(hi) << 16); }
__device__ __forceinline__ float bf2f(unsigned short b) { return __builtin_bit_cast(float, ((unsigned)b) << 16); }
__device__ __forceinline__ float bflo(unsigned w) { return __builtin_bit_cast(float, w << 16); }
__device__ __forceinline__ float bfhi(unsigned w) { return __builtin_bit_cast(float, w & 0xffff0000u); }
__device__ __forceinline__ float wave_sum(float v) {
#pragma unroll
    for (int o = 1; o < 64; o <<= 1) v += __shfl_xor(v, o);
    return v;
}
__device__ __forceinline__ float sigmoidf_(float x) { return 1.0f / (1.0f + __expf(-x)); }
__device__ __forceinline__ float siluf_(float x) { return x / (1.0f + __expf(-x)); }

#define XB_TMO      128
#define XB_XCNT(j)  (256  + 64 * (j))
#define XB_XSUB(j)  (1280 + 64 * (j))
#define XB_XGEN(j)  (2304 + 64 * (j))
#define XB_TOP      3328
#define XB_TOPGEN   3392
#define XCD_BAR_WORDS 3456
#define XB_SPIN_CAP (1u << 18)
__device__ __forceinline__ unsigned xb_ld(unsigned* p)              { return __hip_atomic_load(p, __ATOMIC_RELAXED, __HIP_MEMORY_SCOPE_AGENT); }
__device__ __forceinline__ unsigned xb_add(unsigned* p, unsigned v) { return __hip_atomic_fetch_add(p, v, __ATOMIC_RELAXED, __HIP_MEMORY_SCOPE_AGENT); }
__device__ __forceinline__ unsigned xb_xcc_id() { return (unsigned)__builtin_amdgcn_s_getreg((3 << 11) | 20) & 0xFu; }
#define XB_SPIN(cond, bar) do { unsigned _sp = 0; while (cond) { __builtin_amdgcn_s_sleep(1); \
    if ((++_sp & 255u) == 0u) { if (xb_ld(&(bar)[XB_TMO])) break; if (_sp > XB_SPIN_CAP) { atomicAdd(&(bar)[XB_TMO], 1u); break; } } } } while (0)
struct XcdBarrier { unsigned* bar; unsigned x; volatile LAS unsigned* st; };
__device__ __forceinline__ XcdBarrier xcd_barrier_post(unsigned* bar, volatile LAS unsigned* st) {
    XcdBarrier b; b.bar = bar; b.x = xb_xcc_id(); b.st = st;
    if (threadIdx.x == 0) (void)xb_add(&bar[XB_XCNT(b.x)], 1u);
    return b;
}
__device__ __forceinline__ void xcd_barrier_complete(unsigned* bar, unsigned x, unsigned& nloc, unsigned& nx) {
    const unsigned G = gridDim.x * gridDim.y * gridDim.z;
    unsigned sum, cnt, mine, sp = 0u;
    for (;;) {
        sum = 0u; cnt = 0u; mine = 0u;
#pragma unroll
        for (unsigned j = 0; j < 16; ++j) { const unsigned c = xb_ld(&bar[XB_XCNT(j)]); sum += c; cnt += (c > 0u) ? 1u : 0u; mine = (j == x) ? c : mine; }
        if (sum == G) break;
        __builtin_amdgcn_s_sleep(1);
        if ((++sp & 255u) == 0u) { if (xb_ld(&bar[XB_TMO])) break; if (sp > XB_SPIN_CAP) { atomicAdd(&bar[XB_TMO], 1u); break; } }
    }
    nloc = mine > 0u ? mine : 1u; nx = cnt > 0u ? cnt : 1u;
}
__device__ __forceinline__ void xcd_barrier(const XcdBarrier& b) {
    asm volatile("s_waitcnt vmcnt(0)" ::: "memory");
    __syncthreads();
    if (threadIdx.x == 0) {
        unsigned* bar = b.bar;
        __builtin_amdgcn_s_waitcnt(0);
        unsigned nloc = b.st[0], nx = b.st[1];
        if (nloc == 0u) { xcd_barrier_complete(bar, b.x, nloc, nx); b.st[0] = nloc; b.st[1] = nx; }
        const unsigned old = xb_add(&bar[XB_XSUB(b.x)], 1u);
        const unsigned gen = old / nloc;
        if (old + 1u == (gen + 1u) * nloc) {
            __builtin_amdgcn_fence(__ATOMIC_RELEASE, "agent");
            asm volatile("s_waitcnt vmcnt(0)" ::: "memory");
            const unsigned og = xb_add(&bar[XB_TOP], 1u);
            const unsigned tg = og / nx;
            if (og + 1u == (tg + 1u) * nx) xb_add(&bar[XB_TOPGEN], 1u);
            else XB_SPIN(xb_ld(&bar[XB_TOPGEN]) == tg, bar);
            __builtin_amdgcn_fence(__ATOMIC_ACQUIRE, "agent");
            xb_add(&bar[XB_XGEN(b.x)], 1u);
            asm volatile("s_waitcnt vmcnt(0)" ::: "memory");
        } else {
            XB_SPIN(xb_ld(&bar[XB_XGEN(b.x)]) == gen, bar);
            __builtin_amdgcn_fence(__ATOMIC_ACQUIRE, "agent");
            asm volatile("s_waitcnt vmcnt(0)" ::: "memory");
        }
    }
    __syncthreads();
}
namespace pg8 {
constexpr int BM = 256, BK = 64, HALF = 128, HTB = HALF * BK * 2, STAGE_BYTES = 8 * HTB, NXCD = 8, WGM = 8;
__device__ __forceinline__ int lds_byte(int r, int c) { const int st = (r >> 4) * 2 + (c >> 5), rr = r & 15, cc = c & 31, ob = rr * 64 + cc * 2; return st * 1024 + (ob ^ (((ob >> 9) & 1) << 5)); }
__device__ __forceinline__ void stage_rc(int b, int& R, int& C) { const int st = b / 1024, sb = b % 1024, swz = sb ^ (((sb >> 9) & 1) << 5); R = (st >> 1) * 16 + swz / 64; C = (st & 1) * 32 + (swz % 64) / 2; }
__device__ __forceinline__ int perm32(int rho) { const int n = rho >> 4, i = rho & 15; return 8 * (i >> 2) + 4 * n + (i & 3); }

struct Unit { const char* A; const char* B; int pm, pn, ui; };

struct DenseOrder {
    const char* A; const char* B; int nM, nN, nwg, G, c; size_t tstep;
    __device__ __forceinline__ void init(const void* A_, const void* B_, int M, int N, int K, int G_, int c_) { A = (const char*)A_; B = (const char*)B_; nM = M / BM; nN = N / BM; nwg = nM * nN; G = G_; c = c_; tstep = (size_t)BM * K * 2; }
    __device__ __forceinline__ bool next(int i, Unit& u) const {
        const long L = (long)i * G + c; if (L >= nwg) return false;
        int wgid = (int)L; { const int q = nwg / NXCD, r = nwg % NXCD, xcd = wgid % NXCD, off = wgid / NXCD; wgid = (xcd < r ? xcd * (q + 1) : r * (q + 1) + (xcd - r) * q) + off; }
        const int nig = WGM * nN, gid = wgid / nig, fm = gid * WGM, gsz = (nM - fm) < WGM ? (nM - fm) : WGM;
        u.pm = fm + ((wgid % nig) % gsz); u.pn = (wgid % nig) / gsz; u.ui = i;
        u.A = A + (size_t)u.pm * tstep; u.B = B + (size_t)u.pn * tstep; return true;
    }
};
struct MoeOrder {
    const char* A; const char* B; const LAS int* rb_e; int nrb, nN, G, c; size_t tstepA, tstepB, estepB; bool gather;
    __device__ __forceinline__ bool next(int i, Unit& u) const {
        const int L = i * G + c; if (L >= nrb * nN) return false;
        const int rbi = L / nN, pn = L - rbi * nN; const int e = rb_e[rbi];
        u.pm = rbi; u.pn = pn; u.ui = i; u.A = gather ? A : A + (size_t)rbi * tstepA; u.B = B + (size_t)e * estepB + (size_t)pn * tstepB; return true;
    }
};

__device__ __forceinline__ unsigned cvt_pk_bf16(float lo, float hi) { unsigned r; asm volatile("v_cvt_pk_bf16_f32 %0, %1, %2" : "=v"(r) : "v"(lo), "v"(hi)); return r; }

typedef f32x4 Acc[2][2][4][2];

struct EpiZT {
    static constexpr bool PERM = true;
    bf16* O; int ldc; const float* bias;
    __device__ __forceinline__ void operator()(const Acc& acc, const Unit& u, int wr, int wc, int fr, int fq) const {
        const int row0 = u.pm * BM + wr * 64 + fr, col0 = u.pn * BM + wc * 32 + 8 * fq;
#pragma unroll
        for (int ai = 0; ai < 2; ++ai)
#pragma unroll
            for (int m = 0; m < 4; ++m) { const int r = row0 + ai * HALF + m * 16; const float bv = bias[r]; bf16* rowp = O + (size_t)r * ldc + col0;
#pragma unroll
                for (int bj = 0; bj < 2; ++bj) { const f32x4 v0 = acc[ai][bj][m][0] + bv, v1 = acc[ai][bj][m][1] + bv;
                    u32x4 w; w.x = cvt_pk_bf16(v0[0], v0[1]); w.y = cvt_pk_bf16(v0[2], v0[3]); w.z = cvt_pk_bf16(v1[0], v1[1]); w.w = cvt_pk_bf16(v1[2], v1[3]);
                    *(u32x4*)(rowp + bj * HALF) = w; } }
    }
};
struct EpiBf {
    static constexpr bool PERM = true;
    bf16* O; int ldc;
    __device__ __forceinline__ void operator()(const Acc& acc, const Unit& u, int wr, int wc, int fr, int fq) const {
        const int row0 = u.pm * BM + wr * 64 + fr, col0 = u.pn * BM + wc * 32 + 8 * fq;
#pragma unroll
        for (int ai = 0; ai < 2; ++ai)
#pragma unroll
            for (int m = 0; m < 4; ++m) { bf16* rowp = O + (size_t)(row0 + ai * HALF + m * 16) * ldc + col0;
#pragma unroll
                for (int bj = 0; bj < 2; ++bj) { const f32x4 v0 = acc[ai][bj][m][0], v1 = acc[ai][bj][m][1];
                    u32x4 w; w.x = cvt_pk_bf16(v0[0], v0[1]); w.y = cvt_pk_bf16(v0[2], v0[3]); w.z = cvt_pk_bf16(v1[0], v1[1]); w.w = cvt_pk_bf16(v1[2], v1[3]);
                    *(u32x4*)(rowp + bj * HALF) = w; } }
    }
};
struct EpiGU {
    static constexpr bool PERM = true;
    bf16* O; int ldc;
    __device__ __forceinline__ void operator()(const Acc& acc, const Unit& u, int wr, int wc, int fr, int fq) const {
        const int row0 = u.pm * BM + wr * 64 + fr, col0 = u.pn * HALF + wc * 32 + 8 * fq;
#pragma unroll
        for (int ai = 0; ai < 2; ++ai)
#pragma unroll
            for (int m = 0; m < 4; ++m) { bf16* rowp = O + (size_t)(row0 + ai * HALF + m * 16) * ldc + col0;
                f32x4 h0, h1;
#pragma unroll
                for (int j = 0; j < 4; ++j) { h0[j] = siluf_(acc[ai][0][m][0][j]) * acc[ai][1][m][0][j]; h1[j] = siluf_(acc[ai][0][m][1][j]) * acc[ai][1][m][1][j]; }
                u32x4 w; w.x = cvt_pk_bf16(h0[0], h0[1]); w.y = cvt_pk_bf16(h0[2], h0[3]); w.z = cvt_pk_bf16(h1[0], h1[1]); w.w = cvt_pk_bf16(h1[2], h1[3]);
                *(u32x4*)rowp = w; }
    }
};
struct EpiRes {
    static constexpr bool PERM = false;
    const float* base_l; float* out_l; const float* gate_l;
    const float* base_c; float* out_c; const float* gate_c; int gstride; const float* bias;
    __device__ __forceinline__ void operator()(const Acc& acc, const Unit& u, int wr, int wc, int fr, int fq) const {
        const bool isc = u.pm >= TL / BM; const int prow = isc ? u.pm - TL / BM : u.pm;
        const float* base = isc ? base_c : base_l; float* out = isc ? out_c : out_l; const float* gate = isc ? gate_c : gate_l + (size_t)(u.pm / (SL / BM)) * gstride;
        const int row0 = prow * BM + wr * 64 + fr, col0 = u.pn * BM + wc * 32 + 4 * fq;
        f32x4 bv[2][2], gv[2][2];
#pragma unroll
        for (int bj = 0; bj < 2; ++bj)
#pragma unroll
            for (int n = 0; n < 2; ++n) { bv[bj][n] = *(const f32x4*)(bias + col0 + bj * HALF + n * 16); gv[bj][n] = *(const f32x4*)(gate + col0 + bj * HALF + n * 16); }
#pragma unroll
        for (int ai = 0; ai < 2; ++ai)
#pragma unroll
            for (int m = 0; m < 4; ++m) { const size_t off = (size_t)(row0 + ai * HALF + m * 16) * D + col0;
#pragma unroll
                for (int bj = 0; bj < 2; ++bj)
#pragma unroll
                    for (int n = 0; n < 2; ++n) { const f32x4 bs = *(const f32x4*)(base + off + bj * HALF + n * 16);
                        *(f32x4*)(out + off + bj * HALF + n * 16) = bs + gv[bj][n] * (acc[ai][bj][m][n] + bv[bj][n]); }
                asm volatile("" ::: "memory"); }
    }
};
struct EpiGlu {
    static constexpr bool PERM = false;
    float* x; const float* gate; int gstride; const float* b1; const float* b2;
    __device__ __forceinline__ void operator()(const Acc& acc, const Unit& u, int wr, int wc, int fr, int fq) const {
        const float* g = gate + (size_t)(u.pm / (SL / BM)) * gstride;
        const int row0 = u.pm * BM + wr * 64 + fr, col0 = u.pn * HALF + wc * 32 + 4 * fq;
        f32x4 b1v[2], b2v[2], gv[2];
#pragma unroll
        for (int n = 0; n < 2; ++n) { b1v[n] = *(const f32x4*)(b1 + col0 + n * 16); b2v[n] = *(const f32x4*)(b2 + col0 + n * 16); gv[n] = *(const f32x4*)(g + col0 + n * 16); }
#pragma unroll
        for (int ai = 0; ai < 2; ++ai)
#pragma unroll
            for (int m = 0; m < 4; ++m) { float* rowp = x + (size_t)(row0 + ai * HALF + m * 16) * D + col0;
#pragma unroll
                for (int n = 0; n < 2; ++n) { const f32x4 a = acc[ai][0][m][n] + b1v[n], b = acc[ai][1][m][n] + b2v[n]; f32x4 o;
#pragma unroll
                    for (int j = 0; j < 4; ++j) o[j] = a[j] * sigmoidf_(b[j]);
                    const f32x4 bs = *(const f32x4*)(rowp + n * 16); *(f32x4*)(rowp + n * 16) = bs + gv[n] * o; }
                asm volatile("" ::: "memory"); }
    }
};

template <class Epi, class Sched, bool GATHER>
__device__ __forceinline__ void gemm_phase(LAS unsigned char* lds, const int K, const Sched& S, const Epi& E, const LAS unsigned* rowtab) {
    const int tid = threadIdx.x, wid = __builtin_amdgcn_readfirstlane(tid >> 6), lane = tid & 63, wr = wid >> 2, wc = wid & 3, fr = lane & 15, fq = lane >> 4;
    const int nt = K / BK;
    unsigned voffB[2]; unsigned cv[2][2], nv[2][2]; int Rr[2], Cc[2];
    const size_t kstep = (size_t)(BK * 2);
    const size_t hstep = (size_t)HALF * K * 2;
#pragma unroll
    for (int i = 0; i < 2; ++i) { int R, C; stage_rc(tid * 16 + i * 8192, R, C); const int Rb = Epi::PERM ? ((R & ~31) + perm32(R & 31)) : R;
        Rr[i] = R; Cc[i] = C; voffB[i] = (unsigned)(Rb * K + C) * 2u;
        if constexpr (!GATHER) { cv[0][i] = (unsigned)(R * K + C) * 2u; cv[1][i] = cv[0][i] + (unsigned)hstep; } }
    const unsigned ldsw = (unsigned)wid * 1024u;
    const int aoff = lds_byte(wr * 64 + fr, fq * 8), boff = lds_byte(wc * 32 + fr, fq * 8);
#define PG8_SA(b, h) (((b) * 2 + (h)) * HTB)
#define PG8_SB(b, h) ((4 + (b) * 2 + (h)) * HTB)
#define PG8_STAGE(bufoff, gbase, voff) do { _Pragma("unroll") for (int _i = 0; _i < 2; ++_i) \
        __builtin_amdgcn_global_load_lds((const unsigned*)((const char*)(gbase) + (voff)[_i]), (LAS unsigned*)(lds + (bufoff) + ldsw + _i * 8192), 16, 0, 0); } while (0)
#define PG8_LDROWS(dst, uix) do { _Pragma("unroll") for (int _h = 0; _h < 2; ++_h) _Pragma("unroll") for (int _i = 0; _i < 2; ++_i) \
        dst[_h][_i] = rowtab[(uix) * 256 + _h * 128 + Rr[_i]] + (unsigned)(Cc[_i] * 2); } while (0)
#define PG8_LDA(dst, b, h) do { _Pragma("unroll") for (int m = 0; m < 4; ++m) _Pragma("unroll") for (int k = 0; k < 2; ++k) dst[m][k] = *(const LAS bf16x8*)(lds + PG8_SA(b, h) + aoff + m * 2048 + k * 1024); } while (0)
#define PG8_LDB(dst, b, h) do { _Pragma("unroll") for (int n = 0; n < 2; ++n) _Pragma("unroll") for (int k = 0; k < 2; ++k) dst[n][k] = *(const LAS bf16x8*)(lds + PG8_SB(b, h) + boff + n * 2048 + k * 1024); } while (0)
#define PG8_MMA(ai, bj, At, Bt) do { __builtin_amdgcn_s_setprio(1); _Pragma("unroll") for (int m = 0; m < 4; ++m) _Pragma("unroll") for (int n = 0; n < 2; ++n) _Pragma("unroll") for (int k = 0; k < 2; ++k) \
        acc[ai][bj][m][n] = __builtin_amdgcn_mfma_f32_16x16x32_bf16(Bt[n][k], At[m][k], acc[ai][bj][m][n], 0, 0, 0); __builtin_amdgcn_s_setprio(0); } while (0)
#define PG8_WAIT_V(n) asm volatile("s_waitcnt vmcnt(" #n ")" ::: "memory")
#define PG8_WAIT_L(n) asm volatile("s_waitcnt lgkmcnt(" #n ")" ::: "memory")
#define PG8_BAR __builtin_amdgcn_s_barrier()
#define PG8_SCHED __builtin_amdgcn_sched_barrier(0)
    Unit cur, nxt; int ui = 0;
    if (!S.next(0, cur)) return;
    Acc acc;
#pragma unroll
    for (int a = 0; a < 2; ++a)
#pragma unroll
        for (int b = 0; b < 2; ++b)
#pragma unroll
            for (int m = 0; m < 4; ++m)
#pragma unroll
                for (int n = 0; n < 2; ++n) acc[a][b][m][n] = (f32x4){0.f, 0.f, 0.f, 0.f};
    bf16x8 At[4][2], B0[2][2], B1[2][2];
    const char* cA = cur.A; const char* cB = cur.B;
    if constexpr (GATHER) { PG8_LDROWS(cv, cur.ui); PG8_WAIT_L(0); }
    PG8_STAGE(PG8_SB(0, 0), cB, voffB); PG8_STAGE(PG8_SB(0, 1), cB + hstep, voffB); PG8_STAGE(PG8_SA(0, 0), cA, cv[0]); PG8_STAGE(PG8_SA(0, 1), cA, cv[1]);
    if (wr == 1) PG8_BAR;
    PG8_WAIT_V(2); PG8_BAR;
    PG8_STAGE(PG8_SB(1, 0), cB + kstep, voffB); PG8_STAGE(PG8_SA(1, 0), cA + kstep, cv[0]); PG8_STAGE(PG8_SB(1, 1), cB + hstep + kstep, voffB);
    PG8_WAIT_V(6); PG8_BAR;
    for (;;) {
        const bool has_next = S.next(ui + 1, nxt);
        const char* nA = has_next ? nxt.A : cA; const char* nB = has_next ? nxt.B : cB;
        for (int t = 0; t < nt; t += 2) {
            const bool last = (t == nt - 2);
            const char* a1 = cA + (size_t)(t + 1) * kstep;
            const char* a2 = last ? nA : cA + (size_t)(t + 2) * kstep; const char* b2 = last ? nB : cB + (size_t)(t + 2) * kstep;
            const char* a3 = a2 + kstep; const char* b3 = b2 + kstep;
            if constexpr (GATHER) { if (last) { PG8_LDROWS(nv, has_next ? nxt.ui : cur.ui); } else {
#pragma unroll
                for (int h = 0; h < 2; ++h)
#pragma unroll
                    for (int i = 0; i < 2; ++i) nv[h][i] = cv[h][i]; } }
            else {
#pragma unroll
                for (int h = 0; h < 2; ++h)
#pragma unroll
                    for (int i = 0; i < 2; ++i) nv[h][i] = cv[h][i]; }
            PG8_LDB(B0, 0, 0); PG8_LDB(B1, 0, 1); PG8_SCHED; PG8_LDA(At, 0, 0); PG8_STAGE(PG8_SA(1, 1), a1, cv[1]);
            PG8_WAIT_V(8); PG8_WAIT_L(0); PG8_BAR; PG8_MMA(0, 0, At, B0); PG8_MMA(0, 1, At, B1); PG8_BAR; PG8_SCHED;
            PG8_LDA(At, 0, 1); PG8_STAGE(PG8_SB(0, 0), b2, voffB); PG8_STAGE(PG8_SB(0, 1), b2 + hstep, voffB); PG8_STAGE(PG8_SA(0, 0), a2, nv[0]);
            PG8_WAIT_V(8); PG8_WAIT_L(0); PG8_BAR; PG8_MMA(1, 0, At, B0); PG8_MMA(1, 1, At, B1); PG8_BAR; PG8_SCHED;
            PG8_LDB(B0, 1, 0); PG8_LDB(B1, 1, 1); PG8_SCHED; PG8_LDA(At, 1, 0); PG8_STAGE(PG8_SA(0, 1), a2, nv[1]);
            PG8_WAIT_V(8); PG8_WAIT_L(0); PG8_BAR; PG8_MMA(0, 0, At, B0); PG8_MMA(0, 1, At, B1); PG8_BAR; PG8_SCHED;
            PG8_LDA(At, 1, 1); PG8_STAGE(PG8_SB(1, 0), b3, voffB); PG8_STAGE(PG8_SB(1, 1), b3 + hstep, voffB); PG8_STAGE(PG8_SA(1, 0), a3, nv[0]);
            PG8_WAIT_V(8); PG8_WAIT_L(0); PG8_BAR; PG8_MMA(1, 0, At, B0); PG8_MMA(1, 1, At, B1); PG8_BAR; PG8_SCHED;
        }
        if (wr == 0) PG8_BAR;
        E(acc, cur, wr, wc, fr, fq);
        if (!has_next) break;
#pragma unroll
        for (int a = 0; a < 2; ++a)
#pragma unroll
            for (int b = 0; b < 2; ++b)
#pragma unroll
                for (int m = 0; m < 4; ++m)
#pragma unroll
                    for (int n = 0; n < 2; ++n) acc[a][b][m][n] = (f32x4){0.f, 0.f, 0.f, 0.f};
        cur = nxt; cA = nA; cB = nB; ++ui;
        if constexpr (GATHER) {
#pragma unroll
            for (int h = 0; h < 2; ++h)
#pragma unroll
                for (int i = 0; i < 2; ++i) cv[h][i] = nv[h][i]; }
        if (wr == 1) PG8_BAR;
    }
    PG8_WAIT_V(0);
    PG8_BAR;
#undef PG8_SA
#undef PG8_SB
#undef PG8_STAGE
#undef PG8_LDROWS
#undef PG8_LDA
#undef PG8_LDB
#undef PG8_MMA
#undef PG8_WAIT_V
#undef PG8_WAIT_L
#undef PG8_BAR
#undef PG8_SCHED
}
}
struct Params { const float* in[40]; float* out; unsigned char* ws; int ph_lo, ph_hi; };
enum { I_X = 0, I_C, I_CTX, I_CCTX, I_ADAW, I_ADAB, I_NORMG, I_FINALG, I_HWIN, I_HBIN, I_HCW, I_HCB, I_FW1, I_FB1, I_FW2, I_FB2, I_FW3, I_FREQ, I_SKIP, I_HWOUT, I_HBOUT,
       I_SARE, I_SAIM, I_SLOG, I_SBRE, I_SBIM, I_SCRE, I_SCIM, I_SD, I_SW1, I_SB1, I_SW2, I_SB2, I_MWG, I_MBG, I_MWE, I_MBE, I_MGATE, I_MUP, I_MDOWN };

struct Frame {
    LAS unsigned char* lds; unsigned* ctl; unsigned char* ws; const float* const* in; float* out;
    int tid, lane, wave, G, c;
};
#define MODP(F, l, r) ((const float*)((F).ws + WS_MOD) + ((size_t)(l) * 5 + (r)) * 12288)

struct TItem { const float* src; bf16* dst; int N, K; };
__device__ __forceinline__ void p0_item_load(f32x4 (&v)[8], const TItem& t, int lane) {
#pragma unroll
    for (int i = 0; i < 8; ++i) v[i] = *(const GAS f32x4*)(t.src + (size_t)(8 * i + (lane >> 3)) * t.N + 4 * (lane & 7));
}
__device__ __forceinline__ void p0_item_store(const f32x4 (&v)[8], const TItem& t, LAS float* scr, int lane) {
#pragma unroll
    for (int i = 0; i < 8; ++i) { LAS float* s = scr + (8 * i + (lane >> 3)) * 33 + 4 * (lane & 7); s[0] = v[i][0]; s[1] = v[i][1]; s[2] = v[i][2]; s[3] = v[i][3]; }
    LDS_WAIT(); asm volatile("" ::: "memory");
    const int c = lane & 7;
#pragma unroll
    for (int j = 0; j < 4; ++j) { const int n = (lane >> 3) + 8 * j; const LAS float* s = scr + (8 * c) * 33 + n;
        u32x4 o; o.x = pk2(s[0 * 33], s[1 * 33]); o.y = pk2(s[2 * 33], s[3 * 33]); o.z = pk2(s[4 * 33], s[5 * 33]); o.w = pk2(s[6 * 33], s[7 * 33]);
        *(GAS u32x4*)(t.dst + (size_t)n * t.K + 8 * c) = o; }
    LDS_WAIT(); asm volatile("" ::: "memory");
}
__device__ __forceinline__ TItem p0_job(const float* W, int K, int N, bf16* WT, bool ilv, int ilv_off, int idx) {
    const int nblk = N / 32, kb = idx / nblk, nb = idx - kb * nblk, n0 = 32 * nb, k0 = 64 * kb;
    const int drow0 = ilv ? ((n0 >> 7) * 256 + ilv_off + (n0 & 127)) : n0;
    TItem t; t.src = W + (size_t)k0 * N + n0; t.dst = WT + (size_t)drow0 * K + k0; t.N = N; t.K = K; return t;
}
__device__ __forceinline__ TItem p0_decode(const float* const* in, unsigned char* ws, int it) {
    constexpr int N_IN = 32 * 192, N_SQ = 32 * 64, N_E = 1024, N_L = 96 * N_E;
    int r = it;
    if (r < N_IN) return p0_job(in[I_HWIN], 2048, 6144, (bf16*)(ws + WS_WIN), false, 0, r); r -= N_IN;
    if (r < N_SQ) return p0_job(in[I_HWOUT], 2048, 2048, (bf16*)(ws + WS_WOUT), false, 0, r); r -= N_SQ;
    if (r < N_SQ) return p0_job(in[I_SW1], 2048, 2048, (bf16*)(ws + WS_W12), true, 0, r); r -= N_SQ;
    if (r < N_SQ) return p0_job(in[I_SW2], 2048, 2048, (bf16*)(ws + WS_W12), true, 128, r); r -= N_SQ;
    const int l = r / N_L; int q = r - l * N_L;
    if (q < 64 * N_E) { const int e = q / (2 * N_E), w2 = q - e * 2 * N_E, which = w2 / N_E, idx = w2 - which * N_E, le = l * 32 + e;
        return p0_job((which ? in[I_MUP] : in[I_MGATE]) + (size_t)le * 2048 * 1024, 2048, 1024, (bf16*)(ws + WS_WGU) + (size_t)le * 2048 * 2048, true, which ? 128 : 0, idx); }
    q -= 64 * N_E; const int e = q / N_E, idx = q - e * N_E, le = l * 32 + e;
    return p0_job(in[I_MDOWN] + (size_t)le * 1024 * 2048, 1024, 2048, (bf16*)(ws + WS_WD) + (size_t)le * 2048 * 1024, false, 0, idx);
}

__device__ __forceinline__ void p0_adaln(Frame& F) {
    const float* const* in = F.in;
    {
        LAS float* sl = (LAS float*)F.lds;
        for (int i = F.tid; i < 2048 * 5; i += NTHR) { const int r = i / 2048, k = i - r * 2048; const float cv = r < 4 ? in[I_C][r * 2048 + k] : in[I_CCTX][k]; sl[k * 8 + r] = siluf_(cv); }
        __syncthreads();
        LAS float* red = (LAS float*)(F.lds + 65536);
        for (int it = F.c; it < 256; it += F.G) {
            const int l = it >> 7, cbase = 96 * (it & 127); const float* Wl = in[I_ADAW] + (size_t)l * 2048 * 12288;
            const unsigned woff = (unsigned)(cbase + (F.lane & 31));
            float a[3][5];
#pragma unroll
            for (int gq = 0; gq < 3; ++gq)
#pragma unroll
                for (int r = 0; r < 5; ++r) a[gq][r] = 0.f;
            const int kbase = 256 * F.wave + (F.lane >> 5);
#pragma unroll 1
            for (int k0 = 0; k0 < 128; k0 += 8) {
                float wv[8][3];
#pragma unroll
                for (int kk = 0; kk < 8; ++kk)
#pragma unroll
                    for (int gq = 0; gq < 3; ++gq) wv[kk][gq] = Wl[(unsigned)(kbase + 2 * (k0 + kk)) * 12288u + woff + 32u * gq];
#pragma unroll
                for (int kk = 0; kk < 8; ++kk) { const int k = kbase + 2 * (k0 + kk); const f32x4 sv = *(const LAS f32x4*)(sl + k * 8); const float s4 = sl[k * 8 + 4];
#pragma unroll
                    for (int gq = 0; gq < 3; ++gq) { a[gq][0] += sv[0] * wv[kk][gq]; a[gq][1] += sv[1] * wv[kk][gq]; a[gq][2] += sv[2] * wv[kk][gq]; a[gq][3] += sv[3] * wv[kk][gq]; a[gq][4] += s4 * wv[kk][gq]; } }
            }
#pragma unroll
            for (int gq = 0; gq < 3; ++gq)
#pragma unroll
                for (int r = 0; r < 5; ++r) { float v = a[gq][r]; v += __shfl_xor(v, 32); if (F.lane < 32) red[((F.wave * 3 + gq) * 5 + r) * 32 + F.lane] = v; }
            __syncthreads();
            if (F.tid < 480) { float sum = 0.f;
#pragma unroll
                for (int w = 0; w < 8; ++w) sum += red[w * 480 + F.tid];
                const int gq = F.tid / 160, r = (F.tid % 160) >> 5, col = cbase + 32 * gq + (F.tid & 31);
                ((float*)(F.ws + WS_MOD))[((size_t)l * 5 + r) * 12288 + col] = sum + in[I_ADAB][l * 12288 + col]; }
            __syncthreads();
        }
    }
}
__device__ __forceinline__ void p0_filter(Frame& F) {
    const float* const* in = F.in;
    {
        LAS float* zf = (LAS float*)F.lds;
        LAS float* h1 = (LAS float*)(F.lds + 20480);
        LAS float* h2T = (LAS float*)(F.lds + 57344);
        LAS float* w1s = (LAS float*)(F.lds + 94208);
        LAS float* w2s = (LAS float*)(F.lds + 102656);
        LAS float* vs = (LAS float*)(F.lds + 119040);
        for (int i = F.tid; i < 33 * 64; i += NTHR) w1s[i] = in[I_FW1][i];
        for (int i = F.tid; i < 64 * 64; i += NTHR) w2s[i] = in[I_FW2][i];
        if (F.tid < 64) { vs[F.tid] = in[I_FB1][F.tid]; vs[64 + F.tid] = in[I_FB2][F.tid]; vs[128 + F.tid] = in[I_FREQ][F.tid]; }
        for (int it = F.c; it < 256; it += F.G) {
            const int pb = it >> 3, cb = it & 7, pbase = pb * 136;
            for (int i = F.tid; i < 136 * 33; i += NTHR) { const int p = i / 33, m = i - p * 33; const int gp = pbase + p; const int Lq = gp < SL ? SL : CL, j = gp < SL ? gp : gp - SL;
                float v;
                if (m == 0) v = (float)j / (float)(Lq - 1);
                else { const int mm = (m - 1) & 15; const float band = 1e-4f + (float)mm * ((15.0f - 1e-4f) / 15.0f); const float w = (6.283185307179586f / (float)Lq) * (float)j; const float a = band * w;
                    v = (m <= 16) ? cosf(a) : -sinf(a); }
                zf[i] = v; }
            __syncthreads();
            for (int i = F.tid; i < 136 * 64; i += NTHR) { const int p = i >> 6, o = i & 63; float s = vs[o];
#pragma unroll
                for (int m = 0; m < 33; ++m) s += zf[p * 33 + m] * w1s[m * 64 + o];
                h1[i] = sinf(vs[128 + o] * s); }
            __syncthreads();
            for (int i = F.tid; i < 136 * 64; i += NTHR) { const int p = i >> 6, o = i & 63; float s = vs[64 + o];
#pragma unroll 16
                for (int m = 0; m < 64; ++m) s += h1[p * 64 + m] * w2s[m * 64 + o];
                h2T[o * 136 + p] = sinf(vs[128 + o] * s); }
            __syncthreads();
            const int cg = F.tid & 127, pg = F.tid >> 7, c0 = 512 * cb + 4 * cg, p0 = 34 * pg;
            f32x4 acc[34];
#pragma unroll
            for (int i = 0; i < 34; ++i) acc[i] = (f32x4){0.f, 0.f, 0.f, 0.f};
            const float* w3 = in[I_FW3] + c0;
            f32x4 wq[2];
#pragma unroll
            for (int k = 0; k < 2; ++k) wq[k] = *(const GAS f32x4*)(w3 + (size_t)k * 4096);
#pragma unroll 1
            for (int o0 = 0; o0 < 64; o0 += 2) {
                f32x4 wn[2];
#pragma unroll
                for (int k = 0; k < 2; ++k) { const int on = o0 + 2 + k; wn[k] = *(const GAS f32x4*)(w3 + (size_t)(on < 64 ? on : 63) * 4096); }
#pragma unroll
                for (int k = 0; k < 2; ++k) {
#pragma unroll
                    for (int i = 0; i < 17; ++i) { const f32x2 hv = *(const LAS f32x2*)(h2T + (o0 + k) * 136 + p0 + 2 * i); acc[2 * i] += wq[k] * hv[0]; acc[2 * i + 1] += wq[k] * hv[1]; } }
#pragma unroll
                for (int k = 0; k < 2; ++k) wq[k] = wn[k];
            }
            const int d0 = c0 & 2047;
            const float dstep = ((-15.350567286626973f) - (-3.0701134573253945f)) / 2047.0f;
            float delta[4];
#pragma unroll
            for (int q = 0; q < 4; ++q) delta[q] = fabsf(-3.0701134573253945f + (float)(d0 + q) * dstep);
            LAS unsigned char* T = F.lds;
#pragma unroll 1
            for (int hf = 0; hf < 2; ++hf) {
                __syncthreads();
                if ((cg >> 6) == hf) {
#pragma unroll
                    for (int i = 0; i < 17; ++i) { const int gp = pbase + p0 + 2 * i; const bool lat = gp < SL; const int Lq = lat ? SL : CL, j = lat ? gp : gp - SL;
                        const float t0 = (float)j / (float)(Lq - 1), t1 = (float)(j + 1) / (float)(Lq - 1);
#pragma unroll
                        for (int q = 0; q < 4; ++q)
                            *(LAS unsigned*)(T + (4 * (cg & 63) + q) * 276 + (p0 + 2 * i) * 2) = pk2(acc[2 * i][q] * __expf(-t0 * delta[q]), acc[2 * i + 1][q] * __expf(-t1 * delta[q])); } }
                __syncthreads();
                for (int idx = F.tid; idx < 256 * 17; idx += NTHR) { const int col = idx / 17, k = idx - col * 17; const LAS unsigned* sp = (const LAS unsigned*)(T + col * 276 + 16 * k);
                    const u32x4 o = {sp[0], sp[1], sp[2], sp[3]};
                    const int c = 512 * cb + 256 * hf + col, dirn = c >> 11, dd = c & 2047, gp0 = pbase + 8 * k;
                    bf16* dst = gp0 < SL ? (bf16*)(F.ws + WS_KRN) + ((size_t)dd * 2 + dirn) * SL + gp0 : (bf16*)(F.ws + WS_KRC) + ((size_t)dd * 2 + dirn) * CL + (gp0 - SL);
                    *(GAS u32x4*)dst = o; }
            }
            __syncthreads();
        }
    }
}
constexpr int CVT_DENSE = 32 * 192 + 3 * 32 * 64, CVT_GU0 = CVT_DENSE + 65536, CVT_D0 = CVT_GU0 + 32768, CVT_GU1 = CVT_D0 + 65536, CVT_NITEMS = CVT_D0 + 98304;
constexpr int CVT_CHUNK = 8;
__device__ __forceinline__ void cvt_weights(Frame& F, int lo, int hi, int wi, int nw, LAS float* scr) {
    const float* const* in = F.in;
    f32x4 va[8], vb[8];
    int it = lo + wi;
    TItem ta = p0_decode(in, F.ws, it < hi ? it : hi - 1), tb;
    p0_item_load(va, ta, F.lane);
#pragma unroll 1
    for (; it < hi; it += 2 * nw) {
        const int ib = it + nw, ia = it + 2 * nw;
        tb = p0_decode(in, F.ws, ib < hi ? ib : hi - 1); p0_item_load(vb, tb, F.lane);
        p0_item_store(va, ta, scr, F.lane);
        ta = p0_decode(in, F.ws, ia < hi ? ia : hi - 1); p0_item_load(va, ta, F.lane);
        if (ib < hi) p0_item_store(vb, tb, scr, F.lane);
    }
}
constexpr int CVT_WG = 128, CVT_TAIL = 32;
__device__ __forceinline__ void cvt_pull(Frame& F, int limit, int max_chunks, bool tail) {
    { int t_ = threadIdx.x; asm volatile("" : "+v"(t_)); F.tid = t_; F.lane = t_ & 63; }
    unsigned* q = F.ctl + CW_CVTQ; LAS float* scr = (LAS float*)(F.lds + F.wave * 8448); volatile LAS int* slot = (volatile LAS int*)(F.lds + MISC_OFF + 64);
    const int csz = tail ? CVT_TAIL : CVT_WG;
#pragma unroll 1
    for (int n = 0; n < max_chunks; ++n) {
        __syncthreads();
        if (F.tid == 0) { int b = CVT_NITEMS; bool go = (int)xb_ld(q) + CVT_DENSE < limit;
            if (go && tail) { const unsigned nloc = ((volatile LAS unsigned*)(F.lds + MISC_OFF))[0]; if (nloc != 0u && (xb_ld(F.ctl + CW_BAR + XB_XSUB(xb_xcc_id())) % nloc) != 0u) go = false; }
            if (go) b = (int)xb_add(q, (unsigned)csz) + CVT_DENSE; slot[0] = b; }
        __syncthreads();
        const int base = slot[0];
        if (base >= CVT_NITEMS) break;
        cvt_weights(F, base, base + csz < CVT_NITEMS ? base + csz : CVT_NITEMS, F.wave, NWAVES, scr);
    }
    __syncthreads();
}
struct Row { f32x4 v[8]; };
__device__ __forceinline__ void row_load(Row& r, const float* p, int lane) {
#pragma unroll
    for (int i = 0; i < 8; ++i) r.v[i] = *(const GAS f32x4*)(p + 4 * lane + 256 * i);
}
__device__ __forceinline__ float row_rstd(const Row& r) {
    float s = 0.f;
#pragma unroll
    for (int i = 0; i < 8; ++i) s += (r.v[i][0] * r.v[i][0] + r.v[i][1] * r.v[i][1]) + (r.v[i][2] * r.v[i][2] + r.v[i][3] * r.v[i][3]);
    return 1.0f / sqrtf(wave_sum(s) * (1.0f / D) + EPS);
}
__device__ __forceinline__ void row_norm_mod_store(const Row& r, float rstd, const float* g, const float* sh, const float* sc, bf16* o, int lane) {
#pragma unroll
    for (int i = 0; i < 8; ++i) { const int c = 4 * lane + 256 * i;
        const f32x4 gv = *(const GAS f32x4*)(g + c), sv = *(const GAS f32x4*)(sc + c), hv = *(const GAS f32x4*)(sh + c);
        const f32x4 y = (r.v[i] * rstd * gv) * (sv + 1.0f) + hv;
        u32x2 w; w.x = pk2(y[0], y[1]); w.y = pk2(y[2], y[3]); *(GAS u32x2*)(o + c) = w; }
}
__device__ __forceinline__ int moe_pos(const LAS int* rbfirst, int packed) { return 256 * rbfirst[packed >> 20] + (packed & 0xfffff); }
__device__ __forceinline__ void row_add_moe(Row& r, const float* gt, const bf16* eo, int p0, int p1, float g0, float g1, int lane) {
#pragma unroll
    for (int i = 0; i < 8; ++i) { const int c = 4 * lane + 256 * i;
        const u32x2 a = *(const GAS u32x2*)(eo + (size_t)p0 * D + c), b = *(const GAS u32x2*)(eo + (size_t)p1 * D + c); const f32x4 gv = *(const GAS f32x4*)(gt + c);
        f32x4 m; m[0] = g0 * bflo(a.x) + g1 * bflo(b.x); m[1] = g0 * bfhi(a.x) + g1 * bfhi(b.x); m[2] = g0 * bflo(a.y) + g1 * bflo(b.y); m[3] = g0 * bfhi(a.y) + g1 * bfhi(b.y);
        r.v[i] += gv * m; }
}
__device__ __forceinline__ void row_store(const Row& r, float* p, int lane) {
#pragma unroll
    for (int i = 0; i < 8; ++i) *(GAS f32x4*)(p + 4 * lane + 256 * i) = r.v[i];
}
__device__ __forceinline__ int moe_tables(Frame& F, int l) {
    LAS int* rb_e = (LAS int*)(F.lds + TAB_OFF); LAS int* rbfirst = rb_e + 168; LAS int* cnt = rbfirst + 33;
    __syncthreads();
    if (F.tid < 32) cnt[F.tid] = (int)xb_ld(F.ctl + CW_CNT + (l * 32 + F.tid) * 64);
    __syncthreads();
    if (F.tid == 0) { int a = 0; for (int e = 0; e < 32; ++e) { rbfirst[e] = a; const int n = (cnt[e] + 255) >> 8; for (int k = 0; k < n; ++k) rb_e[a + k] = e; a += n; } rbfirst[32] = a; }
    __syncthreads();
    return rbfirst[32];
}

__device__ __forceinline__ void p_norm1_l0(Frame& F) {
    const int gw = F.c * NWAVES + F.wave, NGW = F.G * NWAVES;
    for (int r = gw; r < TT; r += NGW) {
        const bool lat = r < TL; const float* src = lat ? F.in[I_X] + (size_t)r * D : F.in[I_CTX] + (size_t)(r - TL) * D; const float* mod = MODP(F, 0, lat ? (r >> 12) : 4);
        Row row; row_load(row, src, F.lane); const float rstd = row_rstd(row);
        row_norm_mod_store(row, rstd, F.in[I_NORMG], mod, mod + 2048, (bf16*)(F.ws + WS_U) + (size_t)r * D, F.lane);
    }
}
__device__ __forceinline__ void p_comb_norm1_l1(Frame& F) {
    moe_tables(F, 0);
    const LAS int* rbfirst = (const LAS int*)(F.lds + TAB_OFF) + 168;
    const int gw = F.c * NWAVES + F.wave, NGW = F.G * NWAVES;
    const int* tokpos = (const int*)(F.ws + WS_TOKPOS); const float* gates = (const float*)(F.ws + WS_GATE);
    for (int r = gw; r < TT; r += NGW) {
        const bool lat = r < TL; float* xp = lat ? F.out + (size_t)r * D : (float*)(F.ws + WS_XC) + (size_t)(r - TL) * D; const int mr = lat ? (r >> 12) : 4;
        Row row; row_load(row, xp, F.lane);
        const int p0 = moe_pos(rbfirst, tokpos[2 * r]), p1 = moe_pos(rbfirst, tokpos[2 * r + 1]);
        row_add_moe(row, MODP(F, 0, mr) + 10240, (const bf16*)(F.ws + WS_EO), p0, p1, gates[2 * r], gates[2 * r + 1], F.lane);
        row_store(row, xp, F.lane);
        const float rstd = row_rstd(row); const float* mod = MODP(F, 1, mr);
        row_norm_mod_store(row, rstd, F.in[I_NORMG] + 2 * D, mod, mod + 2048, (bf16*)(F.ws + WS_U) + (size_t)r * D, F.lane);
    }
}
__device__ __forceinline__ void p_final(Frame& F) {
    moe_tables(F, 1);
    const LAS int* rbfirst = (const LAS int*)(F.lds + TAB_OFF) + 168;
    const int gw = F.c * NWAVES + F.wave, NGW = F.G * NWAVES;
    const int* tokpos = (const int*)(F.ws + WS_TOKPOS); const float* gates = (const float*)(F.ws + WS_GATE);
    for (int r = gw; r < TL; r += NGW) {
        float* xp = F.out + (size_t)r * D;
        Row row; row_load(row, xp, F.lane);
        const int p0 = moe_pos(rbfirst, tokpos[2 * r]), p1 = moe_pos(rbfirst, tokpos[2 * r + 1]);
        row_add_moe(row, MODP(F, 1, r >> 12) + 10240, (const bf16*)(F.ws + WS_EO), p0, p1, gates[2 * r], gates[2 * r + 1], F.lane);
        const float rstd = row_rstd(row);
#pragma unroll
        for (int i = 0; i < 8; ++i) { const int c = 4 * F.lane + 256 * i; const f32x4 gv = *(const GAS f32x4*)(F.in[I_FINALG] + c); row.v[i] = row.v[i] * rstd * gv; }
        row_store(row, xp, F.lane);
    }
}

__device__ __forceinline__ void p_router(Frame& F, int l, int ntok) {
    constexpr int PITCH = 2050;
    LAS float* xt = (LAS float*)F.lds;
    LAS float* red = (LAS float*)F.lds;
    LAS float* lg = (LAS float*)(F.lds + 32768);
    const float* wg = F.in[I_MWG] + (size_t)l * 2048 * 4; const float* we = F.in[I_MWE] + (size_t)l * 2048 * 32;
    const float* g = F.in[I_NORMG] + (size_t)(l * 2 + 1) * D;
    int* list = (int*)(F.ws + WS_LIST); int* tokpos = (int*)(F.ws + WS_TOKPOS); float* gates = (float*)(F.ws + WS_GATE);
    const int ntile = ntok / 16;
    for (int tile = F.c; tile < ntile; tile += F.G) {
        const int t0 = tile * 16;
        __syncthreads();
#pragma unroll 1
        for (int q = 0; q < 2; ++q) { const int r = t0 + 2 * F.wave + q; const bool lat = r < TL;
            const float* xp = lat ? F.out + (size_t)r * D : (const float*)(F.ws + WS_XC) + (size_t)(r - TL) * D; const float* mod = MODP(F, l, lat ? (r >> 12) : 4);
            Row row; row_load(row, xp, F.lane); const float rstd = row_rstd(row);
            bf16* o = (bf16*)(F.ws + WS_U) + (size_t)r * D; LAS float* xr = xt + (2 * F.wave + q) * PITCH;
#pragma unroll
            for (int i = 0; i < 8; ++i) { const int c = 4 * F.lane + 256 * i;
                const f32x4 gv = *(const GAS f32x4*)(g + c), sv = *(const GAS f32x4*)(mod + 8192 + c), hv = *(const GAS f32x4*)(mod + 6144 + c);
                const f32x4 y = (row.v[i] * rstd * gv) * (sv + 1.0f) + hv;
                u32x2 w; w.x = pk2(y[0], y[1]); w.y = pk2(y[2], y[3]); *(GAS u32x2*)(o + c) = w;
                *(LAS f32x2*)(xr + c) = (f32x2){y[0], y[1]}; *(LAS f32x2*)(xr + c + 2) = (f32x2){y[2], y[3]}; } }
        __syncthreads();
        f32x4 a0 = {0.f, 0.f, 0.f, 0.f}, a1 = a0, a2 = a0;
        { const int tk = F.lane & 15, kq = F.lane >> 4, kb = 256 * F.wave + kq; const LAS float* ap = xt + tk * PITCH + kb;
          const bool v0 = tk < 4; const float* b0p = v0 ? wg + (size_t)kb * 4 + tk : we + (size_t)kb * 32 + (tk - 4);
          const float* b1p = we + (size_t)kb * 32 + 12 + tk;
          const bool v2 = tk < 4; const float* b2p = we + (size_t)kb * 32 + (v2 ? 28 + tk : 0);
          const int s0 = v0 ? 16 : 128;
#pragma unroll 8
          for (int ks = 0; ks < 64; ++ks) { const float av = ap[4 * ks]; const float w0 = b0p[(size_t)ks * s0], w1 = b1p[(size_t)ks * 128]; float w2 = b2p[(size_t)ks * 128]; w2 = v2 ? w2 : 0.f;
              a0 = __builtin_amdgcn_mfma_f32_16x16x4f32(av, w0, a0, 0, 0, 0); a1 = __builtin_amdgcn_mfma_f32_16x16x4f32(av, w1, a1, 0, 0, 0); a2 = __builtin_amdgcn_mfma_f32_16x16x4f32(av, w2, a2, 0, 0, 0); } }
        __syncthreads();
        { LAS float* rp = red + F.wave * 768;
#pragma unroll
          for (int j = 0; j < 4; ++j) { const int tk = 4 * (F.lane >> 4) + j; rp[tk * 48 + (F.lane & 15)] = a0[j]; rp[tk * 48 + 16 + (F.lane & 15)] = a1[j]; rp[tk * 48 + 32 + (F.lane & 15)] = a2[j]; } }
        __syncthreads();
        for (int i = F.tid; i < 768; i += NTHR) { float s = 0.f;
#pragma unroll
            for (int w = 0; w < 8; ++w) s += red[w * 768 + i];
            const int n = i % 48; s += n < 4 ? F.in[I_MBG][l * 4 + n] : (n < 36 ? F.in[I_MBE][l * 32 + n - 4] : 0.f); lg[i] = s; }
        __syncthreads();
        if (F.tid < 16) { const LAS float* q = lg + F.tid * 48; const int r = t0 + F.tid;
            int gi = 0; float gm = q[0];
#pragma unroll
            for (int k = 1; k < 4; ++k) if (q[k] > gm) { gm = q[k]; gi = k; }
            float gs = 0.f;
#pragma unroll
            for (int k = 0; k < 4; ++k) gs += __expf(q[k] - gm);
            const float ptop = 1.0f / gs;
            const LAS float* e = q + 4 + 8 * gi; int i0 = 0; float v0 = e[0];
#pragma unroll
            for (int k = 1; k < 8; ++k) if (e[k] > v0) { v0 = e[k]; i0 = k; }
            int i1 = -1; float v1 = -3.0e38f;
#pragma unroll
            for (int k = 0; k < 8; ++k) if (k != i0 && e[k] > v1) { v1 = e[k]; i1 = k; }
            const float x1 = __expf(v1 - v0), den = 1.0f / (1.0f + x1);
            const int e0 = gi * 8 + i0, e1 = gi * 8 + i1;
            const unsigned s0 = xb_add(F.ctl + CW_CNT + (l * 32 + e0) * 64, 1u), s1 = xb_add(F.ctl + CW_CNT + (l * 32 + e1) * 64, 1u);
            list[(size_t)e0 * TT + s0] = r; list[(size_t)e1 * TT + s1] = r;
            tokpos[2 * r] = (e0 << 20) | (int)s0; tokpos[2 * r + 1] = (e1 << 20) | (int)s1;
            gates[2 * r] = ptop * den; gates[2 * r + 1] = ptop * x1 * den; }
    }
}
constexpr int CV_KR = 0, CV_KRC = 16384, CV_ZERO = 17408, CV_V = 17920, CV_VB = 10272, CV_VJ = 640, CV_VC = 59008, CV_VCB = 544, CV_RED = 61184;
__device__ __forceinline__ float conv3(float zm, float z0, float zp, float w0, float w1, float w2, float cb) { return zm * w0 + z0 * w1 + zp * w2 + cb; }
template <int NV> struct ZChunk { u32x4 v[NV]; unsigned short hl, hr; };
template <int NV>
__device__ __forceinline__ void zchunk_load(ZChunk<NV>& z, const bf16* zrow, int col0, int t0, int Lseq) {
#pragma unroll
    for (int i = 0; i < NV; ++i) z.v[i] = *(const GAS u32x4*)(zrow + col0 + 8 * i);
    z.hl = zrow[t0 > 0 ? col0 - 1 : col0];
    z.hr = zrow[(t0 + 8 * NV < Lseq) ? col0 + 8 * NV : col0];
}
template <int NV>
__device__ __forceinline__ void zchunk_conv3(const ZChunk<NV>& zc, int t0, int Lseq, float w0, float w1, float w2, float cb, float* out) {
    float z[8 * NV + 2];
    z[0] = t0 > 0 ? bf2f(zc.hl) : 0.f;
    z[8 * NV + 1] = (t0 + 8 * NV < Lseq) ? bf2f(zc.hr) : 0.f;
#pragma unroll
    for (int i = 0; i < NV; ++i) { const u32x4 w = zc.v[i];
        z[1 + 8 * i] = bflo(w.x); z[2 + 8 * i] = bfhi(w.x); z[3 + 8 * i] = bflo(w.y); z[4 + 8 * i] = bfhi(w.y); z[5 + 8 * i] = bflo(w.z); z[6 + 8 * i] = bfhi(w.z); z[7 + 8 * i] = bflo(w.w); z[8 + 8 * i] = bfhi(w.w); }
#pragma unroll
    for (int i = 0; i < 8 * NV; ++i) out[i] = conv3(z[i], z[i + 1], z[i + 2], w0, w1, w2, cb);
}
#define CV_MMA8(acc, d, bfr) do { \
    unsigned o_[7]; _Pragma("unroll") for (int m_ = 0; m_ < 7; ++m_) o_[m_] = __builtin_amdgcn_alignbit(d[m_ + 1], d[m_], 16); \
    _Pragma("unroll") for (int q_ = 0; q_ < 4; ++q_) { \
        u32x4 fe_ = {d[4 - q_], d[5 - q_], d[6 - q_], d[7 - q_]}; u32x4 fo_ = {o_[3 - q_], o_[4 - q_], o_[5 - q_], o_[6 - q_]}; \
        acc[2 * q_] = __builtin_amdgcn_mfma_f32_16x16x32_bf16(__builtin_bit_cast(bf16x8, fe_), bfr, acc[2 * q_], 0, 0, 0); \
        acc[2 * q_ + 1] = __builtin_amdgcn_mfma_f32_16x16x32_bf16(__builtin_bit_cast(bf16x8, fo_), bfr, acc[2 * q_ + 1], 0, 0, 0); } } while (0)

struct ConvPre { u32x4 kf, kb, kc; ZChunk<4> zv, zx; ZChunk<1> cv, cx; };
__device__ __forceinline__ void conv_issue(ConvPre& P, Frame& F, int d) {
    const int tid = F.tid; const bf16* ZT = (const bf16*)(F.ws + WS_ZT);
    const bf16* kn = (const bf16*)(F.ws + WS_KRN) + (size_t)d * 2 * SL; const bf16* kc = (const bf16*)(F.ws + WS_KRC) + (size_t)d * 2 * CL;
    P.kf = *(const GAS u32x4*)(kn + 8 * tid); P.kb = *(const GAS u32x4*)(kn + SL + 8 * tid);
    P.kc = *(const GAS u32x4*)(kc + ((tid >> 5) & 1) * CL + 8 * (tid & 31));
    { const int b = tid >> 7, t0 = (tid & 127) * 32, col0 = b * SL + t0;
      zchunk_load<4>(P.zv, ZT + (size_t)(4096 + d) * ZLD, col0, t0, SL); zchunk_load<4>(P.zx, ZT + (size_t)(2048 + d) * ZLD, col0, t0, SL); }
    { const int b = (tid >> 5) & 3, t0 = (tid & 31) * 8, col0 = TL + b * CL + t0;
      zchunk_load<1>(P.cv, ZT + (size_t)(4096 + d) * ZLD, col0, t0, CL); zchunk_load<1>(P.cx, ZT + (size_t)(2048 + d) * ZLD, col0, t0, CL); }
}

__device__ __forceinline__ void p_conv(Frame& F) {
    LAS unsigned char* lds = F.lds;
    const bf16* ZT = (const bf16*)(F.ws + WS_ZT); bf16* YXT = (bf16*)(F.ws + WS_YXT);
    const float* cw = F.in[I_HCW]; const float* cbp = F.in[I_HCB];
    const int tid = F.tid, lane = F.lane, w = F.wave, g = w & 1, q = w >> 1, r = lane & 15, h4 = lane >> 4, Isub = r >> 2, bb = r & 3;
    for (int i = tid; i < 128; i += NTHR) ((LAS unsigned*)(lds + CV_ZERO))[i] = 0u;
    ConvPre P;
    if (F.c < D) conv_issue(P, F, F.c);
#pragma unroll 1
    for (int d = F.c; d < D; d += F.G) {
        __syncthreads();
        float nl = 0.f, nc = 0.f;
        { LAS bf16* KR = (LAS bf16*)(lds + CV_KR);
          const unsigned fwv[4] = {P.kf.x, P.kf.y, P.kf.z, P.kf.w}, bwv[4] = {P.kb.x, P.kb.y, P.kb.z, P.kb.w};
#pragma unroll
          for (int e = 0; e < 8; ++e) { const int j = 8 * tid + e; const unsigned short fv = (unsigned short)(fwv[e >> 1] >> (16 * (e & 1))), bv = (unsigned short)(bwv[e >> 1] >> (16 * (e & 1)));
              KR[SL - j] = fv; nl += fabsf(bf2f(fv));
              if (j > 0) { KR[SL + j] = bv; nl += fabsf(bf2f(bv)); } }
          if (tid == 0) KR[0] = 0;
          if (tid < 64) { LAS bf16* KC = (LAS bf16*)(lds + CV_KRC); const int dirn = tid >> 5, j0 = 8 * (tid & 31);
              const unsigned cv4[4] = {P.kc.x, P.kc.y, P.kc.z, P.kc.w};
#pragma unroll
              for (int e = 0; e < 8; ++e) { const int j = j0 + e; const unsigned short v = (unsigned short)(cv4[e >> 1] >> (16 * (e & 1)));
                  if (dirn == 0) { KC[CL - j] = v; nc += fabsf(bf2f(v)); } else if (j > 0) { KC[CL + j] = v; nc += fabsf(bf2f(v)); } }
              if (tid == 0) KC[0] = 0; } }
        { const int chv = 4096 + d, chx = 2048 + d;
          const float v0 = cw[chv], v1 = cw[6144 + chv], v2 = cw[12288 + chv], vb = cbp[chv], x0 = cw[chx], x1 = cw[6144 + chx], x2 = cw[12288 + chx], xb = cbp[chx];
          { const int b = tid >> 7, t0 = (tid & 127) * 32; float zv[32], zx[32];
            zchunk_conv3<4>(P.zv, t0, SL, v0, v1, v2, vb, zv); zchunk_conv3<4>(P.zx, t0, SL, x0, x1, x2, xb, zx);
            LAS unsigned char* dst = lds + CV_V + b * CV_VB + (t0 >> 8) * CV_VJ + (t0 & 255) * 2;
#pragma unroll
            for (int i = 0; i < 4; ++i) { u32x4 o; o.x = pk2(zv[8 * i] * zx[8 * i], zv[8 * i + 1] * zx[8 * i + 1]); o.y = pk2(zv[8 * i + 2] * zx[8 * i + 2], zv[8 * i + 3] * zx[8 * i + 3]);
                o.z = pk2(zv[8 * i + 4] * zx[8 * i + 4], zv[8 * i + 5] * zx[8 * i + 5]); o.w = pk2(zv[8 * i + 6] * zx[8 * i + 6], zv[8 * i + 7] * zx[8 * i + 7]); *(LAS u32x4*)(dst + 16 * i) = o; } }
          { const int b = (tid >> 5) & 3, t0 = (tid & 31) * 8; float zv[8], zx[8];
            zchunk_conv3<1>(P.cv, t0, CL, v0, v1, v2, vb, zv); zchunk_conv3<1>(P.cx, t0, CL, x0, x1, x2, xb, zx);
            u32x4 o; o.x = pk2(zv[0] * zx[0], zv[1] * zx[1]); o.y = pk2(zv[2] * zx[2], zv[3] * zx[3]); o.z = pk2(zv[4] * zx[4], zv[5] * zx[5]); o.w = pk2(zv[6] * zx[6], zv[7] * zx[7]);
            if (tid < 128) *(LAS u32x4*)(lds + CV_VC + b * CV_VCB + t0 * 2) = o; } }
        nl = wave_sum(nl); nc = wave_sum(nc);
        if (lane == 0) { ((LAS float*)(lds + CV_RED))[w] = nl; ((LAS float*)(lds + CV_RED))[8 + w] = nc; }
        __syncthreads();
        const int I_ep = 4 * q + Isub, t0l = 256 * I_ep + 128 * g + 32 * h4, col0l = bb * SL + t0l, t0c = 128 * g + 32 * h4, col0c = TL + bb * CL + t0c;
        ZChunk<4> xl_, xc_;
        zchunk_load<4>(xl_, ZT + (size_t)d * ZLD, col0l, t0l, SL);
        { const int dn = d + F.G; conv_issue(P, F, dn < D ? dn : d); }
        float inv_l = 0.f, inv_c = ((LAS float*)(lds + CV_RED))[8];
#pragma unroll
        for (int i = 0; i < 8; ++i) inv_l += ((LAS float*)(lds + CV_RED))[i];
        inv_l = 1.0f / inv_l; inv_c = 1.0f / inv_c;
        const float skip = F.in[I_SKIP][d];
        const float c0 = cw[d], c1 = cw[6144 + d], c2 = cw[12288 + d], cb0 = cbp[d];
        {
            f32x4 acc[8];
#pragma unroll
            for (int i = 0; i < 8; ++i) acc[i] = (f32x4){0.f, 0.f, 0.f, 0.f};
#define CV_BASES(dl_, ap_, bp_) do { const int J_ = 4 * q + Isub - (dl_); const bool v_ = (J_ >= 0) && (J_ <= 15); \
                bp_ = v_ ? lds + CV_V + bb * CV_VB + J_ * CV_VJ + h4 * 16 : lds + CV_ZERO + h4 * 16; \
                ap_ = lds + CV_KR + (SL - 256 * (dl_) - 128 * g - 8 * r + 8 * h4 - 8) * 2; } while (0)
            const LAS unsigned char *ap, *bp, *apn, *bpn;
            CV_BASES(4 * q - 15, ap, bp);
            u32x4 ca = *(const LAS u32x4*)(ap), cbv = *(const LAS u32x4*)(ap + 16); bf16x8 bfr = *(const LAS bf16x8*)(bp);
#pragma unroll 1
            for (int dl = 4 * q - 15; dl <= 4 * q + 3; ++dl) {
                { const int dn_ = dl < 4 * q + 3 ? dl + 1 : dl; CV_BASES(dn_, apn, bpn); }
#pragma unroll
                for (int kk = 0; kk < 8; ++kk) {
                    const LAS unsigned char* an_ = kk < 7 ? ap + 64 * (kk + 1) : apn; const LAS unsigned char* bn_ = kk < 7 ? bp + 64 * (kk + 1) : bpn;
                    const u32x4 can = *(const LAS u32x4*)(an_), cbn = *(const LAS u32x4*)(an_ + 16); const bf16x8 bfn = *(const LAS bf16x8*)(bn_);
                    __builtin_amdgcn_sched_barrier(0);
                    const unsigned dd[8] = {ca.x, ca.y, ca.z, ca.w, cbv.x, cbv.y, cbv.z, cbv.w};
                    CV_MMA8(acc, dd, bfr);
                    __builtin_amdgcn_sched_barrier(0);
                    ca = can; cbv = cbn; bfr = bfn;
                }
                ap = apn; bp = bpn;
            }
#undef CV_BASES
            float x0c[32]; zchunk_conv3<4>(xl_, t0l, SL, c0, c1, c2, cb0, x0c);
            const LAS unsigned char* vp = lds + CV_V + bb * CV_VB + I_ep * CV_VJ + (128 * g + 32 * h4) * 2;
#pragma unroll
            for (int i = 0; i < 4; ++i) { const u32x4 vv = *(const LAS u32x4*)(vp + 16 * i); const unsigned vw[4] = {vv.x, vv.y, vv.z, vv.w}; unsigned ow[4];
#pragma unroll
                for (int p = 0; p < 4; ++p) { const int e0 = 8 * i + 2 * p, e1 = e0 + 1;
                    const float y0 = (acc[e0 & 7][e0 >> 3] * inv_l + skip * bflo(vw[p])) * x0c[e0], y1 = (acc[e1 & 7][e1 >> 3] * inv_l + skip * bfhi(vw[p])) * x0c[e1];
                    ow[p] = pk2(y0, y1); }
                *(GAS u32x4*)(YXT + (size_t)d * ZLD + col0l + 8 * i) = (u32x4){ow[0], ow[1], ow[2], ow[3]}; }
        }
        zchunk_load<4>(xc_, ZT + (size_t)d * ZLD, col0c, t0c, CL);
        if (w < 2) {
            f32x4 acc[8];
#pragma unroll
            for (int i = 0; i < 8; ++i) acc[i] = (f32x4){0.f, 0.f, 0.f, 0.f};
            const bool valid = Isub == 0;
            const LAS unsigned char* bp = valid ? lds + CV_VC + bb * CV_VCB + h4 * 16 : lds + CV_ZERO + h4 * 16;
            const int xb = CL - 128 * g - 8 * r + 8 * h4;
            const LAS unsigned char* ap = lds + CV_KRC + (xb - 8) * 2;
#pragma unroll
            for (int kk = 0; kk < 8; ++kk) {
                const u32x4 ca = *(const LAS u32x4*)(ap + 64 * kk), cbv = *(const LAS u32x4*)(ap + 64 * kk + 16);
                const bf16x8 bfr = *(const LAS bf16x8*)(bp + 64 * kk);
                const unsigned dd[8] = {ca.x, ca.y, ca.z, ca.w, cbv.x, cbv.y, cbv.z, cbv.w};
                CV_MMA8(acc, dd, bfr);
            }
            float x0c[32]; zchunk_conv3<4>(xc_, t0c, CL, c0, c1, c2, cb0, x0c);
            const LAS unsigned char* vp = lds + CV_VC + bb * CV_VCB + t0c * 2;
            u32x4 outv[4];
#pragma unroll
            for (int i = 0; i < 4; ++i) { const u32x4 vv = *(const LAS u32x4*)(vp + 16 * i); const unsigned vw[4] = {vv.x, vv.y, vv.z, vv.w}; unsigned ow[4];
#pragma unroll
                for (int p = 0; p < 4; ++p) { const int e0 = 8 * i + 2 * p, e1 = e0 + 1;
                    const float y0 = (acc[e0 & 7][e0 >> 3] * inv_c + skip * bflo(vw[p])) * x0c[e0], y1 = (acc[e1 & 7][e1 >> 3] * inv_c + skip * bfhi(vw[p])) * x0c[e1];
                    ow[p] = pk2(y0, y1); }
                outv[i] = (u32x4){ow[0], ow[1], ow[2], ow[3]}; }
            if (valid) {
#pragma unroll
                for (int i = 0; i < 4; ++i) *(GAS u32x4*)(YXT + (size_t)d * ZLD + col0c + 8 * i) = outv[i]; }
        }
    }
}

__device__ __forceinline__ void p_transpose_yx(Frame& F) {
    const bf16* src = (const bf16*)(F.ws + WS_YXT); bf16* dst = (bf16*)(F.ws + WS_YX);
    LAS unsigned short* scr = (LAS unsigned short*)(F.lds + F.wave * 8704);
    const int gw = F.c * NWAVES + F.wave, NGW = F.G * NWAVES, lane = F.lane;
    constexpr int NT_T = TT / 64, NTILES = (D / 64) * NT_T;
    for (int it = gw; it < NTILES; it += NGW) {
        const int cb = it / NT_T, tb = it - cb * NT_T, c0 = 64 * cb, tk0 = 64 * tb;
        u32x4 v[8];
#pragma unroll
        for (int i = 0; i < 8; ++i) v[i] = *(const GAS u32x4*)(src + (size_t)(c0 + 8 * i + (lane >> 3)) * ZLD + tk0 + 8 * (lane & 7));
#pragma unroll
        for (int i = 0; i < 8; ++i) { LAS unsigned* s = (LAS unsigned*)(scr + (8 * i + (lane >> 3)) * 68 + 8 * (lane & 7)); s[0] = v[i].x; s[1] = v[i].y; s[2] = v[i].z; s[3] = v[i].w; }
        LDS_WAIT(); asm volatile("" ::: "memory");
#pragma unroll
        for (int j = 0; j < 8; ++j) { const int tk = 8 * j + (lane >> 3), cc = 8 * (lane & 7); unsigned short e[8];
#pragma unroll
            for (int k = 0; k < 8; ++k) e[k] = scr[(cc + k) * 68 + tk];
            u32x4 o; o.x = e[0] | ((unsigned)e[1] << 16); o.y = e[2] | ((unsigned)e[3] << 16); o.z = e[4] | ((unsigned)e[5] << 16); o.w = e[6] | ((unsigned)e[7] << 16);
            *(GAS u32x4*)(dst + (size_t)(tk0 + tk) * D + c0 + cc) = o; }
        LDS_WAIT(); asm volatile("" ::: "memory");
    }
}
constexpr int S5_HS = 9216;
__device__ __forceinline__ size_t s5_row(int ti, int tau, int b, int dir) {
    if (ti < 8) { const int pos = 32 * ti + tau; return (size_t)(TL + b * CL + (dir ? CL - 1 - pos : pos)); }
    const int pos = 32 * (ti - 8) + tau; return (size_t)(b * SL + (dir ? SL - 1 - pos : pos));
}
__device__ __forceinline__ void p_s5(Frame& F) {
    if (F.wave >= 4) return;
    const int lane = F.lane, w = F.wave;
    const bf16* U = (const bf16*)(F.ws + WS_U);
    LAS unsigned char* Hs = F.lds + w * S5_HS;
    for (int sq = F.c * 4 + w; sq < 1024; sq += F.G * 4) {
        const int g = sq & 127, db = sq >> 7, dir = db >> 2, b = db & 3, pg = dir * 128 + g;
        const float step = __expf(F.in[I_SLOG][pg]);
        float lr, li;
        { const float ar = F.in[I_SARE][pg * 64 + lane], ai = F.in[I_SAIM][pg * 64 + lane]; const float er = expf(ar * step); float sn, cs; sincosf(ai * step, &sn, &cs); lr = er * cs; li = er * sn; }
        bf16x8 Bf[2][2];
#pragma unroll
        for (int ph = 0; ph < 2; ++ph) { const int p = 32 * ph + (lane & 31), hh = lane >> 5;
            const float ar = F.in[I_SARE][pg * 64 + p], ai = F.in[I_SAIM][pg * 64 + p]; const float er = expf(ar * step); float sn, cs; sincosf(ai * step, &sn, &cs);
            const float nr = er * cs - 1.0f, ni = er * sn, dn = 1.0f / (ar * ar + ai * ai); const float cr = (nr * ar + ni * ai) * dn, ci = (ni * ar - nr * ai) * dn;
            const float* br = F.in[I_SBRE] + ((size_t)pg * 64 + p) * 16 + 8 * hh; const float* bi = F.in[I_SBIM] + ((size_t)pg * 64 + p) * 16 + 8 * hh;
            unsigned wr_[4], wi_[4];
#pragma unroll
            for (int j = 0; j < 4; ++j) { const float r0 = br[2 * j], r1 = br[2 * j + 1], i0 = bi[2 * j], i1 = bi[2 * j + 1];
                wr_[j] = pk2(cr * r0 - ci * i0, cr * r1 - ci * i1); wi_[j] = pk2(cr * i0 + ci * r0, cr * i1 + ci * r1); }
            Bf[0][ph] = __builtin_bit_cast(bf16x8, (u32x4){wr_[0], wr_[1], wr_[2], wr_[3]}); Bf[1][ph] = __builtin_bit_cast(bf16x8, (u32x4){wi_[0], wi_[1], wi_[2], wi_[3]}); }
        bf16x8 Cf[4];
#pragma unroll
        for (int ks = 0; ks < 4; ++ks) { const int hp = lane & 15, p0 = 16 * ks + 4 * (lane >> 4);
            const float* crp = F.in[I_SCRE] + ((size_t)pg * 16 + hp) * 64 + p0; const float* cip = F.in[I_SCIM] + ((size_t)pg * 16 + hp) * 64 + p0;
            Cf[ks] = __builtin_bit_cast(bf16x8, (u32x4){pk2(crp[0], -cip[0]), pk2(crp[1], -cip[1]), pk2(crp[2], -cip[2]), pk2(crp[3], -cip[3])}); }
        bf16* Yp = (bf16*)(F.ws + (dir ? WS_YB : WS_YF));
        float hr = 0.f, hi = 0.f;
#define urow(ti_, tau_) s5_row((ti_), (tau_), b, dir)
        const int tau_a = lane & 31, coff = 16 * g + 8 * (lane >> 5);
        constexpr int NPF = 2;
        bf16x8 uq[NPF];
#pragma unroll
        for (int k = 0; k < NPF; ++k) uq[k] = *(const GAS bf16x8*)(U + urow(k, tau_a) * D + coff);
#pragma unroll 1
        for (int ti = 0; ti < 136; ++ti) {
            const bf16x8 unew = *(const GAS bf16x8*)(U + urow(ti + NPF < 136 ? ti + NPF : 135, tau_a) * D + coff);
            const bf16x8 u0 = uq[0];
            f32x16 z16;
#pragma unroll
            for (int i = 0; i < 16; ++i) z16[i] = 0.f;
            f32x16 aR0 = __builtin_amdgcn_mfma_f32_32x32x16_bf16(u0, Bf[0][0], z16, 0, 0, 0), aR1 = __builtin_amdgcn_mfma_f32_32x32x16_bf16(u0, Bf[0][1], z16, 0, 0, 0);
            f32x16 aI0 = __builtin_amdgcn_mfma_f32_32x32x16_bf16(u0, Bf[1][0], z16, 0, 0, 0), aI1 = __builtin_amdgcn_mfma_f32_32x32x16_bf16(u0, Bf[1][1], z16, 0, 0, 0);
            float bur[32], bui[32];
#pragma unroll
            for (int r = 0; r < 16; ++r) {
                const float fa = aR0[r], fb = aR1[r], fc = aI0[r], fd = aI1[r];
                auto sr = __builtin_amdgcn_permlane32_swap(__float_as_uint(fa), __float_as_uint(fb), false, false);
                auto si = __builtin_amdgcn_permlane32_swap(__float_as_uint(fc), __float_as_uint(fd), false, false);
                const unsigned sr0 = sr[0], sr1 = sr[1], si0 = si[0], si1 = si[1];
                const int tA = (r & 3) + 8 * (r >> 2);
                bur[tA] = __uint_as_float(sr0); bur[tA + 4] = __uint_as_float(sr1); bui[tA] = __uint_as_float(si0); bui[tA + 4] = __uint_as_float(si1); }
            const bool out_tile = ti >= 8;
#pragma unroll
            for (int tau = 0; tau < 32; ++tau) {
                const float t1 = __builtin_fmaf(lr, hr, bur[tau]), t2 = __builtin_fmaf(lr, hi, bui[tau]);
                const float nhr = __builtin_fmaf(-li, hi, t1), nhi = __builtin_fmaf(li, hr, t2);
                hr = nhr; hi = nhi;
                if (out_tile) *(LAS unsigned*)(Hs + tau * 288 + lane * 4) = pg8::cvt_pk_bf16(hr, hi);
            }
            if (out_tile) {
                asm volatile("s_waitcnt lgkmcnt(0)" ::: "memory");
#pragma unroll
                for (int mt = 0; mt < 2; ++mt) { f32x4 ay = {0.f, 0.f, 0.f, 0.f};
#pragma unroll
                    for (int ks = 0; ks < 4; ++ks) { const bf16x8 hf = *(const LAS bf16x8*)(Hs + (16 * mt + (lane & 15)) * 288 + (32 * ks + 8 * (lane >> 4)) * 2);
                        ay = __builtin_amdgcn_mfma_f32_16x16x32_bf16(Cf[ks], hf, ay, 0, 0, 0); }
                    u32x2 o; o.x = pk2(ay[0], ay[1]); o.y = pk2(ay[2], ay[3]);
                    *(GAS u32x2*)(Yp + urow(ti, 16 * mt + (lane & 15)) * D + 16 * g + 4 * (lane >> 4)) = o; }
                asm volatile("s_waitcnt lgkmcnt(0)" ::: "memory");
            }
#pragma unroll
            for (int k = 0; k + 1 < NPF; ++k) uq[k] = uq[k + 1];
            uq[NPF - 1] = unew;
        }
#undef urow
    }
}
__device__ __forceinline__ float gelu_tanh(float x) { const float u = 0.7978845608028654f * (x + 0.044715f * x * x * x); const float e = __expf(2.0f * u); const float th = 1.0f - 2.0f / (e + 1.0f); return 0.5f * x * (1.0f + th); }
__device__ __forceinline__ void p_s5_gelu(Frame& F) {
    const bf16* U = (const bf16*)(F.ws + WS_U); const bf16* YF = (const bf16*)(F.ws + WS_YF); const bf16* YB = (const bf16*)(F.ws + WS_YB); bf16* Gb = (bf16*)(F.ws + WS_G);
    const float* dsk = F.in[I_SD];
    const size_t n8 = (size_t)TL * D / 8, stride = (size_t)F.G * NTHR;
    for (size_t i = (size_t)F.c * NTHR + F.tid; i < n8; i += stride) {
        const u32x4 u = *(const GAS u32x4*)(U + 8 * i), a = *(const GAS u32x4*)(YF + 8 * i), b = *(const GAS u32x4*)(YB + 8 * i);
        const int c = (int)((8 * i) & 2047); const f32x4 d0 = *(const GAS f32x4*)(dsk + c), d1 = *(const GAS f32x4*)(dsk + c + 4);
        const unsigned uw[4] = {u.x, u.y, u.z, u.w}, aw[4] = {a.x, a.y, a.z, a.w}, bw[4] = {b.x, b.y, b.z, b.w}; const float dv[8] = {d0[0], d0[1], d0[2], d0[3], d1[0], d1[1], d1[2], d1[3]}; unsigned ow[4];
#pragma unroll
        for (int p = 0; p < 4; ++p) { const float y0 = dv[2 * p] * bflo(uw[p]) + bflo(aw[p]) + bflo(bw[p]), y1 = dv[2 * p + 1] * bfhi(uw[p]) + bfhi(aw[p]) + bfhi(bw[p]);
            ow[p] = pk2(gelu_tanh(y0), gelu_tanh(y1)); }
        *(GAS u32x4*)(Gb + 8 * i) = (u32x4){ow[0], ow[1], ow[2], ow[3]};
    }
}
#ifndef MK_N_LAUNCHES
#define MK_N_LAUNCHES 1
#endif
constexpr int N_PHASES = 17;

__device__ __forceinline__ void moe_rowtab(Frame& F, int nrb) {
    const LAS int* rb_e = (const LAS int*)(F.lds + TAB_OFF); const LAS int* rbfirst = rb_e + 168; const LAS int* cnt = rbfirst + 33;
    LAS unsigned* rowtab = (LAS unsigned*)(F.lds + ROWTAB_OFF); const int* list = (const int*)(F.ws + WS_LIST);
    for (int i = 0; i < 8; ++i) { const int L = i * F.G + F.c; if (L >= nrb * 8) break;
        const int rbi = L >> 3, e = rb_e[rbi], rbl = rbi - rbfirst[e];
        if (F.tid < 256) { const int slot = rbl * 256 + F.tid; const int tok = slot < cnt[e] ? list[(size_t)e * TT + slot] : 0; rowtab[i * 256 + F.tid] = (unsigned)tok * (unsigned)(D * 2); } }
    __syncthreads();
}

__global__ void __launch_bounds__(NTHR, 2) mega_fwd(Params P) {
    extern __shared__ __attribute__((aligned(16))) unsigned char lds_raw[];
    Frame F;
    F.lds = (LAS unsigned char*)lds_raw; F.ws = P.ws; F.ctl = (unsigned*)(P.ws + WS_CTL); F.in = P.in; F.out = P.out;
    F.tid = threadIdx.x; F.lane = F.tid & 63; F.wave = __builtin_amdgcn_readfirstlane(F.tid >> 6); F.G = gridDim.x; F.c = blockIdx.x;
    volatile LAS unsigned* MISC = (volatile LAS unsigned*)(F.lds + MISC_OFF);
    if (F.tid < 4) MISC[F.tid] = 0u;
    __syncthreads();
    XcdBarrier bar; bar.bar = F.ctl + CW_BAR; bar.x = 0; bar.st = MISC;
    if (MK_N_LAUNCHES == 1) bar = xcd_barrier_post(F.ctl + CW_BAR, MISC);
    const int lo = P.ph_lo, hi = P.ph_hi;
#define IN(k) (lo <= (k) && (k) < hi)
#define SEAM(k) do { if (IN(k) && IN((k) + 1)) xcd_barrier(bar); } while (0)
#ifndef PROBE_REP
#define PROBE_REP -1
#endif
    const size_t TS2048 = (size_t)256 * 2048 * 2, TS1024 = (size_t)256 * 1024 * 2;

#ifndef PROBE_N
#define PROBE_N 1
#endif
#define REFRESH() do { int t_ = threadIdx.x; asm volatile("" : "+v"(t_)); F.tid = t_; F.lane = t_ & 63; } while (0)
#define RUN(k, ...) if (IN(k)) { REFRESH(); __VA_ARGS__ if (PROBE_REP == (k)) { _Pragma("unroll 1") for (int rep_ = 0; rep_ < PROBE_N; ++rep_) { xcd_barrier(bar); __VA_ARGS__ } } } SEAM(k);
#define TAIL(nunits_, chunks_) do { const int nu_ = (nunits_), mx_ = (nu_ + F.G - 1) / F.G, my_ = nu_ > F.c ? (nu_ - F.c + F.G - 1) / F.G : 0; if (my_ < mx_) cvt_pull(F, CVT_NITEMS, (chunks_), true); } while (0)
#define DRAIN(limit_) cvt_pull(F, (limit_), 1 << 30, false)
    RUN(0, p0_adaln(F); __syncthreads(); REFRESH(); p0_filter(F); __syncthreads(); REFRESH(); cvt_weights(F, 0, CVT_DENSE, F.c * NWAVES + F.wave, F.G * NWAVES, (LAS float*)(F.lds + F.wave * 8448));)
    RUN(1, p_norm1_l0(F);)
    RUN(2, {
        pg8::DenseOrder S; S.init(F.ws + WS_WIN, F.ws + WS_U, 6144, TT, 2048, F.G, F.c);
        pg8::EpiZT E{(bf16*)(F.ws + WS_ZT), ZLD, F.in[I_HBIN]};
        pg8::gemm_phase<pg8::EpiZT, pg8::DenseOrder, false>(F.lds, 2048, S, E, nullptr); TAIL(24 * 68, 12); })
    RUN(3, p_conv(F);)
    RUN(4, p_transpose_yx(F);)
    RUN(5, {
        pg8::DenseOrder S; S.init(F.ws + WS_YX, F.ws + WS_WOUT, TT, 2048, 2048, F.G, F.c);
        pg8::EpiRes E{F.in[I_X], F.out, MODP(F, 0, 0) + 4096, F.in[I_CTX], (float*)(F.ws + WS_XC), MODP(F, 0, 4) + 4096, 12288, F.in[I_HBOUT]};
        pg8::gemm_phase<pg8::EpiRes, pg8::DenseOrder, false>(F.lds, 2048, S, E, nullptr); TAIL(68 * 8, 12); })
#define MOE_PHASES(l, P_R, P_GU, P_DN, NTOK, LIM_GU, LIM_DN) \
    RUN(P_R, p_router(F, (l), (NTOK)); __syncthreads(); DRAIN(LIM_GU);) \
    RUN(P_GU, { const int nrb = moe_tables(F, (l)); moe_rowtab(F, nrb); \
        pg8::MoeOrder S{(const char*)(F.ws + WS_U), (const char*)(F.ws + WS_WGU) + (size_t)(l) * 32 * 2048 * 2048 * 2, (const LAS int*)(F.lds + TAB_OFF), nrb, 8, F.G, F.c, 0, TS2048, (size_t)2048 * 2048 * 2, true}; \
        pg8::EpiGU E{(bf16*)(F.ws + WS_H), 1024}; \
        pg8::gemm_phase<pg8::EpiGU, pg8::MoeOrder, true>(F.lds, 2048, S, E, (const LAS unsigned*)(F.lds + ROWTAB_OFF)); TAIL(nrb * 8, 12); DRAIN(LIM_DN); }) \
    RUN(P_DN, { const int nrb = moe_tables(F, (l)); \
        pg8::MoeOrder S{(const char*)(F.ws + WS_H), (const char*)(F.ws + WS_WD) + (size_t)(l) * 32 * 2048 * 1024 * 2, (const LAS int*)(F.lds + TAB_OFF), nrb, 8, F.G, F.c, TS1024, TS1024, (size_t)2048 * 1024 * 2, false}; \
        pg8::EpiBf E{(bf16*)(F.ws + WS_EO), 2048}; \
        pg8::gemm_phase<pg8::EpiBf, pg8::MoeOrder, false>(F.lds, 1024, S, E, nullptr); TAIL(nrb * 8, 6); })
    MOE_PHASES(0, 6, 7, 8, TT, CVT_GU0, CVT_D0)
    RUN(9, p_comb_norm1_l1(F);)
    RUN(10, p_s5(F);)
    RUN(11, p_s5_gelu(F);)
    RUN(12, {
        pg8::DenseOrder S; S.init(F.ws + WS_G, F.ws + WS_W12, TL, 4096, 2048, F.G, F.c);
        pg8::EpiGlu E{F.out, MODP(F, 1, 0) + 4096, 12288, F.in[I_SB1], F.in[I_SB2]};
        pg8::gemm_phase<pg8::EpiGlu, pg8::DenseOrder, false>(F.lds, 2048, S, E, nullptr); TAIL(64 * 16, 12); })
    MOE_PHASES(1, 13, 14, 15, TL, CVT_GU1, CVT_NITEMS)
    if (IN(16)) { REFRESH(); p_final(F); }
#undef IN
#undef SEAM
}

extern "C" void kernel_launch(void* const* d_in, const int* in_sizes, int n_in, void* d_out, int out_size, void* d_ws, size_t ws_size, hipStream_t stream) {
    static int grid = 0;
    if (grid == 0) {
        if (n_in != 40 || out_size != TL * D || ws_size < WS_END) { fprintf(stderr, "kernel_launch: unexpected shapes (n_in %d, out %d, ws %zu)\n", n_in, out_size, ws_size); grid = -1; return; }
        int dev = 0, cus = 0, per_cu = 0;
        if (hipGetDevice(&dev) != hipSuccess || hipDeviceGetAttribute(&cus, hipDeviceAttributeMultiprocessorCount, dev) != hipSuccess) { grid = -1; return; }
        if (hipFuncSetAttribute((const void*)mega_fwd, hipFuncAttributeMaxDynamicSharedMemorySize, LDS_BYTES) != hipSuccess) { fprintf(stderr, "kernel_launch: hipFuncSetAttribute failed\n"); grid = -1; return; }
        if (hipOccupancyMaxActiveBlocksPerMultiprocessor(&per_cu, (const void*)mega_fwd, NTHR, LDS_BYTES) != hipSuccess || per_cu < 1) { fprintf(stderr, "kernel_launch: occupancy query reports %d blocks per CU\n", per_cu); }
        (void)hipGetLastError();
        grid = cus;
    }
    if (grid < 0) return;
    (void)hipMemsetAsync((char*)d_ws + WS_CTL, 0, CTL_BYTES, stream);
    Params p{};
    for (int i = 0; i < 40; ++i) p.in[i] = (const float*)d_in[i];
    p.out = (float*)d_out; p.ws = (unsigned char*)d_ws;
#if MK_N_LAUNCHES == 1
    p.ph_lo = 0; p.ph_hi = N_PHASES;
    hipLaunchKernelGGL(mega_fwd, dim3(grid), dim3(NTHR), LDS_BYTES, stream, p);
#else
    for (int k = 0; k < N_PHASES; ++k) { p.ph_lo = k; p.ph_hi = k + 1; hipLaunchKernelGGL(mega_fwd, dim3(grid), dim3(NTHR), LDS_BYTES, stream, p); }
#endif
}
```

```cpp
#ifndef MK_N_LAUNCHES
#define MK_N_LAUNCHES 1
#endif
#include <hip/hip_runtime.h>
#include <cstdio>
#include <cstdint>

#define LAS __attribute__((address_space(3)))
#define GAS __attribute__((address_space(1)))
typedef unsigned short bf16;
typedef short bf16x8 __attribute__((ext_vector_type(8)));
typedef float f32x4 __attribute__((ext_vector_type(4)));
typedef float f32x2 __attribute__((ext_vector_type(2)));
typedef float f32x16 __attribute__((ext_vector_type(16)));
typedef unsigned u32x4 __attribute__((ext_vector_type(4)));
typedef unsigned u32x2 __attribute__((ext_vector_type(2)));

constexpr int D = 2048, NB = 4, SL = 4096, CL = 256, TL = NB * SL  , TC = NB * CL  , TT = TL + TC  ;
constexpr int NE = 32, DE = 1024, NRB_MAX = 168, ZLD = TT;
constexpr float EPS = 1e-6f;
constexpr int NWAVES = 8, NTHR = 512;

constexpr size_t MiB = 1u << 20;
constexpr size_t WS_CTL = 0, CTL_BYTES = 1 * MiB;
constexpr size_t WS_MOD = 1 * MiB;
constexpr size_t WS_LIST = 2 * MiB;
constexpr size_t WS_TOKPOS = 5 * MiB;
constexpr size_t WS_GATE = 5 * MiB + 512 * 1024;
constexpr size_t WS_WRT = 4 * MiB + 256 * 1024;
constexpr size_t WS_KRN = 6 * MiB;
constexpr size_t WS_KRC = 38 * MiB;
constexpr size_t WS_WIN = 40 * MiB;
constexpr size_t WS_WOUT = 64 * MiB;
constexpr size_t WS_W12 = 72 * MiB;
constexpr size_t WS_WGU = 88 * MiB;
constexpr size_t WS_WD = 600 * MiB;
constexpr size_t WS_XC = 856 * MiB;
constexpr size_t WS_U = 864 * MiB;
constexpr size_t WS_ZT = 932 * MiB;
constexpr size_t WS_YXT = 1138 * MiB;
constexpr size_t WS_YX = 1207 * MiB;
constexpr size_t WS_H = 1275 * MiB;
constexpr size_t WS_EO = 1359 * MiB;
constexpr size_t WS_END = 1527 * MiB;
constexpr size_t WS_YF = WS_ZT, WS_YB = WS_ZT + 64 * MiB, WS_G = WS_ZT + 128 * MiB;

constexpr int CW_TMO = 0;
constexpr int CW_BAR = 4096;
constexpr int CW_P1 = 3136;
constexpr int CW_P4 = 3072;
constexpr int CW_CVTQ = 2048;
constexpr int CW_CNT = 8192;

constexpr int LDS_BYTES = 147456;
constexpr int ROWTAB_OFF = 131072;
constexpr int TAB_OFF = 139264;
constexpr int MISC_OFF = 141312;

#define LDS_WAIT() asm volatile("s_waitcnt lgkmcnt(0)" ::: "memory")
#define VM_WAIT() asm volatile("s_waitcnt vmcnt(0)" ::: "memory")
#define LDS_BARRIER() do { asm volatile("s_waitcnt lgkmcnt(0)" ::: "memory"); __builtin_amdgcn_s_barrier(); asm volatile("" ::: "memory"); } while (0)
__device__ __forceinline__ unsigned f2bf(float f) { unsigned u = __builtin_bit_cast(unsigned, f); return (u + 0x7fffu + ((u >> 16) & 1u)) >> 16; }
typedef __bf16 bf16x2_t __attribute__((ext_vector_type(2)));
__device__ __forceinline__ unsigned pk2(float lo, float hi) { const f32x2 v = {lo, hi}; const bf16x2_t b = __builtin_convertvector(v, bf16x2_t); return __builtin_bit_cast(unsigned, b); }
__device__ __forceinline__ float bf2f(unsigned short b) { return __builtin_bit_cast(float, ((unsigned)b) << 16); }
__device__ __forceinline__ float bflo(unsigned w) { return __builtin_bit_cast(float, w << 16); }
__device__ __forceinline__ float bfhi(unsigned w) { return __builtin_bit_cast(float, w & 0xffff0000u); }
__device__ __forceinline__ float wave_sum(float v) {
#pragma unroll
    for (int o = 1; o < 64; o <<= 1) v += __shfl_xor(v, o);
    return v;
}
__device__ __forceinline__ float sigmoidf_(float x) { return 1.0f / (1.0f + __expf(-x)); }
__device__ __forceinline__ float siluf_(float x) { return x / (1.0f + __expf(-x)); }

#define XB_TMO      128
#define XB_XCNT(j)  (256  + 64 * (j))
#define XB_XSUB(j)  (1280 + 64 * (j))
#define XB_XGEN(j)  (2304 + 64 * (j))
#define XB_TOP      3328
#define XB_TOPGEN   3392
#define XCD_BAR_WORDS 3456
#define XB_SPIN_CAP (1u << 18)
__device__ __forceinline__ unsigned xb_ld(unsigned* p)              { return __hip_atomic_load(p, __ATOMIC_RELAXED, __HIP_MEMORY_SCOPE_AGENT); }
__device__ __forceinline__ unsigned xb_add(unsigned* p, unsigned v) { return __hip_atomic_fetch_add(p, v, __ATOMIC_RELAXED, __HIP_MEMORY_SCOPE_AGENT); }
__device__ __forceinline__ unsigned xb_xcc_id() { return (unsigned)__builtin_amdgcn_s_getreg((3 << 11) | 20) & 0xFu; }
#define XB_SPIN(cond, bar) do { unsigned _sp = 0; while (cond) { __builtin_amdgcn_s_sleep(1); \
    if ((++_sp & 255u) == 0u) { if (xb_ld(&(bar)[XB_TMO])) break; if (_sp > XB_SPIN_CAP) { atomicAdd(&(bar)[XB_TMO], 1u); break; } } } } while (0)
struct XcdBarrier { unsigned* bar; unsigned x; volatile LAS unsigned* st; };
__device__ __forceinline__ XcdBarrier xcd_barrier_post(unsigned* bar, volatile LAS unsigned* st) {
    XcdBarrier b; b.bar = bar; b.x = xb_xcc_id(); b.st = st;
    if (threadIdx.x == 0) (void)xb_add(&bar[XB_XCNT(b.x)], 1u);
    return b;
}
__device__ __forceinline__ void xcd_barrier_complete(unsigned* bar, unsigned x, unsigned& nloc, unsigned& nx) {
    const unsigned G = gridDim.x * gridDim.y * gridDim.z;
    unsigned sum, cnt, mine, sp = 0u;
    for (;;) {
        sum = 0u; cnt = 0u; mine = 0u;
#pragma unroll
        for (unsigned j = 0; j < 16; ++j) { const unsigned c = xb_ld(&bar[XB_XCNT(j)]); sum += c; cnt += (c > 0u) ? 1u : 0u; mine = (j == x) ? c : mine; }
        if (sum == G) break;
        __builtin_amdgcn_s_sleep(1);
        if ((++sp & 255u) == 0u) { if (xb_ld(&bar[XB_TMO])) break; if (sp > XB_SPIN_CAP) { atomicAdd(&bar[XB_TMO], 1u); break; } }
    }
    nloc = mine > 0u ? mine : 1u; nx = cnt > 0u ? cnt : 1u;
}
__device__ __forceinline__ void xcd_barrier(const XcdBarrier& b) {
    asm volatile("s_waitcnt vmcnt(0)" ::: "memory");
    __syncthreads();
    if (threadIdx.x == 0) {
        unsigned* bar = b.bar;
        __builtin_amdgcn_s_waitcnt(0);
        unsigned nloc = b.st[0], nx = b.st[1];
        if (nloc == 0u) { xcd_barrier_complete(bar, b.x, nloc, nx); b.st[0] = nloc; b.st[1] = nx; }
        const unsigned old = xb_add(&bar[XB_XSUB(b.x)], 1u);
        const unsigned gen = old / nloc;
        if (old + 1u == (gen + 1u) * nloc) {
            __builtin_amdgcn_fence(__ATOMIC_RELEASE, "agent");
            asm volatile("s_waitcnt vmcnt(0)" ::: "memory");
            const unsigned og = xb_add(&bar[XB_TOP], 1u);
            const unsigned tg = og / nx;
            if (og + 1u == (tg + 1u) * nx) xb_add(&bar[XB_TOPGEN], 1u);
            else XB_SPIN(xb_ld(&bar[XB_TOPGEN]) == tg, bar);
            __builtin_amdgcn_fence(__ATOMIC_ACQUIRE, "agent");
            xb_add(&bar[XB_XGEN(b.x)], 1u);
            asm volatile("s_waitcnt vmcnt(0)" ::: "memory");
        } else {
            XB_SPIN(xb_ld(&bar[XB_XGEN(b.x)]) == gen, bar);
            __builtin_amdgcn_fence(__ATOMIC_ACQUIRE, "agent");
            asm volatile("s_waitcnt vmcnt(0)" ::: "memory");
        }
    }
    __syncthreads();
}
namespace pg8 {
constexpr int BM = 256, BK = 64, HALF = 128, HTB = HALF * BK * 2, STAGE_BYTES = 8 * HTB, NXCD = 8, WGM = 8;
__device__ __forceinline__ int lds_byte(int r, int c) { const int st = (r >> 4) * 2 + (c >> 5), rr = r & 15, cc = c & 31, ob = rr * 64 + cc * 2; return st * 1024 + (ob ^ (((ob >> 9) & 1) << 5)); }
__device__ __forceinline__ void stage_rc(int b, int& R, int& C) { const int st = b / 1024, sb = b % 1024, swz = sb ^ (((sb >> 9) & 1) << 5); R = (st >> 1) * 16 + swz / 64; C = (st & 1) * 32 + (swz % 64) / 2; }
__device__ __forceinline__ int perm32(int rho) { const int n = rho >> 4, i = rho & 15; return 8 * (i >> 2) + 4 * n + (i & 3); }

struct Unit { const char* A; const char* B; int pm, pn, ui; };

struct DenseOrder {
    const char* A; const char* B; int nM, nN, nwg, G, c; size_t tstep;
    __device__ __forceinline__ void init(const void* A_, const void* B_, int M, int N, int K, int G_, int c_) { A = (const char*)A_; B = (const char*)B_; nM = M / BM; nN = N / BM; nwg = nM * nN; G = G_; c = c_; tstep = (size_t)BM * K * 2; }
    __device__ __forceinline__ bool next(int i, Unit& u) const {
        const long L = (long)i * G + c; if (L >= nwg) return false;
        int wgid = (int)L; { const int q = nwg / NXCD, r = nwg % NXCD, xcd = wgid % NXCD, off = wgid / NXCD; wgid = (xcd < r ? xcd * (q + 1) : r * (q + 1) + (xcd - r) * q) + off; }
        const int nig = WGM * nN, gid = wgid / nig, fm = gid * WGM, gsz = (nM - fm) < WGM ? (nM - fm) : WGM;
        u.pm = fm + ((wgid % nig) % gsz); u.pn = (wgid % nig) / gsz; u.ui = i;
        u.A = A + (size_t)u.pm * tstep; u.B = B + (size_t)u.pn * tstep; return true;
    }
};
struct P2Order {
    DenseOrder D; int sub;
    __device__ __forceinline__ bool next(int i, Unit& u) const {
        if (sub == 0) { if (i > 0 || D.c >= 96) return false; u.pm = D.c >> 2; u.pn = TL / BM + (D.c & 3); u.ui = 0; u.A = D.A + (size_t)u.pm * D.tstep; u.B = D.B + (size_t)u.pn * D.tstep; return true; }
        return D.next(i, u);
    }
};
struct P5Order {
    DenseOrder D; int sub;
    __device__ __forceinline__ bool next(int i, Unit& u) const {
        if (sub == 0) { if (i > 0 || D.c >= 32) return false; u.pm = TL / BM + (D.c >> 3); u.pn = D.c & 7; u.ui = 0; u.A = D.A + (size_t)u.pm * D.tstep; u.B = D.B + (size_t)u.pn * D.tstep; return true; }
        return D.next(i, u);
    }
};
struct MoeOrder {
    const char* A; const char* B; const LAS int* rb_e; int nrb, nN, G, c; size_t tstepA, tstepB, estepB; bool gather;
    __device__ __forceinline__ bool next(int i, Unit& u) const {
        const int L = i * G + c; if (L >= nrb * nN) return false;
        const int rbi = L / nN, pn = L - rbi * nN; const int e = rb_e[rbi];
        u.pm = rbi; u.pn = pn; u.ui = i; u.A = gather ? A : A + (size_t)rbi * tstepA; u.B = B + (size_t)e * estepB + (size_t)pn * tstepB; return true;
    }
};

__device__ __forceinline__ unsigned cvt_pk_bf16(float lo, float hi) { return pk2(lo, hi); }

typedef f32x4 Acc[2][2][4][2];

struct EpiZT {
    static constexpr bool PERM = true;
    bf16* O; int ldc; const float* bias;
    __device__ __forceinline__ void operator()(const Acc& acc, const Unit& u, int wr, int wc, int fr, int fq) const {
        const int row0 = u.pm * BM + wr * 64 + fr, col0 = u.pn * BM + wc * 32 + 8 * fq;
        float bvv[2][4];
#pragma unroll
        for (int ai = 0; ai < 2; ++ai)
#pragma unroll
            for (int m = 0; m < 4; ++m) bvv[ai][m] = bias[row0 + ai * HALF + m * 16];
#pragma unroll
        for (int ai = 0; ai < 2; ++ai)
#pragma unroll
            for (int m = 0; m < 4; ++m) { const int r = row0 + ai * HALF + m * 16; const float bv = bvv[ai][m]; bf16* rowp = O + (size_t)r * ldc + col0;
#pragma unroll
                for (int bj = 0; bj < 2; ++bj) { const f32x4 v0 = acc[ai][bj][m][0] + bv, v1 = acc[ai][bj][m][1] + bv;
                    u32x4 w; w.x = cvt_pk_bf16(v0[0], v0[1]); w.y = cvt_pk_bf16(v0[2], v0[3]); w.z = cvt_pk_bf16(v1[0], v1[1]); w.w = cvt_pk_bf16(v1[2], v1[3]);
                    *(u32x4*)(rowp + bj * HALF) = w; } }
    }
};
struct EpiBf {
    static constexpr bool PERM = true;
    bf16* O; int ldc;
    __device__ __forceinline__ void operator()(const Acc& acc, const Unit& u, int wr, int wc, int fr, int fq) const {
        const int row0 = u.pm * BM + wr * 64 + fr, col0 = u.pn * BM + wc * 32 + 8 * fq;
#pragma unroll
        for (int ai = 0; ai < 2; ++ai)
#pragma unroll
            for (int m = 0; m < 4; ++m) { bf16* rowp = O + (size_t)(row0 + ai * HALF + m * 16) * ldc + col0;
#pragma unroll
                for (int bj = 0; bj < 2; ++bj) { const f32x4 v0 = acc[ai][bj][m][0], v1 = acc[ai][bj][m][1];
                    u32x4 w; w.x = cvt_pk_bf16(v0[0], v0[1]); w.y = cvt_pk_bf16(v0[2], v0[3]); w.z = cvt_pk_bf16(v1[0], v1[1]); w.w = cvt_pk_bf16(v1[2], v1[3]);
                    *(u32x4*)(rowp + bj * HALF) = w; } }
    }
};
struct EpiGU {
    static constexpr bool PERM = true;
    bf16* O; int ldc;
    __device__ __forceinline__ void operator()(const Acc& acc, const Unit& u, int wr, int wc, int fr, int fq) const {
        const int row0 = u.pm * BM + wr * 64 + fr, col0 = u.pn * HALF + wc * 32 + 8 * fq;
#pragma unroll
        for (int ai = 0; ai < 2; ++ai)
#pragma unroll
            for (int m = 0; m < 4; ++m) { bf16* rowp = O + (size_t)(row0 + ai * HALF + m * 16) * ldc + col0;
                f32x4 h0, h1;
#pragma unroll
                for (int j = 0; j < 4; ++j) { h0[j] = siluf_(acc[ai][0][m][0][j]) * acc[ai][1][m][0][j]; h1[j] = siluf_(acc[ai][0][m][1][j]) * acc[ai][1][m][1][j]; }
                u32x4 w; w.x = cvt_pk_bf16(h0[0], h0[1]); w.y = cvt_pk_bf16(h0[2], h0[3]); w.z = cvt_pk_bf16(h1[0], h1[1]); w.w = cvt_pk_bf16(h1[2], h1[3]);
                *(u32x4*)rowp = w; }
    }
};
struct EpiRes {
    static constexpr bool PERM = false;
    const float* base_l; float* out_l; const float* gate_l;
    const float* base_c; float* out_c; const float* gate_c; int gstride; const float* bias;
    __device__ __forceinline__ void operator()(const Acc& acc, const Unit& u, int wr, int wc, int fr, int fq) const {
        const bool isc = u.pm >= TL / BM; const int prow = isc ? u.pm - TL / BM : u.pm;
        const float* base = isc ? base_c : base_l; float* out = isc ? out_c : out_l; const float* gate = isc ? gate_c : gate_l + (size_t)(u.pm / (SL / BM)) * gstride;
        const int row0 = prow * BM + wr * 64 + fr, col0 = u.pn * BM + wc * 32 + 4 * fq;
        f32x4 bv[2][2], gv[2][2];
#pragma unroll
        for (int bj = 0; bj < 2; ++bj)
#pragma unroll
            for (int n = 0; n < 2; ++n) { bv[bj][n] = *(const f32x4*)(bias + col0 + bj * HALF + n * 16); gv[bj][n] = *(const f32x4*)(gate + col0 + bj * HALF + n * 16); }
#pragma unroll
        for (int ai = 0; ai < 2; ++ai)
#pragma unroll
            for (int mh = 0; mh < 2; ++mh) { f32x4 bs[2][2][2];
#pragma unroll
                for (int mm = 0; mm < 2; ++mm) { const size_t off = (size_t)(row0 + ai * HALF + (2 * mh + mm) * 16) * D + col0;
#pragma unroll
                    for (int bj = 0; bj < 2; ++bj)
#pragma unroll
                        for (int n = 0; n < 2; ++n) bs[mm][bj][n] = *(const f32x4*)(base + off + bj * HALF + n * 16); }
#pragma unroll
                for (int mm = 0; mm < 2; ++mm) { const int m = 2 * mh + mm; const size_t off = (size_t)(row0 + ai * HALF + m * 16) * D + col0;
#pragma unroll
                    for (int bj = 0; bj < 2; ++bj)
#pragma unroll
                        for (int n = 0; n < 2; ++n) *(f32x4*)(out + off + bj * HALF + n * 16) = bs[mm][bj][n] + gv[bj][n] * (acc[ai][bj][m][n] + bv[bj][n]); }
                asm volatile("" ::: "memory"); }
    }
};
struct EpiGlu {
    static constexpr bool PERM = false;
    float* x; const float* gate; int gstride; const float* b1; const float* b2;
    __device__ __forceinline__ void operator()(const Acc& acc, const Unit& u, int wr, int wc, int fr, int fq) const {
        const float* g = gate + (size_t)(u.pm / (SL / BM)) * gstride;
        const int row0 = u.pm * BM + wr * 64 + fr, col0 = u.pn * HALF + wc * 32 + 4 * fq;
        f32x4 b1v[2], b2v[2], gv[2];
#pragma unroll
        for (int n = 0; n < 2; ++n) { b1v[n] = *(const f32x4*)(b1 + col0 + n * 16); b2v[n] = *(const f32x4*)(b2 + col0 + n * 16); gv[n] = *(const f32x4*)(g + col0 + n * 16); }
#define EG_LOAD(bs_, q_) do { _Pragma("unroll") for (int mm = 0; mm < 2; ++mm) _Pragma("unroll") for (int n = 0; n < 2; ++n) \
            bs_[mm][n] = *(const f32x4*)(x + (size_t)(row0 + ((q_) >> 1) * HALF + (2 * ((q_) & 1) + mm) * 16) * D + col0 + n * 16); asm volatile("" ::: "memory"); } while (0)
#define EG_STORE(bs_, q_) do { _Pragma("unroll") for (int mm = 0; mm < 2; ++mm) { const int m_ = 2 * ((q_) & 1) + mm; float* rowp = x + (size_t)(row0 + ((q_) >> 1) * HALF + m_ * 16) * D + col0; \
            _Pragma("unroll") for (int n = 0; n < 2; ++n) { const f32x4 a = acc[(q_) >> 1][0][m_][n] + b1v[n], b = acc[(q_) >> 1][1][m_][n] + b2v[n]; f32x4 o; \
                _Pragma("unroll") for (int j = 0; j < 4; ++j) o[j] = a[j] * sigmoidf_(b[j]); \
                *(f32x4*)(rowp + n * 16) = bs_[mm][n] + gv[n] * o; } } asm volatile("" ::: "memory"); } while (0)
        f32x4 bsA[2][2], bsB[2][2], bsC[2][2];
        EG_LOAD(bsA, 0); EG_LOAD(bsB, 1); EG_LOAD(bsC, 2); EG_STORE(bsA, 0); EG_LOAD(bsA, 3); EG_STORE(bsB, 1); EG_STORE(bsC, 2); EG_STORE(bsA, 3);
#undef EG_LOAD
#undef EG_STORE
    }
};

template <class Epi, class Sched, bool GATHER>
__device__ __forceinline__ void gemm_phase(LAS unsigned char* lds, const int K, const Sched& S, const Epi& E, const LAS unsigned* rowtab) {
    const int tid = threadIdx.x, wid = __builtin_amdgcn_readfirstlane(tid >> 6), lane = tid & 63, wr = wid >> 2, wc = wid & 3, fr = lane & 15, fq = lane >> 4;
    const int nt = K / BK;
    unsigned voffB[2]; unsigned cv[2][2], nv[2][2]; int Rr[2], Cc[2];
    const size_t kstep = (size_t)(BK * 2);
    const size_t hstep = (size_t)HALF * K * 2;
#pragma unroll
    for (int i = 0; i < 2; ++i) { int R, C; stage_rc(tid * 16 + i * 8192, R, C); const int Rb = Epi::PERM ? ((R & ~31) + perm32(R & 31)) : R;
        Rr[i] = R; Cc[i] = C; voffB[i] = (unsigned)(Rb * K + C) * 2u;
        if constexpr (!GATHER) { cv[0][i] = (unsigned)(R * K + C) * 2u; cv[1][i] = cv[0][i] + (unsigned)hstep; } }
    const unsigned ldsw = (unsigned)wid * 1024u;
    const int aoff = lds_byte(wr * 64 + fr, fq * 8), boff = lds_byte(wc * 32 + fr, fq * 8);
#define PG8_SA(b, h) (((b) * 2 + (h)) * HTB)
#define PG8_SB(b, h) ((4 + (b) * 2 + (h)) * HTB)
#define PG8_STAGE(bufoff, gbase, voff) do { _Pragma("unroll") for (int _i = 0; _i < 2; ++_i) \
        __builtin_amdgcn_global_load_lds((const unsigned*)((const char*)(gbase) + (voff)[_i]), (LAS unsigned*)(lds + (bufoff) + ldsw + _i * 8192), 16, 0, 0); } while (0)
#define PG8_LDROWS(dst, uix) do { _Pragma("unroll") for (int _h = 0; _h < 2; ++_h) _Pragma("unroll") for (int _i = 0; _i < 2; ++_i) \
        dst[_h][_i] = rowtab[(uix) * 256 + _h * 128 + Rr[_i]] + (unsigned)(Cc[_i] * 2); } while (0)
#define PG8_LDA(dst, b, h) do { _Pragma("unroll") for (int m = 0; m < 4; ++m) _Pragma("unroll") for (int k = 0; k < 2; ++k) dst[m][k] = *(const LAS bf16x8*)(lds + PG8_SA(b, h) + aoff + m * 2048 + k * 1024); } while (0)
#define PG8_LDB(dst, b, h) do { _Pragma("unroll") for (int n = 0; n < 2; ++n) _Pragma("unroll") for (int k = 0; k < 2; ++k) dst[n][k] = *(const LAS bf16x8*)(lds + PG8_SB(b, h) + boff + n * 2048 + k * 1024); } while (0)
#define PG8_MMA(ai, bj, At, Bt) do { __builtin_amdgcn_s_setprio(1); _Pragma("unroll") for (int m = 0; m < 4; ++m) _Pragma("unroll") for (int n = 0; n < 2; ++n) _Pragma("unroll") for (int k = 0; k < 2; ++k) \
        acc[ai][bj][m][n] = __builtin_amdgcn_mfma_f32_16x16x32_bf16(Bt[n][k], At[m][k], acc[ai][bj][m][n], 0, 0, 0); __builtin_amdgcn_s_setprio(0); } while (0)
#define PG8_WAIT_V(n) asm volatile("s_waitcnt vmcnt(" #n ")" ::: "memory")
#define PG8_WAIT_L(n) asm volatile("s_waitcnt lgkmcnt(" #n ")" ::: "memory")
#define PG8_BAR __builtin_amdgcn_s_barrier()
#define PG8_SCHED __builtin_amdgcn_sched_barrier(0)
    Unit cur, nxt; int ui = 0;
    if (!S.next(0, cur)) return;
    Acc acc;
#pragma unroll
    for (int a = 0; a < 2; ++a)
#pragma unroll
        for (int b = 0; b < 2; ++b)
#pragma unroll
            for (int m = 0; m < 4; ++m)
#pragma unroll
                for (int n = 0; n < 2; ++n) acc[a][b][m][n] = (f32x4){0.f, 0.f, 0.f, 0.f};
    bf16x8 At[4][2], B0[2][2], B1[2][2];
    const char* cA = cur.A; const char* cB = cur.B;
    if constexpr (GATHER) { PG8_LDROWS(cv, cur.ui); PG8_WAIT_L(0); }
    PG8_STAGE(PG8_SB(0, 0), cB, voffB); PG8_STAGE(PG8_SB(0, 1), cB + hstep, voffB); PG8_STAGE(PG8_SA(0, 0), cA, cv[0]); PG8_STAGE(PG8_SA(0, 1), cA, cv[1]);
    if (wr == 1) PG8_BAR;
    PG8_WAIT_V(2); PG8_BAR;
    PG8_STAGE(PG8_SB(1, 0), cB + kstep, voffB); PG8_STAGE(PG8_SA(1, 0), cA + kstep, cv[0]); PG8_STAGE(PG8_SB(1, 1), cB + hstep + kstep, voffB);
    PG8_WAIT_V(6); PG8_BAR;
    for (;;) {
        const bool has_next = S.next(ui + 1, nxt);
        const char* nA = has_next ? nxt.A : cA; const char* nB = has_next ? nxt.B : cB;
        for (int t = 0; t < nt; t += 2) {
            const bool last = (t == nt - 2);
            const char* a1 = cA + (size_t)(t + 1) * kstep;
            const char* a2 = last ? nA : cA + (size_t)(t + 2) * kstep; const char* b2 = last ? nB : cB + (size_t)(t + 2) * kstep;
            const char* a3 = a2 + kstep; const char* b3 = b2 + kstep;
            if constexpr (GATHER) { if (last) { PG8_LDROWS(nv, has_next ? nxt.ui : cur.ui); } else {
#pragma unroll
                for (int h = 0; h < 2; ++h)
#pragma unroll
                    for (int i = 0; i < 2; ++i) nv[h][i] = cv[h][i]; } }
            else {
#pragma unroll
                for (int h = 0; h < 2; ++h)
#pragma unroll
                    for (int i = 0; i < 2; ++i) nv[h][i] = cv[h][i]; }
            PG8_LDB(B0, 0, 0); PG8_LDB(B1, 0, 1); PG8_SCHED; PG8_LDA(At, 0, 0); PG8_STAGE(PG8_SA(1, 1), a1, cv[1]);
            PG8_WAIT_V(8); PG8_WAIT_L(0); PG8_BAR; PG8_MMA(0, 0, At, B0); PG8_MMA(0, 1, At, B1); PG8_BAR; PG8_SCHED;
            PG8_LDA(At, 0, 1); PG8_STAGE(PG8_SB(0, 0), b2, voffB); PG8_STAGE(PG8_SB(0, 1), b2 + hstep, voffB); PG8_STAGE(PG8_SA(0, 0), a2, nv[0]);
            PG8_WAIT_V(8); PG8_WAIT_L(0); PG8_BAR; PG8_MMA(1, 0, At, B0); PG8_MMA(1, 1, At, B1); PG8_BAR; PG8_SCHED;
            PG8_LDB(B0, 1, 0); PG8_LDB(B1, 1, 1); PG8_SCHED; PG8_LDA(At, 1, 0); PG8_STAGE(PG8_SA(0, 1), a2, nv[1]);
            PG8_WAIT_V(8); PG8_WAIT_L(0); PG8_BAR; PG8_MMA(0, 0, At, B0); PG8_MMA(0, 1, At, B1); PG8_BAR; PG8_SCHED;
            PG8_LDA(At, 1, 1); PG8_STAGE(PG8_SB(1, 0), b3, voffB); PG8_STAGE(PG8_SB(1, 1), b3 + hstep, voffB); PG8_STAGE(PG8_SA(1, 0), a3, nv[0]);
            PG8_WAIT_V(8); PG8_WAIT_L(0); PG8_BAR; PG8_MMA(1, 0, At, B0); PG8_MMA(1, 1, At, B1); PG8_BAR; PG8_SCHED;
        }
        if (wr == 0) PG8_BAR;
        E(acc, cur, wr, wc, fr, fq);
        if (!has_next) break;
#pragma unroll
        for (int a = 0; a < 2; ++a)
#pragma unroll
            for (int b = 0; b < 2; ++b)
#pragma unroll
                for (int m = 0; m < 4; ++m)
#pragma unroll
                    for (int n = 0; n < 2; ++n) acc[a][b][m][n] = (f32x4){0.f, 0.f, 0.f, 0.f};
        cur = nxt; cA = nA; cB = nB; ++ui;
        if constexpr (GATHER) {
#pragma unroll
            for (int h = 0; h < 2; ++h)
#pragma unroll
                for (int i = 0; i < 2; ++i) cv[h][i] = nv[h][i]; }
        if (wr == 1) PG8_BAR;
    }
    PG8_WAIT_V(0);
    PG8_BAR;
#undef PG8_SA
#undef PG8_SB
#undef PG8_STAGE
#undef PG8_LDROWS
#undef PG8_LDA
#undef PG8_LDB
#undef PG8_MMA
#undef PG8_WAIT_V
#undef PG8_WAIT_L
#undef PG8_BAR
#undef PG8_SCHED
}
}
struct Params { const float* in[40]; float* out; unsigned char* ws; int ph_lo, ph_hi; };
enum { I_X = 0, I_C, I_CTX, I_CCTX, I_ADAW, I_ADAB, I_NORMG, I_FINALG, I_HWIN, I_HBIN, I_HCW, I_HCB, I_FW1, I_FB1, I_FW2, I_FB2, I_FW3, I_FREQ, I_SKIP, I_HWOUT, I_HBOUT,
       I_SARE, I_SAIM, I_SLOG, I_SBRE, I_SBIM, I_SCRE, I_SCIM, I_SD, I_SW1, I_SB1, I_SW2, I_SB2, I_MWG, I_MBG, I_MWE, I_MBE, I_MGATE, I_MUP, I_MDOWN };

struct Frame {
    LAS unsigned char* lds; unsigned* ctl; unsigned char* ws; const float* const* in; float* out;
    int tid, lane, wave, G, c;
};
#define MODP(F, l, r) ((const float*)((F).ws + WS_MOD) + ((size_t)(l) * 5 + (r)) * 12288)

struct TItem { const float* src; bf16* dst; int N, K; };
__device__ __forceinline__ void p0_item_load(f32x4 (&v)[8], const TItem& t, int lane) {
#pragma unroll
    for (int i = 0; i < 8; ++i) v[i] = *(const GAS f32x4*)(t.src + (size_t)(8 * i + (lane >> 3)) * t.N + 4 * (lane & 7));
}
__device__ __forceinline__ void p0_item_store(const f32x4 (&v)[8], const TItem& t, LAS float* scr, int lane) {
#pragma unroll
    for (int i = 0; i < 8; ++i) { LAS float* s = scr + (8 * i + (lane >> 3)) * 33 + 4 * (lane & 7); s[0] = v[i][0]; s[1] = v[i][1]; s[2] = v[i][2]; s[3] = v[i][3]; }
    LDS_WAIT(); asm volatile("" ::: "memory");
    const int c = lane & 7;
#pragma unroll
    for (int j = 0; j < 4; ++j) { const int n = (lane >> 3) + 8 * j; const LAS float* s = scr + (8 * c) * 33 + n;
        u32x4 o; o.x = pk2(s[0 * 33], s[1 * 33]); o.y = pk2(s[2 * 33], s[3 * 33]); o.z = pk2(s[4 * 33], s[5 * 33]); o.w = pk2(s[6 * 33], s[7 * 33]);
        *(GAS u32x4*)(t.dst + (size_t)n * t.K + 8 * c) = o; }
    LDS_WAIT(); asm volatile("" ::: "memory");
}
__device__ __forceinline__ TItem p0_job(const float* W, int K, int N, bf16* WT, bool ilv, int ilv_off, int idx) {
    const int nblk = N / 32, kb = idx / nblk, nb = idx - kb * nblk, n0 = 32 * nb, k0 = 64 * kb;
    const int drow0 = ilv ? ((n0 >> 7) * 256 + ilv_off + (n0 & 127)) : n0;
    TItem t; t.src = W + (size_t)k0 * N + n0; t.dst = WT + (size_t)drow0 * K + k0; t.N = N; t.K = K; return t;
}
__device__ __forceinline__ TItem p0_decode(const float* const* in, unsigned char* ws, int it) {
    constexpr int N_IN = 32 * 192, N_SQ = 32 * 64, N_E = 1024, N_L = 96 * N_E;
    int r = it;
    if (r < N_IN) return p0_job(in[I_HWIN], 2048, 6144, (bf16*)(ws + WS_WIN), false, 0, r); r -= N_IN;
    if (r < N_SQ) return p0_job(in[I_HWOUT], 2048, 2048, (bf16*)(ws + WS_WOUT), false, 0, r); r -= N_SQ;
    if (r < N_SQ) return p0_job(in[I_SW1], 2048, 2048, (bf16*)(ws + WS_W12), true, 0, r); r -= N_SQ;
    if (r < N_SQ) return p0_job(in[I_SW2], 2048, 2048, (bf16*)(ws + WS_W12), true, 128, r); r -= N_SQ;
    const int l = r / N_L; int q = r - l * N_L;
    if (q < 64 * N_E) { const int e = q / (2 * N_E), w2 = q - e * 2 * N_E, which = w2 / N_E, idx = w2 - which * N_E, le = l * 32 + e;
        return p0_job((which ? in[I_MUP] : in[I_MGATE]) + (size_t)le * 2048 * 1024, 2048, 1024, (bf16*)(ws + WS_WGU) + (size_t)le * 2048 * 2048, true, which ? 128 : 0, idx); }
    q -= 64 * N_E; const int e = q / N_E, idx = q - e * N_E, le = l * 32 + e;
    return p0_job(in[I_MDOWN] + (size_t)le * 1024 * 2048, 1024, 2048, (bf16*)(ws + WS_WD) + (size_t)le * 2048 * 1024, false, 0, idx);
}

__device__ __forceinline__ void p0_adaln(Frame& F) {
    const float* const* in = F.in;
    for (int i = F.c * NTHR + F.tid; i < 2 * 48 * 2048; i += F.G * NTHR) { const int l = i / (48 * 2048), rr = i - l * 48 * 2048, n = rr >> 11, k = rr & 2047;
        ((float*)(F.ws + WS_WRT))[i] = n < 4 ? in[I_MWG][((size_t)l * 2048 + k) * 4 + n] : (n < 36 ? in[I_MWE][((size_t)l * 2048 + k) * 32 + (n - 4)] : 0.f); }
    {
        LAS float* sl = (LAS float*)F.lds;
        for (int i = F.tid; i < 2048 * 5; i += NTHR) { const int r = i / 2048, k = i - r * 2048; const float cv = r < 4 ? in[I_C][r * 2048 + k] : in[I_CCTX][k]; sl[k * 8 + r] = siluf_(cv); }
        __syncthreads();
        LAS float* red = (LAS float*)(F.lds + 65536);
        for (int it = F.c; it < 256; it += F.G) {
            const int l = it >> 7, cbase = 96 * (it & 127); const float* Wl = in[I_ADAW] + (size_t)l * 2048 * 12288;
            const unsigned woff = (unsigned)(cbase + (F.lane & 31));
            float a[3][5];
#pragma unroll
            for (int gq = 0; gq < 3; ++gq)
#pragma unroll
                for (int r = 0; r < 5; ++r) a[gq][r] = 0.f;
            const int kbase = 256 * F.wave + (F.lane >> 5);
#pragma unroll 1
            for (int k0 = 0; k0 < 128; k0 += 8) {
                float wv[8][3];
#pragma unroll
                for (int kk = 0; kk < 8; ++kk)
#pragma unroll
                    for (int gq = 0; gq < 3; ++gq) wv[kk][gq] = Wl[(unsigned)(kbase + 2 * (k0 + kk)) * 12288u + woff + 32u * gq];
#pragma unroll
                for (int kk = 0; kk < 8; ++kk) { const int k = kbase + 2 * (k0 + kk); const f32x4 sv = *(const LAS f32x4*)(sl + k * 8); const float s4 = sl[k * 8 + 4];
#pragma unroll
                    for (int gq = 0; gq < 3; ++gq) { a[gq][0] += sv[0] * wv[kk][gq]; a[gq][1] += sv[1] * wv[kk][gq]; a[gq][2] += sv[2] * wv[kk][gq]; a[gq][3] += sv[3] * wv[kk][gq]; a[gq][4] += s4 * wv[kk][gq]; } }
            }
#pragma unroll
            for (int gq = 0; gq < 3; ++gq)
#pragma unroll
                for (int r = 0; r < 5; ++r) { float v = a[gq][r]; v += __shfl_xor(v, 32); if (F.lane < 32) red[((F.wave * 3 + gq) * 5 + r) * 32 + F.lane] = v; }
            __syncthreads();
            if (F.tid < 480) { float sum = 0.f;
#pragma unroll
                for (int w = 0; w < 8; ++w) sum += red[w * 480 + F.tid];
                const int gq = F.tid / 160, r = (F.tid % 160) >> 5, col = cbase + 32 * gq + (F.tid & 31);
                ((float*)(F.ws + WS_MOD))[((size_t)l * 5 + r) * 12288 + col] = sum + in[I_ADAB][l * 12288 + col]; }
            __syncthreads();
        }
    }
}
__device__ __forceinline__ void p0_filter(Frame& F, int dry = 0) {
    const float* const* in = F.in;
    {
        LAS float* zf = (LAS float*)F.lds;
        LAS float* h1 = (LAS float*)(F.lds + 20480);
        LAS float* h2T = (LAS float*)(F.lds + 57344);
        LAS float* w1s = (LAS float*)(F.lds + 94208);
        LAS float* w2s = (LAS float*)(F.lds + 102656);
        LAS float* vs = (LAS float*)(F.lds + 119040);
        for (int i = F.tid; i < 33 * 64; i += NTHR) w1s[i] = in[I_FW1][i];
        for (int i = F.tid; i < 64 * 64; i += NTHR) w2s[i] = in[I_FW2][i];
        if (F.tid < 64) { vs[F.tid] = in[I_FB1][F.tid]; vs[64 + F.tid] = in[I_FB2][F.tid]; vs[128 + F.tid] = in[I_FREQ][F.tid]; }
        for (int it = F.c; it < 256; it += F.G) {
            const int pb = it >> 3, cb = it & 7, pbase = pb * 136;
            if (!(dry & 1)) {
            for (int i = F.tid; i < 136 * 33; i += NTHR) { const int p = i / 33, m = i - p * 33; const int gp = pbase + p; const int Lq = gp < SL ? SL : CL, j = gp < SL ? gp : gp - SL;
                float v;
                if (m == 0) v = (float)j / (float)(Lq - 1);
                else { const int mm = (m - 1) & 15; const float band = 1e-4f + (float)mm * ((15.0f - 1e-4f) / 15.0f); const float w = (6.283185307179586f / (float)Lq) * (float)j; const float a = band * w;
                    v = (m <= 16) ? __cosf(a) : -__sinf(a); }
                zf[i] = v; }
            __syncthreads();
            {
                const int o = F.tid & 63, pq = F.tid >> 6; float sacc[17];
#pragma unroll
                for (int i = 0; i < 17; ++i) sacc[i] = vs[o];
#pragma unroll 3
                for (int m = 0; m < 33; ++m) { const float w = w1s[m * 64 + o];
#pragma unroll
                    for (int i = 0; i < 17; ++i) sacc[i] += zf[(pq + 8 * i) * 33 + m] * w; }
                const float fr = vs[128 + o];
#pragma unroll
                for (int i = 0; i < 17; ++i) h1[(pq + 8 * i) * 64 + o] = __sinf(fr * sacc[i]); }
            __syncthreads();
            {
                const int o = F.tid & 63, pq = F.tid >> 6; float sacc[17];
#pragma unroll
                for (int i = 0; i < 17; ++i) sacc[i] = vs[64 + o];
#pragma unroll 2
                for (int m4 = 0; m4 < 16; ++m4) { const float w0 = w2s[(4 * m4) * 64 + o], w1 = w2s[(4 * m4 + 1) * 64 + o], w2 = w2s[(4 * m4 + 2) * 64 + o], w3 = w2s[(4 * m4 + 3) * 64 + o];
#pragma unroll
                    for (int i = 0; i < 17; ++i) { const f32x4 hv = *(const LAS f32x4*)(h1 + (pq + 8 * i) * 64 + 4 * m4); sacc[i] += (hv[0] * w0 + hv[1] * w1) + (hv[2] * w2 + hv[3] * w3); } }
                const float fr = vs[128 + o];
#pragma unroll
                for (int i = 0; i < 17; ++i) h2T[o * 136 + pq + 8 * i] = __sinf(fr * sacc[i]); }
            }
            __syncthreads();
            const int cg = F.tid & 127, pg = F.tid >> 7, c0 = 512 * cb + 4 * cg, p0 = 34 * pg;
            f32x4 acc[34];
#pragma unroll
            for (int i = 0; i < 34; ++i) acc[i] = (f32x4){0.f, 0.f, 0.f, 0.f};
            const float* w3 = in[I_FW3] + c0;
            f32x4 wq[2];
#pragma unroll
            for (int k = 0; k < 2; ++k) wq[k] = *(const GAS f32x4*)(w3 + (size_t)k * 4096);
#pragma unroll 1
            for (int o0 = 0; o0 < ((dry & 2) ? 2 : 64); o0 += 2) {
                f32x4 wn[2];
#pragma unroll
                for (int k = 0; k < 2; ++k) { const int on = o0 + 2 + k; wn[k] = *(const GAS f32x4*)(w3 + (size_t)(on < 64 ? on : 63) * 4096); }
#pragma unroll
                for (int k = 0; k < 2; ++k) {
#pragma unroll
                    for (int i = 0; i < 17; ++i) { const f32x2 hv = *(const LAS f32x2*)(h2T + (o0 + k) * 136 + p0 + 2 * i); acc[2 * i] += wq[k] * hv[0]; acc[2 * i + 1] += wq[k] * hv[1]; } }
#pragma unroll
                for (int k = 0; k < 2; ++k) wq[k] = wn[k];
            }
            const int d0 = c0 & 2047;
            const float dstep = ((-15.350567286626973f) - (-3.0701134573253945f)) / 2047.0f;
            float delta[4];
#pragma unroll
            for (int q = 0; q < 4; ++q) delta[q] = fabsf(-3.0701134573253945f + (float)(d0 + q) * dstep);
            LAS unsigned char* T = F.lds;
#pragma unroll 1
            for (int hf = 0; hf < ((dry & 4) ? 0 : 2); ++hf) {
                __syncthreads();
                if ((cg >> 6) == hf) {
#pragma unroll
                    for (int i = 0; i < 17; ++i) { const int gp = pbase + p0 + 2 * i; const bool lat = gp < SL; const int Lq = lat ? SL : CL, j = lat ? gp : gp - SL;
                        const float t0 = (float)j / (float)(Lq - 1), t1 = (float)(j + 1) / (float)(Lq - 1);
#pragma unroll
                        for (int q = 0; q < 4; ++q)
                            *(LAS unsigned*)(T + (4 * (cg & 63) + q) * 276 + (p0 + 2 * i) * 2) = pk2(acc[2 * i][q] * __expf(-t0 * delta[q]), acc[2 * i + 1][q] * __expf(-t1 * delta[q])); } }
                __syncthreads();
                for (int idx = F.tid; idx < 256 * 17; idx += NTHR) { const int col = idx / 17, k = idx - col * 17; const LAS unsigned* sp = (const LAS unsigned*)(T + col * 276 + 16 * k);
                    const u32x4 o = {sp[0], sp[1], sp[2], sp[3]};
                    const int c = 512 * cb + 256 * hf + col, dirn = c >> 11, dd = c & 2047, gp0 = pbase + 8 * k;
                    bf16* dst = gp0 < SL ? (bf16*)(F.ws + WS_KRN) + ((size_t)dd * 2 + dirn) * SL + gp0 : (bf16*)(F.ws + WS_KRC) + ((size_t)dd * 2 + dirn) * CL + (gp0 - SL);
                    if (!dry) *(GAS u32x4*)dst = o; else if (o.x == 0x12345678u) *(GAS u32x4*)dst = o; }
            }
            __syncthreads();
        }
    }
}
constexpr int CVT_DENSE = 32 * 192 + 3 * 32 * 64, CVT_GU0 = CVT_DENSE + 65536, CVT_D0 = CVT_GU0 + 32768, CVT_GU1 = CVT_D0 + 65536, CVT_NITEMS = CVT_D0 + 98304;
constexpr int CVT_CHUNK = 8;
#ifndef CVT_P10_ITEMS
#define CVT_P10_ITEMS 30720
#endif
constexpr int CVT_P10 = CVT_NITEMS - CVT_P10_ITEMS;
__device__ __forceinline__ void cvt_weights(Frame& F, int lo, int hi, int wi, int nw, LAS float* scr) {
    const float* const* in = F.in;
    f32x4 va[8], vb[8];
    int it = lo + wi;
    TItem ta = p0_decode(in, F.ws, it < hi ? it : hi - 1), tb;
    p0_item_load(va, ta, F.lane);
#pragma unroll 1
    for (; it < hi; it += 2 * nw) {
        const int ib = it + nw, ia = it + 2 * nw;
        tb = p0_decode(in, F.ws, ib < hi ? ib : hi - 1); p0_item_load(vb, tb, F.lane);
        p0_item_store(va, ta, scr, F.lane);
        ta = p0_decode(in, F.ws, ia < hi ? ia : hi - 1); p0_item_load(va, ta, F.lane);
        if (ib < hi) p0_item_store(vb, tb, scr, F.lane);
    }
}
constexpr int CVT_WG = 128, CVT_TAIL = 32;
__device__ __forceinline__ void cvt_pull(Frame& F, int limit, int max_chunks, bool tail) {
    { int t_ = threadIdx.x; asm volatile("" : "+v"(t_)); F.tid = t_; F.lane = t_ & 63; }
    unsigned* q = F.ctl + CW_CVTQ; LAS float* scr = (LAS float*)(F.lds + F.wave * 8448); volatile LAS int* slot = (volatile LAS int*)(F.lds + MISC_OFF + 64);
    const int csz = tail ? CVT_TAIL : CVT_WG;
#pragma unroll 1
    for (int n = 0; n < max_chunks; ++n) {
        __syncthreads();
        if (F.tid == 0) { int b = CVT_NITEMS; bool go = (int)xb_ld(q) + CVT_DENSE < limit;
            if (go && tail) { const unsigned nloc = ((volatile LAS unsigned*)(F.lds + MISC_OFF))[0]; if (nloc != 0u && (xb_ld(F.ctl + CW_BAR + XB_XSUB(xb_xcc_id())) % nloc) != 0u) go = false; }
            if (go) b = (int)xb_add(q, (unsigned)csz) + CVT_DENSE; slot[0] = b; }
        __syncthreads();
        const int base = slot[0];
        if (base >= CVT_NITEMS) break;
        cvt_weights(F, base, base + csz < CVT_NITEMS ? base + csz : CVT_NITEMS, F.wave, NWAVES, scr);
    }
    __syncthreads();
}
__device__ __forceinline__ void cvt_drain(Frame& F, int d, int limit) {
    unsigned* q = F.ctl + CW_CVTQ; volatile LAS int* slot = (volatile LAS int*)(F.lds + MISC_OFF + 64);
    __syncthreads();
    if (F.tid == 0) { const unsigned cur = xb_ld(q); unsigned expect = 0u;
        const bool won = __hip_atomic_compare_exchange_strong(F.ctl + CW_CVTQ + 64 * (1 + d), &expect, cur + 1u, __ATOMIC_RELAXED, __ATOMIC_RELAXED, __HIP_MEMORY_SCOPE_AGENT);
        const unsigned snap = won ? cur : expect - 1u;
        __hip_atomic_fetch_max(q, (unsigned)(limit - CVT_DENSE), __ATOMIC_RELAXED, __HIP_MEMORY_SCOPE_AGENT);
        slot[0] = (int)snap + CVT_DENSE; }
    __syncthreads();
    const int q0 = slot[0];
    if (q0 < limit) cvt_weights(F, q0, limit, F.c * NWAVES + F.wave, F.G * NWAVES, (LAS float*)(F.lds + F.wave * 8448));
    __syncthreads();
}
struct Row { f32x4 v[8]; };
__device__ __forceinline__ void row_load(Row& r, const float* p, int lane) {
#pragma unroll
    for (int i = 0; i < 8; ++i) r.v[i] = *(const GAS f32x4*)(p + 4 * lane + 256 * i);
}
__device__ __forceinline__ float row_rstd(const Row& r) {
    float s = 0.f;
#pragma unroll
    for (int i = 0; i < 8; ++i) s += (r.v[i][0] * r.v[i][0] + r.v[i][1] * r.v[i][1]) + (r.v[i][2] * r.v[i][2] + r.v[i][3] * r.v[i][3]);
    return 1.0f / sqrtf(wave_sum(s) * (1.0f / D) + EPS);
}
__device__ __forceinline__ void row_norm_mod_store(const Row& r, float rstd, const float* g, const float* sh, const float* sc, bf16* o, int lane) {
    f32x4 mv[8], hv[8];
#pragma unroll
    for (int i = 0; i < 8; ++i) { const int c = 4 * lane + 256 * i;
        const f32x4 gv = *(const GAS f32x4*)(g + c), sv = *(const GAS f32x4*)(sc + c); hv[i] = *(const GAS f32x4*)(sh + c); mv[i] = gv * (sv + 1.0f); }
    asm volatile("" ::: "memory");
#pragma unroll
    for (int i = 0; i < 8; ++i) { const int c = 4 * lane + 256 * i;
        const f32x4 y = (r.v[i] * rstd) * mv[i] + hv[i];
        u32x2 w; w.x = pk2(y[0], y[1]); w.y = pk2(y[2], y[3]); *(GAS u32x2*)(o + c) = w; }
}
__device__ __forceinline__ int moe_pos(const LAS int* rbfirst, int packed) { return 256 * rbfirst[packed >> 20] + (packed & 0xfffff); }
__device__ __forceinline__ void row_add_moe(Row& r, const float* gt, const bf16* eo, int p0, int p1, float g0, float g1, int lane) {
#pragma unroll
    for (int i = 0; i < 8; ++i) { const int c = 4 * lane + 256 * i;
        const u32x2 a = *(const GAS u32x2*)(eo + (size_t)p0 * D + c), b = *(const GAS u32x2*)(eo + (size_t)p1 * D + c); const f32x4 gv = *(const GAS f32x4*)(gt + c);
        f32x4 m; m[0] = g0 * bflo(a.x) + g1 * bflo(b.x); m[1] = g0 * bfhi(a.x) + g1 * bfhi(b.x); m[2] = g0 * bflo(a.y) + g1 * bflo(b.y); m[3] = g0 * bfhi(a.y) + g1 * bfhi(b.y);
        r.v[i] += gv * m; }
}
__device__ __forceinline__ void row_store(const Row& r, float* p, int lane) {
#pragma unroll
    for (int i = 0; i < 8; ++i) *(GAS f32x4*)(p + 4 * lane + 256 * i) = r.v[i];
}
__device__ __forceinline__ int moe_tables_cached(Frame& F, int l);
__device__ __forceinline__ int moe_tables(Frame& F, int l) {
    LAS int* rb_e = (LAS int*)(F.lds + TAB_OFF); LAS int* rbfirst = rb_e + 168; LAS int* cnt = rbfirst + 33;
    __syncthreads();
    if (F.tid < 64) {
        const int e = F.tid & 31; const int c = (int)xb_ld(F.ctl + CW_CNT + (l * 32 + e) * 64); const int n = (c + 255) >> 8;
        int incl = n;
#pragma unroll
        for (int d = 1; d < 32; d <<= 1) { const int t = __shfl_up(incl, d, 64); if (F.tid >= d) incl += t; }
        if (F.tid < 32) { const int first = incl - n; cnt[e] = c; rbfirst[e] = first; for (int k = 0; k < n; ++k) rb_e[first + k] = e; if (e == 31) rbfirst[32] = incl; }
    }
    __syncthreads();
    return rbfirst[32];
}
__device__ __forceinline__ int moe_tables_cached(Frame& F, int l) {
    if (MK_N_LAUNCHES != 1) return moe_tables(F, l);
    return ((const LAS int*)(F.lds + TAB_OFF))[168 + 32];
}

__device__ __forceinline__ void p_norm1_l0(Frame& F) {
    const bool cw = F.c < 96; const int gw = (cw ? F.c : F.c - 96) * NWAVES + F.wave, NGW = (cw ? 96 : F.G - 96) * NWAVES, plo = cw ? TL / 2 : 0, phi = cw ? TT / 2 : TL / 2;
    for (int pr = plo + gw; pr < phi; pr += NGW) { const int r = 2 * pr;
        const bool lat = r < TL; const float* src = lat ? F.in[I_X] + (size_t)r * D : F.in[I_CTX] + (size_t)(r - TL) * D; const float* mod = MODP(F, 0, lat ? (r >> 12) : 4);
        Row ra, rb; row_load(ra, src, F.lane); row_load(rb, src + D, F.lane);
        const float* g = F.in[I_NORMG]; const float* sh = mod; const float* sc = mod + 2048; bf16* o = (bf16*)(F.ws + WS_U) + (size_t)r * D;
        f32x4 mv[8], hv[8];
#pragma unroll
        for (int i = 0; i < 8; ++i) { const int c = 4 * F.lane + 256 * i; const f32x4 gv = *(const GAS f32x4*)(g + c), sv = *(const GAS f32x4*)(sc + c); hv[i] = *(const GAS f32x4*)(sh + c); mv[i] = gv * (sv + 1.0f); }
        const float rsa = row_rstd(ra), rsb = row_rstd(rb);
        asm volatile("" ::: "memory");
#pragma unroll
        for (int i = 0; i < 8; ++i) { const int c = 4 * F.lane + 256 * i;
            const f32x4 ya = (ra.v[i] * rsa) * mv[i] + hv[i], yb = (rb.v[i] * rsb) * mv[i] + hv[i];
            u32x2 wa; wa.x = pk2(ya[0], ya[1]); wa.y = pk2(ya[2], ya[3]); *(GAS u32x2*)(o + c) = wa;
            u32x2 wb; wb.x = pk2(yb[0], yb[1]); wb.y = pk2(yb[2], yb[3]); *(GAS u32x2*)(o + D + c) = wb; }
    }
}
__device__ __forceinline__ void p_comb_norm1_l1(Frame& F) {
    moe_tables_cached(F, 0);
    const LAS int* rbfirst = (const LAS int*)(F.lds + TAB_OFF) + 168;
    const int gw = F.c * NWAVES + F.wave, NGW = F.G * NWAVES;
    const int* tokpos = (const int*)(F.ws + WS_TOKPOS); const float* gates = (const float*)(F.ws + WS_GATE);
    for (int r = gw; r < TT; r += NGW) {
        const bool lat = r < TL; float* xp = lat ? F.out + (size_t)r * D : (float*)(F.ws + WS_XC) + (size_t)(r - TL) * D; const int mr = lat ? (r >> 12) : 4;
        Row row; row_load(row, xp, F.lane);
        const int p0 = moe_pos(rbfirst, tokpos[2 * r]), p1 = moe_pos(rbfirst, tokpos[2 * r + 1]);
        row_add_moe(row, MODP(F, 0, mr) + 10240, (const bf16*)(F.ws + WS_EO), p0, p1, gates[2 * r], gates[2 * r + 1], F.lane);
        row_store(row, xp, F.lane);
        const float rstd = row_rstd(row); const float* mod = MODP(F, 1, mr);
        row_norm_mod_store(row, rstd, F.in[I_NORMG] + 2 * D, mod, mod + 2048, (bf16*)(F.ws + WS_U) + (size_t)r * D, F.lane);
    }
}
__device__ __forceinline__ void p_final(Frame& F) {
    moe_tables_cached(F, 1);
    const LAS int* rbfirst = (const LAS int*)(F.lds + TAB_OFF) + 168;
    const int gw = F.c * NWAVES + F.wave, NGW = F.G * NWAVES;
    const int* tokpos = (const int*)(F.ws + WS_TOKPOS); const float* gates = (const float*)(F.ws + WS_GATE);
    for (int r = gw; r < TL; r += NGW) {
        float* xp = F.out + (size_t)r * D;
        Row row; row_load(row, xp, F.lane);
        const int p0 = moe_pos(rbfirst, tokpos[2 * r]), p1 = moe_pos(rbfirst, tokpos[2 * r + 1]);
        row_add_moe(row, MODP(F, 1, r >> 12) + 10240, (const bf16*)(F.ws + WS_EO), p0, p1, gates[2 * r], gates[2 * r + 1], F.lane);
        const float rstd = row_rstd(row);
#pragma unroll
        for (int i = 0; i < 8; ++i) { const int c = 4 * F.lane + 256 * i; const f32x4 gv = *(const GAS f32x4*)(F.in[I_FINALG] + c); row.v[i] = row.v[i] * rstd * gv; }
        row_store(row, xp, F.lane);
    }
}

__device__ __forceinline__ void p_router(Frame& F, int l, int ntok, int dry = 0) {
    constexpr int PITCH = 2056;
    LAS float* xt = (LAS float*)F.lds;
    LAS float* red = (LAS float*)F.lds;
    LAS float* lg = (LAS float*)(F.lds + 132096);
    const float* wrt = (const float*)(F.ws + WS_WRT) + (size_t)l * 48 * 2048;
    const float* g = F.in[I_NORMG] + (size_t)(l * 2 + 1) * D;
    int* list = (int*)(F.ws + WS_LIST); int* tokpos = (int*)(F.ws + WS_TOKPOS); float* gates = (float*)(F.ws + WS_GATE);
    const int ntile = ntok / 16;
#define ROUTER_XP(t0_) ((t0_) + 2 * F.wave < TL ? F.out + (size_t)((t0_) + 2 * F.wave) * D : (const float*)(F.ws + WS_XC) + (size_t)((t0_) + 2 * F.wave - TL) * D)
    Row ra, rb;
    { const int tf = F.c < ntile ? F.c : ntile - 1; const float* xp = ROUTER_XP(tf * 16); row_load(ra, xp, F.lane); row_load(rb, xp + D, F.lane); }
    LAS float* lbias = lg + 768;
    if (F.tid < 48) lbias[F.tid] = F.tid < 4 ? F.in[I_MBG][l * 4 + F.tid] : (F.tid < 36 ? F.in[I_MBE][l * 32 + F.tid - 4] : 0.f);
    int pr_r = -1, pr_e0 = 0, pr_e1 = 0; unsigned pr_s0 = 0, pr_s1 = 0; float pr_g0 = 0.f, pr_g1 = 0.f;
    f32x4 mvs[8], hvs[8];
#define ROUTER_MOD(tile_) do { const int r0_ = (tile_) * 16 + 2 * F.wave; const float* mod_ = MODP(F, l, r0_ < TL ? (r0_ >> 12) : 4); \
        _Pragma("unroll") for (int i = 0; i < 8; ++i) { const int c = 4 * F.lane + 256 * i; \
            const f32x4 gv = *(const GAS f32x4*)(g + c), sv = *(const GAS f32x4*)(mod_ + 8192 + c); hvs[i] = *(const GAS f32x4*)(mod_ + 6144 + c); mvs[i] = gv * (sv + 1.0f); } } while (0)
    { const int tf = F.c < ntile ? F.c : ntile - 1; ROUTER_MOD(tf); }
#define ROUTER_FINISH() do { if (pr_r >= 0) { list[(size_t)pr_e0 * TT + pr_s0] = pr_r; list[(size_t)pr_e1 * TT + pr_s1] = pr_r; \
        tokpos[2 * pr_r] = (pr_e0 << 20) | (int)pr_s0; tokpos[2 * pr_r + 1] = (pr_e1 << 20) | (int)pr_s1; gates[2 * pr_r] = pr_g0; gates[2 * pr_r + 1] = pr_g1; pr_r = -1; } } while (0)
    LDS_BARRIER();
#pragma unroll 1
    for (int tile = F.c; tile < ntile; tile += F.G) {
        const int t0 = tile * 16;
        {
            const int r0 = t0 + 2 * F.wave;
            if (!(dry & 4)) {
            const float rsa = row_rstd(ra), rsb = row_rstd(rb);
            bf16* oa = (bf16*)(F.ws + WS_U) + (size_t)r0 * D; LAS float* xa = xt + (2 * F.wave) * PITCH;
#pragma unroll
            for (int i = 0; i < 8; ++i) { const int c = 4 * F.lane + 256 * i;
                const f32x4 mv = mvs[i], hv = hvs[i];
                const f32x4 ya = (ra.v[i] * rsa) * mv + hv, yb = (rb.v[i] * rsb) * mv + hv;
                u32x2 wa; wa.x = pk2(ya[0], ya[1]); wa.y = pk2(ya[2], ya[3]); if (!dry) *(GAS u32x2*)(oa + c) = wa;
                u32x2 wb; wb.x = pk2(yb[0], yb[1]); wb.y = pk2(yb[2], yb[3]); if (!dry) *(GAS u32x2*)(oa + D + c) = wb;
                *(LAS f32x4*)(xa + c) = ya; *(LAS f32x4*)(xa + PITCH + c) = yb; } } }
        ROUTER_FINISH();
        const int tk = F.lane & 15, kq = F.lane >> 4, kb = 256 * F.wave + 4 * kq; const LAS float* ap = xt + tk * PITCH + kb;
        const float* bp = wrt + (size_t)tk * 2048 + kb;
        f32x4 wq[4][3];
#pragma unroll
        for (int s = 0; s < 4; ++s)
#pragma unroll
            for (int nt = 0; nt < 3; ++nt) wq[s][nt] = *(const GAS f32x4*)(bp + (size_t)nt * 16 * 2048 + 16 * s);
        LDS_BARRIER();
        f32x4 a0 = {0.f, 0.f, 0.f, 0.f}, a1 = a0, a2 = a0;
#define ROUTER_MMA(S0_) do { _Pragma("unroll") for (int s = 0; s < 4; ++s) { const f32x4 av = *(const LAS f32x4*)(ap + 16 * ((S0_) + s)); \
            _Pragma("unroll") for (int j = 0; j < 4; ++j) { a0 = __builtin_amdgcn_mfma_f32_16x16x4f32(av[j], wq[s][0][j], a0, 0, 0, 0); a1 = __builtin_amdgcn_mfma_f32_16x16x4f32(av[j], wq[s][1][j], a1, 0, 0, 0); \
                a2 = __builtin_amdgcn_mfma_f32_16x16x4f32(av[j], wq[s][2][j], a2, 0, 0, 0); } } } while (0)
#pragma unroll 1
        for (int S0 = 0; S0 < 12; S0 += 4) {
            f32x4 wn[4][3];
#pragma unroll
            for (int s = 0; s < 4; ++s)
#pragma unroll
                for (int nt = 0; nt < 3; ++nt) wn[s][nt] = *(const GAS f32x4*)(bp + (size_t)nt * 16 * 2048 + 16 * (S0 + 4 + s));
            ROUTER_MMA(S0);
#pragma unroll
            for (int s = 0; s < 4; ++s)
#pragma unroll
                for (int nt = 0; nt < 3; ++nt) wq[s][nt] = wn[s][nt];
        }
        { const int tn = tile + F.G < ntile ? tile + F.G : tile; const float* xp = ROUTER_XP(tn * 16); row_load(ra, xp, F.lane); row_load(rb, xp + D, F.lane); }
        ROUTER_MMA(12);
#undef ROUTER_MMA
        LDS_BARRIER();
        { LAS float* rp = red + F.wave * 768;
#pragma unroll
          for (int j = 0; j < 4; ++j) { const int tk = 4 * (F.lane >> 4) + j; rp[tk * 48 + (F.lane & 15)] = a0[j]; rp[tk * 48 + 16 + (F.lane & 15)] = a1[j]; rp[tk * 48 + 32 + (F.lane & 15)] = a2[j]; } }
        LDS_BARRIER();
        for (int i = F.tid; i < 768; i += NTHR) { float s = 0.f;
#pragma unroll
            for (int w = 0; w < 8; ++w) s += red[w * 768 + i];
            s += lbias[i % 48]; lg[i] = s; }
        LDS_BARRIER();
        { const int tn = tile + F.G < ntile ? tile + F.G : tile; ROUTER_MOD(tn); }
        if (F.tid < 16 && !(dry & 2)) { const LAS float* q = lg + F.tid * 48; const int r = t0 + F.tid;
            int gi = 0; float gm = q[0];
#pragma unroll
            for (int k = 1; k < 4; ++k) if (q[k] > gm) { gm = q[k]; gi = k; }
            float gs = 0.f;
#pragma unroll
            for (int k = 0; k < 4; ++k) gs += __expf(q[k] - gm);
            const float ptop = 1.0f / gs;
            const LAS float* e = q + 4 + 8 * gi; int i0 = 0; float v0 = e[0];
#pragma unroll
            for (int k = 1; k < 8; ++k) if (e[k] > v0) { v0 = e[k]; i0 = k; }
            int i1 = -1; float v1 = -3.0e38f;
#pragma unroll
            for (int k = 0; k < 8; ++k) if (k != i0 && e[k] > v1) { v1 = e[k]; i1 = k; }
            const float x1 = __expf(v1 - v0), den = 1.0f / (1.0f + x1);
            const int e0 = gi * 8 + i0, e1 = gi * 8 + i1;
            if (!dry) {
            pr_s0 = xb_add(F.ctl + CW_CNT + (l * 32 + e0) * 64, 1u); pr_s1 = xb_add(F.ctl + CW_CNT + (l * 32 + e1) * 64, 1u);
            pr_r = r; pr_e0 = e0; pr_e1 = e1; pr_g0 = ptop * den; pr_g1 = ptop * x1 * den; }
            else { ((volatile LAS float*)lg)[F.tid * 48 + 40] = ptop * den + (float)(e0 + e1); } }
    }
    ROUTER_FINISH();
#undef ROUTER_FINISH
#undef ROUTER_MOD
#undef ROUTER_XP
}
constexpr int CV_KR = 0, CV_KRC = 16384, CV_ZERO = 17408, CV_V = 17920, CV_VB = 10272, CV_VJ = 640, CV_VC = 59008, CV_VCB = 544, CV_RED = 61184;
__device__ __forceinline__ float conv3(float zm, float z0, float zp, float w0, float w1, float w2, float cb) { return zm * w0 + z0 * w1 + zp * w2 + cb; }
template <int NV> struct ZChunk { u32x4 v[NV]; unsigned short hl, hr; };
template <int NV>
__device__ __forceinline__ void zchunk_load(ZChunk<NV>& z, const bf16* zrow, int col0, int t0, int Lseq) {
#pragma unroll
    for (int i = 0; i < NV; ++i) z.v[i] = *(const GAS u32x4*)(zrow + col0 + 8 * i);
    z.hl = zrow[t0 > 0 ? col0 - 1 : col0];
    z.hr = zrow[(t0 + 8 * NV < Lseq) ? col0 + 8 * NV : col0];
}
template <int NV>
__device__ __forceinline__ void zchunk_conv3(const ZChunk<NV>& zc, int t0, int Lseq, float w0, float w1, float w2, float cb, float* out) {
    float z[8 * NV + 2];
    z[0] = t0 > 0 ? bf2f(zc.hl) : 0.f;
    z[8 * NV + 1] = (t0 + 8 * NV < Lseq) ? bf2f(zc.hr) : 0.f;
#pragma unroll
    for (int i = 0; i < NV; ++i) { const u32x4 w = zc.v[i];
        z[1 + 8 * i] = bflo(w.x); z[2 + 8 * i] = bfhi(w.x); z[3 + 8 * i] = bflo(w.y); z[4 + 8 * i] = bfhi(w.y); z[5 + 8 * i] = bflo(w.z); z[6 + 8 * i] = bfhi(w.z); z[7 + 8 * i] = bflo(w.w); z[8 + 8 * i] = bfhi(w.w); }
#pragma unroll
    for (int i = 0; i < 8 * NV; ++i) out[i] = conv3(z[i], z[i + 1], z[i + 2], w0, w1, w2, cb);
}
#define CV_MMA8(acc, d, bfr) do { \
    unsigned o_[7]; _Pragma("unroll") for (int m_ = 0; m_ < 7; ++m_) o_[m_] = __builtin_amdgcn_alignbit(d[m_ + 1], d[m_], 16); \
    _Pragma("unroll") for (int q_ = 0; q_ < 4; ++q_) { \
        u32x4 fe_ = {d[4 - q_], d[5 - q_], d[6 - q_], d[7 - q_]}; u32x4 fo_ = {o_[3 - q_], o_[4 - q_], o_[5 - q_], o_[6 - q_]}; \
        acc[2 * q_] = __builtin_amdgcn_mfma_f32_16x16x32_bf16(__builtin_bit_cast(bf16x8, fe_), bfr, acc[2 * q_], 0, 0, 0); \
        acc[2 * q_ + 1] = __builtin_amdgcn_mfma_f32_16x16x32_bf16(__builtin_bit_cast(bf16x8, fo_), bfr, acc[2 * q_ + 1], 0, 0, 0); } } while (0)

struct ConvPre { u32x4 kf, kb, kc; ZChunk<4> zv, zx; ZChunk<1> cv, cx; };
__device__ __forceinline__ void conv_issue(ConvPre& P, Frame& F, int d) {
    const int tid = F.tid; const bf16* ZT = (const bf16*)(F.ws + WS_ZT);
    const bf16* kn = (const bf16*)(F.ws + WS_KRN) + (size_t)d * 2 * SL; const bf16* kc = (const bf16*)(F.ws + WS_KRC) + (size_t)d * 2 * CL;
    P.kf = *(const GAS u32x4*)(kn + 8 * tid); P.kb = *(const GAS u32x4*)(kn + SL + 8 * tid);
    P.kc = *(const GAS u32x4*)(kc + ((tid >> 5) & 1) * CL + 8 * (tid & 31));
    { const int b = tid >> 7, t0 = (tid & 127) * 32, col0 = b * SL + t0;
      zchunk_load<4>(P.zv, ZT + (size_t)(4096 + d) * ZLD, col0, t0, SL); zchunk_load<4>(P.zx, ZT + (size_t)(2048 + d) * ZLD, col0, t0, SL); }
    { const int b = (tid >> 5) & 3, t0 = (tid & 31) * 8, col0 = TL + b * CL + t0;
      zchunk_load<1>(P.cv, ZT + (size_t)(4096 + d) * ZLD, col0, t0, CL); zchunk_load<1>(P.cx, ZT + (size_t)(2048 + d) * ZLD, col0, t0, CL); }
}

__device__ __forceinline__ void p_conv(Frame& F) {
    LAS unsigned char* lds = F.lds;
    const bf16* ZT = (const bf16*)(F.ws + WS_ZT); bf16* YXT = (bf16*)(F.ws + WS_YXT);
    const float* cw = F.in[I_HCW]; const float* cbp = F.in[I_HCB];
    const int tid = F.tid, lane = F.lane, w = F.wave, g = w & 1, q = w >> 1, r = lane & 15, h4 = lane >> 4, Isub = r >> 2, bb = r & 3;
    for (int i = tid; i < 128; i += NTHR) ((LAS unsigned*)(lds + CV_ZERO))[i] = 0u;
    ConvPre P;
    if (F.c < D) conv_issue(P, F, F.c);
#pragma unroll 1
    for (int d = F.c; d < D; d += F.G) {
        __syncthreads();
        float nl = 0.f, nc = 0.f;
        { LAS bf16* KR = (LAS bf16*)(lds + CV_KR);
          const unsigned fwv[4] = {P.kf.x, P.kf.y, P.kf.z, P.kf.w}, bwv[4] = {P.kb.x, P.kb.y, P.kb.z, P.kb.w};
#pragma unroll
          for (int e = 0; e < 8; ++e) { const int j = 8 * tid + e; const unsigned short fv = (unsigned short)(fwv[e >> 1] >> (16 * (e & 1))), bv = (unsigned short)(bwv[e >> 1] >> (16 * (e & 1)));
              KR[SL - j] = fv; nl += fabsf(bf2f(fv));
              if (j > 0) { KR[SL + j] = bv; nl += fabsf(bf2f(bv)); } }
          if (tid == 0) KR[0] = 0;
          if (tid < 64) { LAS bf16* KC = (LAS bf16*)(lds + CV_KRC); const int dirn = tid >> 5, j0 = 8 * (tid & 31);
              const unsigned cv4[4] = {P.kc.x, P.kc.y, P.kc.z, P.kc.w};
#pragma unroll
              for (int e = 0; e < 8; ++e) { const int j = j0 + e; const unsigned short v = (unsigned short)(cv4[e >> 1] >> (16 * (e & 1)));
                  if (dirn == 0) { KC[CL - j] = v; nc += fabsf(bf2f(v)); } else if (j > 0) { KC[CL + j] = v; nc += fabsf(bf2f(v)); } }
              if (tid == 0) KC[0] = 0; } }
        { const int chv = 4096 + d, chx = 2048 + d;
          const float v0 = cw[chv], v1 = cw[6144 + chv], v2 = cw[12288 + chv], vb = cbp[chv], x0 = cw[chx], x1 = cw[6144 + chx], x2 = cw[12288 + chx], xb = cbp[chx];
          { const int b = tid >> 7, t0 = (tid & 127) * 32; float zv[32], zx[32];
            zchunk_conv3<4>(P.zv, t0, SL, v0, v1, v2, vb, zv); zchunk_conv3<4>(P.zx, t0, SL, x0, x1, x2, xb, zx);
            LAS unsigned char* dst = lds + CV_V + b * CV_VB + (t0 >> 8) * CV_VJ + (t0 & 255) * 2;
#pragma unroll
            for (int i = 0; i < 4; ++i) { u32x4 o; o.x = pk2(zv[8 * i] * zx[8 * i], zv[8 * i + 1] * zx[8 * i + 1]); o.y = pk2(zv[8 * i + 2] * zx[8 * i + 2], zv[8 * i + 3] * zx[8 * i + 3]);
                o.z = pk2(zv[8 * i + 4] * zx[8 * i + 4], zv[8 * i + 5] * zx[8 * i + 5]); o.w = pk2(zv[8 * i + 6] * zx[8 * i + 6], zv[8 * i + 7] * zx[8 * i + 7]); *(LAS u32x4*)(dst + 16 * i) = o; } }
          { const int b = (tid >> 5) & 3, t0 = (tid & 31) * 8; float zv[8], zx[8];
            zchunk_conv3<1>(P.cv, t0, CL, v0, v1, v2, vb, zv); zchunk_conv3<1>(P.cx, t0, CL, x0, x1, x2, xb, zx);
            u32x4 o; o.x = pk2(zv[0] * zx[0], zv[1] * zx[1]); o.y = pk2(zv[2] * zx[2], zv[3] * zx[3]); o.z = pk2(zv[4] * zx[4], zv[5] * zx[5]); o.w = pk2(zv[6] * zx[6], zv[7] * zx[7]);
            if (tid < 128) *(LAS u32x4*)(lds + CV_VC + b * CV_VCB + t0 * 2) = o; } }
        nl = wave_sum(nl); nc = wave_sum(nc);
        if (lane == 0) { ((LAS float*)(lds + CV_RED))[w] = nl; ((LAS float*)(lds + CV_RED))[8 + w] = nc; }
        __syncthreads();
        const int I_ep = 4 * q + Isub, t0l = 256 * I_ep + 128 * g + 32 * h4, col0l = bb * SL + t0l, t0c = 128 * g + 32 * h4, col0c = TL + bb * CL + t0c;
        ZChunk<4> xl_, xc_;
        zchunk_load<4>(xl_, ZT + (size_t)d * ZLD, col0l, t0l, SL);
        { const int dn = d + F.G; conv_issue(P, F, dn < D ? dn : d); }
        float inv_l = 0.f, inv_c = ((LAS float*)(lds + CV_RED))[8];
#pragma unroll
        for (int i = 0; i < 8; ++i) inv_l += ((LAS float*)(lds + CV_RED))[i];
        inv_l = 1.0f / inv_l; inv_c = 1.0f / inv_c;
        const float skip = F.in[I_SKIP][d];
        const float c0 = cw[d], c1 = cw[6144 + d], c2 = cw[12288 + d], cb0 = cbp[d];
        {
            f32x4 acc[8];
#pragma unroll
            for (int i = 0; i < 8; ++i) acc[i] = (f32x4){0.f, 0.f, 0.f, 0.f};
#define CV_BASES(dl_, ap_, bp_) do { const int J_ = 4 * q + Isub - (dl_); const bool v_ = (J_ >= 0) && (J_ <= 15); \
                bp_ = v_ ? lds + CV_V + bb * CV_VB + J_ * CV_VJ + h4 * 16 : lds + CV_ZERO + h4 * 16; \
                ap_ = lds + CV_KR + (SL - 256 * (dl_) - 128 * g - 8 * r + 8 * h4 - 8) * 2; } while (0)
            const LAS unsigned char *ap, *bp, *apn, *bpn;
            CV_BASES(4 * q - 15, ap, bp);
            u32x4 ca = *(const LAS u32x4*)(ap), cbv = *(const LAS u32x4*)(ap + 16); bf16x8 bfr = *(const LAS bf16x8*)(bp);
#pragma unroll 1
            for (int dl = 4 * q - 15; dl <= 4 * q + 3; ++dl) {
                { const int dn_ = dl < 4 * q + 3 ? dl + 1 : dl; CV_BASES(dn_, apn, bpn); }
#pragma unroll
                for (int kk = 0; kk < 8; ++kk) {
                    const LAS unsigned char* an_ = kk < 7 ? ap + 64 * (kk + 1) : apn; const LAS unsigned char* bn_ = kk < 7 ? bp + 64 * (kk + 1) : bpn;
                    const u32x4 can = *(const LAS u32x4*)(an_), cbn = *(const LAS u32x4*)(an_ + 16); const bf16x8 bfn = *(const LAS bf16x8*)(bn_);
                    __builtin_amdgcn_sched_barrier(0);
                    const unsigned dd[8] = {ca.x, ca.y, ca.z, ca.w, cbv.x, cbv.y, cbv.z, cbv.w};
                    CV_MMA8(acc, dd, bfr);
                    __builtin_amdgcn_sched_barrier(0);
                    ca = can; cbv = cbn; bfr = bfn;
                }
                ap = apn; bp = bpn;
            }
#undef CV_BASES
            float x0c[32]; zchunk_conv3<4>(xl_, t0l, SL, c0, c1, c2, cb0, x0c);
            const LAS unsigned char* vp = lds + CV_V + bb * CV_VB + I_ep * CV_VJ + (128 * g + 32 * h4) * 2;
#pragma unroll
            for (int i = 0; i < 4; ++i) { const u32x4 vv = *(const LAS u32x4*)(vp + 16 * i); const unsigned vw[4] = {vv.x, vv.y, vv.z, vv.w}; unsigned ow[4];
#pragma unroll
                for (int p = 0; p < 4; ++p) { const int e0 = 8 * i + 2 * p, e1 = e0 + 1;
                    const float y0 = (acc[e0 & 7][e0 >> 3] * inv_l + skip * bflo(vw[p])) * x0c[e0], y1 = (acc[e1 & 7][e1 >> 3] * inv_l + skip * bfhi(vw[p])) * x0c[e1];
                    ow[p] = pk2(y0, y1); }
                *(GAS u32x4*)(YXT + (size_t)d * ZLD + col0l + 8 * i) = (u32x4){ow[0], ow[1], ow[2], ow[3]}; }
        }
        zchunk_load<4>(xc_, ZT + (size_t)d * ZLD, col0c, t0c, CL);
        if (w < 2) {
            f32x4 acc[8];
#pragma unroll
            for (int i = 0; i < 8; ++i) acc[i] = (f32x4){0.f, 0.f, 0.f, 0.f};
            const bool valid = Isub == 0;
            const LAS unsigned char* bp = valid ? lds + CV_VC + bb * CV_VCB + h4 * 16 : lds + CV_ZERO + h4 * 16;
            const int xb = CL - 128 * g - 8 * r + 8 * h4;
            const LAS unsigned char* ap = lds + CV_KRC + (xb - 8) * 2;
#pragma unroll
            for (int kk = 0; kk < 8; ++kk) {
                const u32x4 ca = *(const LAS u32x4*)(ap + 64 * kk), cbv = *(const LAS u32x4*)(ap + 64 * kk + 16);
                const bf16x8 bfr = *(const LAS bf16x8*)(bp + 64 * kk);
                const unsigned dd[8] = {ca.x, ca.y, ca.z, ca.w, cbv.x, cbv.y, cbv.z, cbv.w};
                CV_MMA8(acc, dd, bfr);
            }
            float x0c[32]; zchunk_conv3<4>(xc_, t0c, CL, c0, c1, c2, cb0, x0c);
            const LAS unsigned char* vp = lds + CV_VC + bb * CV_VCB + t0c * 2;
            u32x4 outv[4];
#pragma unroll
            for (int i = 0; i < 4; ++i) { const u32x4 vv = *(const LAS u32x4*)(vp + 16 * i); const unsigned vw[4] = {vv.x, vv.y, vv.z, vv.w}; unsigned ow[4];
#pragma unroll
                for (int p = 0; p < 4; ++p) { const int e0 = 8 * i + 2 * p, e1 = e0 + 1;
                    const float y0 = (acc[e0 & 7][e0 >> 3] * inv_c + skip * bflo(vw[p])) * x0c[e0], y1 = (acc[e1 & 7][e1 >> 3] * inv_c + skip * bfhi(vw[p])) * x0c[e1];
                    ow[p] = pk2(y0, y1); }
                outv[i] = (u32x4){ow[0], ow[1], ow[2], ow[3]}; }
            if (valid) {
#pragma unroll
                for (int i = 0; i < 4; ++i) *(GAS u32x4*)(YXT + (size_t)d * ZLD + col0c + 8 * i) = outv[i]; }
        }
    }
}

__device__ __forceinline__ void p_conv_mix(Frame& F, bool do_cvt = true) {
    LAS unsigned char* lds = F.lds;
    const bf16* ZT = (const bf16*)(F.ws + WS_ZT); bf16* YXT = (bf16*)(F.ws + WS_YXT);
    const float* cw = F.in[I_HCW]; const float* cbp = F.in[I_HCB];
    const int tid = F.tid, lane = F.lane, w = F.wave, g = w & 1, r = lane & 15, h4 = lane >> 4, Isub = r >> 2, bb = r & 3;
    for (int i = tid; i < 128; i += NTHR) ((LAS unsigned*)(lds + CV_ZERO))[i] = 0u;
    ConvPre P;
    if (F.c < D) conv_issue(P, F, F.c);
    const int cw_i = F.c * 4 + (w - 4), cw_n = F.G * 4; int cvt_pos = CVT_DENSE;
    const int nch = (D - F.c + F.G - 1) / F.G; const int cvt_per = ((CVT_P10 - CVT_DENSE + cw_n - 1) / cw_n + nch - 1) / nch * cw_n;
#pragma unroll 1
    for (int d = F.c; d < D; d += F.G) {
        LDS_BARRIER();
        float nl = 0.f, nc = 0.f;
        { LAS bf16* KR = (LAS bf16*)(lds + CV_KR);
          const unsigned fwv[4] = {P.kf.x, P.kf.y, P.kf.z, P.kf.w}, bwv[4] = {P.kb.x, P.kb.y, P.kb.z, P.kb.w};
#pragma unroll
          for (int e = 0; e < 8; ++e) { const int j = 8 * tid + e; const unsigned short fv = (unsigned short)(fwv[e >> 1] >> (16 * (e & 1))), bv = (unsigned short)(bwv[e >> 1] >> (16 * (e & 1)));
              KR[SL - j] = fv; nl += fabsf(bf2f(fv));
              if (j > 0) { KR[SL + j] = bv; nl += fabsf(bf2f(bv)); } }
          if (tid == 0) KR[0] = 0;
          if (tid < 64) { LAS bf16* KC = (LAS bf16*)(lds + CV_KRC); const int dirn = tid >> 5, j0 = 8 * (tid & 31);
              const unsigned cv4[4] = {P.kc.x, P.kc.y, P.kc.z, P.kc.w};
#pragma unroll
              for (int e = 0; e < 8; ++e) { const int j = j0 + e; const unsigned short v = (unsigned short)(cv4[e >> 1] >> (16 * (e & 1)));
                  if (dirn == 0) { KC[CL - j] = v; nc += fabsf(bf2f(v)); } else if (j > 0) { KC[CL + j] = v; nc += fabsf(bf2f(v)); } }
              if (tid == 0) KC[0] = 0; } }
        { const int chv = 4096 + d, chx = 2048 + d;
          const float v0 = cw[chv], v1 = cw[6144 + chv], v2 = cw[12288 + chv], vb = cbp[chv], x0 = cw[chx], x1 = cw[6144 + chx], x2 = cw[12288 + chx], xb = cbp[chx];
          { const int b = tid >> 7, t0 = (tid & 127) * 32; float zv[32], zx[32];
            zchunk_conv3<4>(P.zv, t0, SL, v0, v1, v2, vb, zv); zchunk_conv3<4>(P.zx, t0, SL, x0, x1, x2, xb, zx);
            LAS unsigned char* dst = lds + CV_V + b * CV_VB + (t0 >> 8) * CV_VJ + (t0 & 255) * 2;
#pragma unroll
            for (int i = 0; i < 4; ++i) { u32x4 o; o.x = pk2(zv[8 * i] * zx[8 * i], zv[8 * i + 1] * zx[8 * i + 1]); o.y = pk2(zv[8 * i + 2] * zx[8 * i + 2], zv[8 * i + 3] * zx[8 * i + 3]);
                o.z = pk2(zv[8 * i + 4] * zx[8 * i + 4], zv[8 * i + 5] * zx[8 * i + 5]); o.w = pk2(zv[8 * i + 6] * zx[8 * i + 6], zv[8 * i + 7] * zx[8 * i + 7]); *(LAS u32x4*)(dst + 16 * i) = o; } }
          { const int b = (tid >> 5) & 3, t0 = (tid & 31) * 8; float zv[8], zx[8];
            zchunk_conv3<1>(P.cv, t0, CL, v0, v1, v2, vb, zv); zchunk_conv3<1>(P.cx, t0, CL, x0, x1, x2, xb, zx);
            u32x4 o; o.x = pk2(zv[0] * zx[0], zv[1] * zx[1]); o.y = pk2(zv[2] * zx[2], zv[3] * zx[3]); o.z = pk2(zv[4] * zx[4], zv[5] * zx[5]); o.w = pk2(zv[6] * zx[6], zv[7] * zx[7]);
            if (tid < 128) *(LAS u32x4*)(lds + CV_VC + b * CV_VCB + t0 * 2) = o; } }
        nl = wave_sum(nl); nc = wave_sum(nc);
        if (lane == 0) { ((LAS float*)(lds + CV_RED))[w] = nl; ((LAS float*)(lds + CV_RED))[8 + w] = nc; }
        LDS_BARRIER();
        { const int dn = d + F.G; conv_issue(P, F, dn < D ? dn : d); }
        float inv_l = 0.f, inv_c = ((LAS float*)(lds + CV_RED))[8];
#pragma unroll
        for (int i = 0; i < 8; ++i) inv_l += ((LAS float*)(lds + CV_RED))[i];
        inv_l = 1.0f / inv_l; inv_c = 1.0f / inv_c;
        const float skip = F.in[I_SKIP][d];
        const float c0 = cw[d], c1 = cw[6144 + d], c2 = cw[12288 + d], cb0 = cbp[d];
        if (w >= 4) { const int lo = cvt_pos, hi = cvt_pos + cvt_per < CVT_P10 ? cvt_pos + cvt_per : CVT_P10; if (lo < hi && do_cvt) cvt_weights(F, lo, hi, cw_i, cw_n, (LAS float*)(lds + 65536 + (w - 4) * 8448)); }
        else
#pragma unroll 1
        for (int qi = 0; qi < 2; ++qi) {
            const int q = (w >> 1) + 2 * qi;
            const int I_ep = 4 * q + Isub, t0l = 256 * I_ep + 128 * g + 32 * h4, col0l = bb * SL + t0l;
            ZChunk<4> xl_; zchunk_load<4>(xl_, ZT + (size_t)d * ZLD, col0l, t0l, SL);
            f32x4 acc[8];
#pragma unroll
            for (int i = 0; i < 8; ++i) acc[i] = (f32x4){0.f, 0.f, 0.f, 0.f};
#define CV_BASES(dl_, ap_, bp_) do { const int J_ = 4 * q + Isub - (dl_); const bool v_ = (J_ >= 0) && (J_ <= 15); \
                bp_ = v_ ? lds + CV_V + bb * CV_VB + J_ * CV_VJ + h4 * 16 : lds + CV_ZERO + h4 * 16; \
                ap_ = lds + CV_KR + (SL - 256 * (dl_) - 128 * g - 8 * r + 8 * h4 - 8) * 2; } while (0)
            const LAS unsigned char *ap, *bp, *apn, *bpn;
            CV_BASES(4 * q - 15, ap, bp);
            u32x4 ca = *(const LAS u32x4*)(ap), cbv = *(const LAS u32x4*)(ap + 16); bf16x8 bfr = *(const LAS bf16x8*)(bp);
#pragma unroll 1
            for (int dl = 4 * q - 15; dl <= 4 * q + 3; ++dl) {
                { const int dn_ = dl < 4 * q + 3 ? dl + 1 : dl; CV_BASES(dn_, apn, bpn); }
#pragma unroll
                for (int kk = 0; kk < 8; ++kk) {
                    const LAS unsigned char* an_ = kk < 7 ? ap + 64 * (kk + 1) : apn; const LAS unsigned char* bn_ = kk < 7 ? bp + 64 * (kk + 1) : bpn;
                    const u32x4 can = *(const LAS u32x4*)(an_), cbn = *(const LAS u32x4*)(an_ + 16); const bf16x8 bfn = *(const LAS bf16x8*)(bn_);
                    __builtin_amdgcn_sched_barrier(0);
                    const unsigned dd[8] = {ca.x, ca.y, ca.z, ca.w, cbv.x, cbv.y, cbv.z, cbv.w};
                    CV_MMA8(acc, dd, bfr);
                    __builtin_amdgcn_sched_barrier(0);
                    ca = can; cbv = cbn; bfr = bfn;
                }
                ap = apn; bp = bpn;
            }
#undef CV_BASES
            float x0c[32]; zchunk_conv3<4>(xl_, t0l, SL, c0, c1, c2, cb0, x0c);
            const LAS unsigned char* vp = lds + CV_V + bb * CV_VB + I_ep * CV_VJ + (128 * g + 32 * h4) * 2;
#pragma unroll
            for (int i = 0; i < 4; ++i) { const u32x4 vv = *(const LAS u32x4*)(vp + 16 * i); const unsigned vw[4] = {vv.x, vv.y, vv.z, vv.w}; unsigned ow[4];
#pragma unroll
                for (int p = 0; p < 4; ++p) { const int e0 = 8 * i + 2 * p, e1 = e0 + 1;
                    const float y0 = (acc[e0 & 7][e0 >> 3] * inv_l + skip * bflo(vw[p])) * x0c[e0], y1 = (acc[e1 & 7][e1 >> 3] * inv_l + skip * bfhi(vw[p])) * x0c[e1];
                    ow[p] = pk2(y0, y1); }
                *(GAS u32x4*)(YXT + (size_t)d * ZLD + col0l + 8 * i) = (u32x4){ow[0], ow[1], ow[2], ow[3]}; }
        }
        cvt_pos += cvt_per;
        if (w < 2) {
            const int t0c = 128 * g + 32 * h4, col0c = TL + bb * CL + t0c;
            ZChunk<4> xc_; zchunk_load<4>(xc_, ZT + (size_t)d * ZLD, col0c, t0c, CL);
            f32x4 acc[8];
#pragma unroll
            for (int i = 0; i < 8; ++i) acc[i] = (f32x4){0.f, 0.f, 0.f, 0.f};
            const bool valid = Isub == 0;
            const LAS unsigned char* bp = valid ? lds + CV_VC + bb * CV_VCB + h4 * 16 : lds + CV_ZERO + h4 * 16;
            const int xb = CL - 128 * g - 8 * r + 8 * h4;
            const LAS unsigned char* ap = lds + CV_KRC + (xb - 8) * 2;
#pragma unroll
            for (int kk = 0; kk < 8; ++kk) {
                const u32x4 ca = *(const LAS u32x4*)(ap + 64 * kk), cbv = *(const LAS u32x4*)(ap + 64 * kk + 16);
                const bf16x8 bfr = *(const LAS bf16x8*)(bp + 64 * kk);
                const unsigned dd[8] = {ca.x, ca.y, ca.z, ca.w, cbv.x, cbv.y, cbv.z, cbv.w};
                CV_MMA8(acc, dd, bfr);
            }
            float x0c[32]; zchunk_conv3<4>(xc_, t0c, CL, c0, c1, c2, cb0, x0c);
            const LAS unsigned char* vp = lds + CV_VC + bb * CV_VCB + t0c * 2;
            u32x4 outv[4];
#pragma unroll
            for (int i = 0; i < 4; ++i) { const u32x4 vv = *(const LAS u32x4*)(vp + 16 * i); const unsigned vw[4] = {vv.x, vv.y, vv.z, vv.w}; unsigned ow[4];
#pragma unroll
                for (int p = 0; p < 4; ++p) { const int e0 = 8 * i + 2 * p, e1 = e0 + 1;
                    const float y0 = (acc[e0 & 7][e0 >> 3] * inv_c + skip * bflo(vw[p])) * x0c[e0], y1 = (acc[e1 & 7][e1 >> 3] * inv_c + skip * bfhi(vw[p])) * x0c[e1];
                    ow[p] = pk2(y0, y1); }
                outv[i] = (u32x4){ow[0], ow[1], ow[2], ow[3]}; }
            if (valid) {
#pragma unroll
                for (int i = 0; i < 4; ++i) *(GAS u32x4*)(YXT + (size_t)d * ZLD + col0c + 8 * i) = outv[i]; }
        }
    }
}

constexpr int CV_BAR4 = 61312;
__device__ __forceinline__ void bar4(volatile LAS unsigned* cnt, unsigned target, int lane) {
    asm volatile("s_waitcnt lgkmcnt(0)" ::: "memory");
    if (lane == 0) __hip_atomic_fetch_add((LAS unsigned*)cnt, 1u, __ATOMIC_RELAXED, __HIP_MEMORY_SCOPE_WORKGROUP);
    while (*cnt < target) __builtin_amdgcn_s_sleep(1);
    asm volatile("" ::: "memory");
}
struct ConvPre4 { u32x4 kf[2], kb[2], kc; ZChunk<4> zv[2], zx[2]; ZChunk<1> cv, cx; };
__device__ __forceinline__ void conv4_issue(ConvPre4& P, Frame& F, int d) {
    const int tid = F.tid; const bf16* ZT = (const bf16*)(F.ws + WS_ZT);
    const bf16* kn = (const bf16*)(F.ws + WS_KRN) + (size_t)d * 2 * SL; const bf16* kc = (const bf16*)(F.ws + WS_KRC) + (size_t)d * 2 * CL;
#pragma unroll
    for (int h = 0; h < 2; ++h) { P.kf[h] = *(const GAS u32x4*)(kn + 16 * tid + 8 * h); P.kb[h] = *(const GAS u32x4*)(kn + SL + 16 * tid + 8 * h); }
    P.kc = *(const GAS u32x4*)(kc + ((tid >> 5) & 1) * CL + 8 * (tid & 31));
    { const int b = tid >> 6, t0 = (tid & 63) * 64;
#pragma unroll
      for (int h = 0; h < 2; ++h) { zchunk_load<4>(P.zv[h], ZT + (size_t)(4096 + d) * ZLD, b * SL + t0 + 32 * h, t0 + 32 * h, SL); zchunk_load<4>(P.zx[h], ZT + (size_t)(2048 + d) * ZLD, b * SL + t0 + 32 * h, t0 + 32 * h, SL); } }
    { const int b = (tid >> 5) & 3, t0 = (tid & 31) * 8, col0 = TL + b * CL + t0;
      zchunk_load<1>(P.cv, ZT + (size_t)(4096 + d) * ZLD, col0, t0, CL); zchunk_load<1>(P.cx, ZT + (size_t)(2048 + d) * ZLD, col0, t0, CL); }
}
__device__ __forceinline__ void p_conv4(Frame& F) {
    LAS unsigned char* lds = F.lds;
    for (int i = F.tid; i < 128; i += NTHR) ((LAS unsigned*)(lds + CV_ZERO))[i] = 0u;
    if (F.tid == 0) *(volatile LAS unsigned*)(lds + CV_BAR4) = 0u;
    __syncthreads();
    if (F.wave >= 4) {
        cvt_weights(F, CVT_DENSE, CVT_NITEMS, F.c * 4 + (F.wave - 4), F.G * 4, (LAS float*)(lds + 65536 + (F.wave - 4) * 8448)); return; }
    const bf16* ZT = (const bf16*)(F.ws + WS_ZT); bf16* YXT = (bf16*)(F.ws + WS_YXT);
    const float* cw = F.in[I_HCW]; const float* cbp = F.in[I_HCB];
    const int tid = F.tid, lane = F.lane, w = F.wave, g = w & 1, r = lane & 15, h4 = lane >> 4, Isub = r >> 2, bb = r & 3;
    volatile LAS unsigned* b4 = (volatile LAS unsigned*)(lds + CV_BAR4); unsigned nb4 = 0;
    ConvPre4 P;
    if (F.c < D) conv4_issue(P, F, F.c);
#pragma unroll 1
    for (int d = F.c; d < D; d += F.G) {
        nb4 += 4; bar4(b4, nb4, lane);
        float nl = 0.f, nc = 0.f;
        { LAS bf16* KR = (LAS bf16*)(lds + CV_KR);
#pragma unroll
          for (int h = 0; h < 2; ++h) { const unsigned fwv[4] = {P.kf[h].x, P.kf[h].y, P.kf[h].z, P.kf[h].w}, bwv[4] = {P.kb[h].x, P.kb[h].y, P.kb[h].z, P.kb[h].w};
#pragma unroll
              for (int e = 0; e < 8; ++e) { const int j = 16 * tid + 8 * h + e; const unsigned short fv = (unsigned short)(fwv[e >> 1] >> (16 * (e & 1))), bv = (unsigned short)(bwv[e >> 1] >> (16 * (e & 1)));
                  KR[SL - j] = fv; nl += fabsf(bf2f(fv));
                  if (j > 0) { KR[SL + j] = bv; nl += fabsf(bf2f(bv)); } } }
          if (tid == 0) KR[0] = 0;
          if (tid < 64) { LAS bf16* KC = (LAS bf16*)(lds + CV_KRC); const int dirn = tid >> 5, j0 = 8 * (tid & 31);
              const unsigned cv4[4] = {P.kc.x, P.kc.y, P.kc.z, P.kc.w};
#pragma unroll
              for (int e = 0; e < 8; ++e) { const int j = j0 + e; const unsigned short v = (unsigned short)(cv4[e >> 1] >> (16 * (e & 1)));
                  if (dirn == 0) { KC[CL - j] = v; nc += fabsf(bf2f(v)); } else if (j > 0) { KC[CL + j] = v; nc += fabsf(bf2f(v)); } }
              if (tid == 0) KC[0] = 0; } }
        { const int chv = 4096 + d, chx = 2048 + d;
          const float v0 = cw[chv], v1 = cw[6144 + chv], v2 = cw[12288 + chv], vb = cbp[chv], x0 = cw[chx], x1 = cw[6144 + chx], x2 = cw[12288 + chx], xb = cbp[chx];
#pragma unroll
          for (int h = 0; h < 2; ++h) { const int b = tid >> 6, t0 = (tid & 63) * 64 + 32 * h; float zv[32], zx[32];
            zchunk_conv3<4>(P.zv[h], t0, SL, v0, v1, v2, vb, zv); zchunk_conv3<4>(P.zx[h], t0, SL, x0, x1, x2, xb, zx);
            LAS unsigned char* dst = lds + CV_V + b * CV_VB + (t0 >> 8) * CV_VJ + (t0 & 255) * 2;
#pragma unroll
            for (int i = 0; i < 4; ++i) { u32x4 o; o.x = pk2(zv[8 * i] * zx[8 * i], zv[8 * i + 1] * zx[8 * i + 1]); o.y = pk2(zv[8 * i + 2] * zx[8 * i + 2], zv[8 * i + 3] * zx[8 * i + 3]);
                o.z = pk2(zv[8 * i + 4] * zx[8 * i + 4], zv[8 * i + 5] * zx[8 * i + 5]); o.w = pk2(zv[8 * i + 6] * zx[8 * i + 6], zv[8 * i + 7] * zx[8 * i + 7]); *(LAS u32x4*)(dst + 16 * i) = o; } }
          { const int b = (tid >> 5) & 3, t0 = (tid & 31) * 8; float zv[8], zx[8];
            zchunk_conv3<1>(P.cv, t0, CL, v0, v1, v2, vb, zv); zchunk_conv3<1>(P.cx, t0, CL, x0, x1, x2, xb, zx);
            u32x4 o; o.x = pk2(zv[0] * zx[0], zv[1] * zx[1]); o.y = pk2(zv[2] * zx[2], zv[3] * zx[3]); o.z = pk2(zv[4] * zx[4], zv[5] * zx[5]); o.w = pk2(zv[6] * zx[6], zv[7] * zx[7]);
            if (tid < 128) *(LAS u32x4*)(lds + CV_VC + b * CV_VCB + t0 * 2) = o; } }
        nl = wave_sum(nl); nc = wave_sum(nc);
        if (lane == 0) { ((LAS float*)(lds + CV_RED))[w] = nl; ((LAS float*)(lds + CV_RED))[8 + w] = nc; }
        nb4 += 4; bar4(b4, nb4, lane);
        { const int dn = d + F.G; conv4_issue(P, F, dn < D ? dn : d); }
        float inv_l = 0.f, inv_c = ((LAS float*)(lds + CV_RED))[8];
#pragma unroll
        for (int i = 0; i < 4; ++i) inv_l += ((LAS float*)(lds + CV_RED))[i];
        inv_l = 1.0f / inv_l; inv_c = 1.0f / inv_c;
        const float skip = F.in[I_SKIP][d];
        const float c0 = cw[d], c1 = cw[6144 + d], c2 = cw[12288 + d], cb0 = cbp[d];
#pragma unroll 1
        for (int qi = 0; qi < 2; ++qi) {
            const int q = (w >> 1) + 2 * qi;
            const int I_ep = 4 * q + Isub, t0l = 256 * I_ep + 128 * g + 32 * h4, col0l = bb * SL + t0l;
            ZChunk<4> xl_; zchunk_load<4>(xl_, ZT + (size_t)d * ZLD, col0l, t0l, SL);
            f32x4 acc[8];
#pragma unroll
            for (int i = 0; i < 8; ++i) acc[i] = (f32x4){0.f, 0.f, 0.f, 0.f};
#define CV_BASES(dl_, ap_, bp_) do { const int J_ = 4 * q + Isub - (dl_); const bool v_ = (J_ >= 0) && (J_ <= 15); \
                bp_ = v_ ? lds + CV_V + bb * CV_VB + J_ * CV_VJ + h4 * 16 : lds + CV_ZERO + h4 * 16; \
                ap_ = lds + CV_KR + (SL - 256 * (dl_) - 128 * g - 8 * r + 8 * h4 - 8) * 2; } while (0)
            const LAS unsigned char *ap, *bp, *apn, *bpn;
            CV_BASES(4 * q - 15, ap, bp);
            u32x4 ca = *(const LAS u32x4*)(ap), cbv = *(const LAS u32x4*)(ap + 16); bf16x8 bfr = *(const LAS bf16x8*)(bp);
#pragma unroll 1
            for (int dl = 4 * q - 15; dl <= 4 * q + 3; ++dl) {
                { const int dn_ = dl < 4 * q + 3 ? dl + 1 : dl; CV_BASES(dn_, apn, bpn); }
#pragma unroll
                for (int kk = 0; kk < 8; ++kk) {
                    const LAS unsigned char* an_ = kk < 7 ? ap + 64 * (kk + 1) : apn; const LAS unsigned char* bn_ = kk < 7 ? bp + 64 * (kk + 1) : bpn;
                    const u32x4 can = *(const LAS u32x4*)(an_), cbn = *(const LAS u32x4*)(an_ + 16); const bf16x8 bfn = *(const LAS bf16x8*)(bn_);
                    __builtin_amdgcn_sched_barrier(0);
                    const unsigned dd[8] = {ca.x, ca.y, ca.z, ca.w, cbv.x, cbv.y, cbv.z, cbv.w};
                    CV_MMA8(acc, dd, bfr);
                    __builtin_amdgcn_sched_barrier(0);
                    ca = can; cbv = cbn; bfr = bfn;
                }
                ap = apn; bp = bpn;
            }
#undef CV_BASES
            float x0c[32]; zchunk_conv3<4>(xl_, t0l, SL, c0, c1, c2, cb0, x0c);
            const LAS unsigned char* vp = lds + CV_V + bb * CV_VB + I_ep * CV_VJ + (128 * g + 32 * h4) * 2;
#pragma unroll
            for (int i = 0; i < 4; ++i) { const u32x4 vv = *(const LAS u32x4*)(vp + 16 * i); const unsigned vw[4] = {vv.x, vv.y, vv.z, vv.w}; unsigned ow[4];
#pragma unroll
                for (int p = 0; p < 4; ++p) { const int e0 = 8 * i + 2 * p, e1 = e0 + 1;
                    const float y0 = (acc[e0 & 7][e0 >> 3] * inv_l + skip * bflo(vw[p])) * x0c[e0], y1 = (acc[e1 & 7][e1 >> 3] * inv_l + skip * bfhi(vw[p])) * x0c[e1];
                    ow[p] = pk2(y0, y1); }
                *(GAS u32x4*)(YXT + (size_t)d * ZLD + col0l + 8 * i) = (u32x4){ow[0], ow[1], ow[2], ow[3]}; }
        }
        if (w < 2) {
            const int t0c = 128 * g + 32 * h4, col0c = TL + bb * CL + t0c;
            ZChunk<4> xc_; zchunk_load<4>(xc_, ZT + (size_t)d * ZLD, col0c, t0c, CL);
            f32x4 acc[8];
#pragma unroll
            for (int i = 0; i < 8; ++i) acc[i] = (f32x4){0.f, 0.f, 0.f, 0.f};
            const bool valid = Isub == 0;
            const LAS unsigned char* bp = valid ? lds + CV_VC + bb * CV_VCB + h4 * 16 : lds + CV_ZERO + h4 * 16;
            const int xb = CL - 128 * g - 8 * r + 8 * h4;
            const LAS unsigned char* ap = lds + CV_KRC + (xb - 8) * 2;
#pragma unroll
            for (int kk = 0; kk < 8; ++kk) {
                const u32x4 ca = *(const LAS u32x4*)(ap + 64 * kk), cbv = *(const LAS u32x4*)(ap + 64 * kk + 16);
                const bf16x8 bfr = *(const LAS bf16x8*)(bp + 64 * kk);
                const unsigned dd[8] = {ca.x, ca.y, ca.z, ca.w, cbv.x, cbv.y, cbv.z, cbv.w};
                CV_MMA8(acc, dd, bfr);
            }
            float x0c[32]; zchunk_conv3<4>(xc_, t0c, CL, c0, c1, c2, cb0, x0c);
            const LAS unsigned char* vp = lds + CV_VC + bb * CV_VCB + t0c * 2;
            u32x4 outv[4];
#pragma unroll
            for (int i = 0; i < 4; ++i) { const u32x4 vv = *(const LAS u32x4*)(vp + 16 * i); const unsigned vw[4] = {vv.x, vv.y, vv.z, vv.w}; unsigned ow[4];
#pragma unroll
                for (int p = 0; p < 4; ++p) { const int e0 = 8 * i + 2 * p, e1 = e0 + 1;
                    const float y0 = (acc[e0 & 7][e0 >> 3] * inv_c + skip * bflo(vw[p])) * x0c[e0], y1 = (acc[e1 & 7][e1 >> 3] * inv_c + skip * bfhi(vw[p])) * x0c[e1];
                    ow[p] = pk2(y0, y1); }
                outv[i] = (u32x4){ow[0], ow[1], ow[2], ow[3]}; }
            if (valid) {
#pragma unroll
                for (int i = 0; i < 4; ++i) *(GAS u32x4*)(YXT + (size_t)d * ZLD + col0c + 8 * i) = outv[i]; }
        }
    }
}

__device__ __forceinline__ void p_transpose_yx(Frame& F) {
    const bf16* src = (const bf16*)(F.ws + WS_YXT); bf16* dst = (bf16*)(F.ws + WS_YX);
    LAS unsigned short* scr = (LAS unsigned short*)(F.lds + F.wave * 8704);
    const bool cw = F.c < 32; const int lane = F.lane;
    const int gw = (cw ? F.c : F.c - 32) * NWAVES + F.wave, NGW = (cw ? 32 : F.G - 32) * NWAVES;
    const int ntb = cw ? TC / 64 : TL / 64, tb0 = cw ? TL / 64 : 0, NTILES = (D / 64) * ntb;
    for (int it = gw; it < NTILES; it += NGW) {
        const int cb = it / ntb, tb = tb0 + it - cb * ntb, c0 = 64 * cb, tk0 = 64 * tb;
        u32x4 v[8];
#pragma unroll
        for (int i = 0; i < 8; ++i) v[i] = *(const GAS u32x4*)(src + (size_t)(c0 + 8 * i + (lane >> 3)) * ZLD + tk0 + 8 * (lane & 7));
#pragma unroll
        for (int i = 0; i < 8; ++i) { LAS unsigned* s = (LAS unsigned*)(scr + (8 * i + (lane >> 3)) * 68 + 8 * (lane & 7)); s[0] = v[i].x; s[1] = v[i].y; s[2] = v[i].z; s[3] = v[i].w; }
        LDS_WAIT(); asm volatile("" ::: "memory");
#pragma unroll
        for (int j = 0; j < 8; ++j) { const int tk = 8 * j + (lane >> 3), cc = 8 * (lane & 7); unsigned short e[8];
#pragma unroll
            for (int k = 0; k < 8; ++k) e[k] = scr[(cc + k) * 68 + tk];
            u32x4 o; o.x = e[0] | ((unsigned)e[1] << 16); o.y = e[2] | ((unsigned)e[3] << 16); o.z = e[4] | ((unsigned)e[5] << 16); o.w = e[6] | ((unsigned)e[7] << 16);
            *(GAS u32x4*)(dst + (size_t)(tk0 + tk) * D + c0 + cc) = o; }
        LDS_WAIT(); asm volatile("" ::: "memory");
    }
}
__device__ __forceinline__ void p4_ctx_handoff(Frame& F, int word = CW_P4, unsigned n = 32u) {
    asm volatile("s_waitcnt vmcnt(0)" ::: "memory");
    __syncthreads();
    if (threadIdx.x == 0) {
        __builtin_amdgcn_fence(__ATOMIC_RELEASE, "agent");
        asm volatile("s_waitcnt vmcnt(0)" ::: "memory");
        (void)xb_add(F.ctl + word, 1u);
        unsigned sp = 0u; while (xb_ld(F.ctl + word) < n) { __builtin_amdgcn_s_sleep(1); if (++sp > (1u << 22)) break; }
        __builtin_amdgcn_fence(__ATOMIC_ACQUIRE, "agent");
        asm volatile("s_waitcnt vmcnt(0)" ::: "memory");
    }
    __syncthreads();
}
constexpr int S5_HS = 9216;
__device__ __forceinline__ unsigned cvt_pk_nv(float lo, float hi) { return pk2(lo, hi); }
__device__ __forceinline__ float fma_asm(float a, float b, float c) { float d; asm("v_fma_f32 %0, %1, %2, %3" : "=v"(d) : "v"(a), "v"(b), "v"(c)); return d; }
__device__ __forceinline__ size_t s5_row(int ti, int tau, int b, int dir) {
    if (ti < 8) { const int pos = 32 * ti + tau; return (size_t)(TL + b * CL + (dir ? CL - 1 - pos : pos)); }
    const int pos = 32 * (ti - 8) + tau; return (size_t)(b * SL + (dir ? SL - 1 - pos : pos));
}
__device__ __forceinline__ void p_s5(Frame& F, int dry = 0) {
    if (F.wave >= 4 && dry) return;
    if (F.wave >= 4) {
        const float* const* in = F.in; LAS float* scr = (LAS float*)(F.lds + 4 * S5_HS + (F.wave - 4) * 8448); f32x4 va[8];
#pragma unroll 1
        for (int it = CVT_P10 + F.c * 4 + (F.wave - 4); it < CVT_NITEMS; it += F.G * 4) { const TItem ta = p0_decode(in, F.ws, it); p0_item_load(va, ta, F.lane); p0_item_store(va, ta, scr, F.lane); __builtin_amdgcn_s_sleep(127); }
        return; }
    const int lane = F.lane, w = F.wave;
    const bf16* U = (const bf16*)(F.ws + WS_U);
    LAS unsigned char* Hs = F.lds + w * S5_HS;
    for (int sq = F.c * 4 + w; sq < 1024; sq += F.G * 4) {
        const int g = sq & 127, db = sq >> 7, dir = db >> 2, b = db & 3, pg = dir * 128 + g;
        const float step = __expf(F.in[I_SLOG][pg]);
        float lr, li;
        { const float ar = F.in[I_SARE][pg * 64 + lane], ai = F.in[I_SAIM][pg * 64 + lane]; const float er = expf(ar * step); float sn, cs; sincosf(ai * step, &sn, &cs); lr = er * cs; li = er * sn; }
        bf16x8 Bf[2][2];
#pragma unroll
        for (int ph = 0; ph < 2; ++ph) { const int p = 32 * ph + (lane & 31), hh = lane >> 5;
            const float ar = F.in[I_SARE][pg * 64 + p], ai = F.in[I_SAIM][pg * 64 + p]; const float er = expf(ar * step); float sn, cs; sincosf(ai * step, &sn, &cs);
            const float nr = er * cs - 1.0f, ni = er * sn, dn = 1.0f / (ar * ar + ai * ai); const float cr = (nr * ar + ni * ai) * dn, ci = (ni * ar - nr * ai) * dn;
            const float* br = F.in[I_SBRE] + ((size_t)pg * 64 + p) * 16 + 8 * hh; const float* bi = F.in[I_SBIM] + ((size_t)pg * 64 + p) * 16 + 8 * hh;
            unsigned wr_[4], wi_[4];
#pragma unroll
            for (int j = 0; j < 4; ++j) { const float r0 = br[2 * j], r1 = br[2 * j + 1], i0 = bi[2 * j], i1 = bi[2 * j + 1];
                wr_[j] = pk2(cr * r0 - ci * i0, cr * r1 - ci * i1); wi_[j] = pk2(cr * i0 + ci * r0, cr * i1 + ci * r1); }
            Bf[0][ph] = __builtin_bit_cast(bf16x8, (u32x4){wr_[0], wr_[1], wr_[2], wr_[3]}); Bf[1][ph] = __builtin_bit_cast(bf16x8, (u32x4){wi_[0], wi_[1], wi_[2], wi_[3]}); }
        bf16x8 Cf[4];
#pragma unroll
        for (int ks = 0; ks < 4; ++ks) { const int hp = lane & 15, p0 = 16 * ks + 4 * (lane >> 4);
            const float* crp = F.in[I_SCRE] + ((size_t)pg * 16 + hp) * 64 + p0; const float* cip = F.in[I_SCIM] + ((size_t)pg * 16 + hp) * 64 + p0;
            Cf[ks] = __builtin_bit_cast(bf16x8, (u32x4){pk2(crp[0], -cip[0]), pk2(crp[1], -cip[1]), pk2(crp[2], -cip[2]), pk2(crp[3], -cip[3])}); }
        bf16* Yp = (bf16*)(F.ws + (dir ? WS_YB : WS_YF));
        float hr = 0.f, hi = 0.f; const float nli = -li;
#define urow(ti_, tau_) s5_row((ti_), (tau_), b, dir)
        const int tau_a = lane & 31, coff = 16 * g + 8 * (lane >> 5);
        constexpr int NPF = 2;
        bf16x8 uq[NPF];
#pragma unroll
        for (int k = 0; k < NPF; ++k) uq[k] = *(const GAS bf16x8*)(U + urow(k, tau_a) * D + coff);
#pragma unroll 1
        for (int ti = 0; ti < 8; ++ti) {
            const bf16x8 unew = *(const GAS bf16x8*)(U + urow(ti + NPF < 136 ? ti + NPF : 135, tau_a) * D + coff);
            const bf16x8 u0 = uq[0];
            f32x16 z16;
#pragma unroll
            for (int i = 0; i < 16; ++i) z16[i] = 0.f;
            float bur[32], bui[32];
            if (dry & 4) {
#pragma unroll
                for (int r = 0; r < 32; ++r) { bur[r] = __builtin_bit_cast(float, (int)u0[0]) * 1e-30f; bui[r] = bur[r]; } }
            else {
            f32x16 aR0 = __builtin_amdgcn_mfma_f32_32x32x16_bf16(u0, Bf[0][0], z16, 0, 0, 0), aR1 = __builtin_amdgcn_mfma_f32_32x32x16_bf16(u0, Bf[0][1], z16, 0, 0, 0);
            f32x16 aI0 = __builtin_amdgcn_mfma_f32_32x32x16_bf16(u0, Bf[1][0], z16, 0, 0, 0), aI1 = __builtin_amdgcn_mfma_f32_32x32x16_bf16(u0, Bf[1][1], z16, 0, 0, 0);
#pragma unroll
            for (int r = 0; r < 16; ++r) {
                const float fa = aR0[r], fb = aR1[r], fc = aI0[r], fd = aI1[r];
                auto sr = __builtin_amdgcn_permlane32_swap(__float_as_uint(fa), __float_as_uint(fb), false, false);
                auto si = __builtin_amdgcn_permlane32_swap(__float_as_uint(fc), __float_as_uint(fd), false, false);
                const unsigned sr0 = sr[0], sr1 = sr[1], si0 = si[0], si1 = si[1];
                const int tA = (r & 3) + 8 * (r >> 2);
                bur[tA] = __uint_as_float(sr0); bur[tA + 4] = __uint_as_float(sr1); bui[tA] = __uint_as_float(si0); bui[tA + 4] = __uint_as_float(si1); }
            }
#pragma unroll
            for (int tau = 0; tau < 32; ++tau) {
                if (dry & 1) { hr = bur[tau]; hi = bui[tau]; } else {
                const float t1 = __builtin_fmaf(lr, hr, bur[tau]), t2 = __builtin_fmaf(lr, hi, bui[tau]);
                const float nhr = __builtin_fmaf(-li, hi, t1), nhi = __builtin_fmaf(li, hr, t2);
                hr = nhr; hi = nhi; }
                if (false) { if (!(dry & 8)) *(LAS unsigned*)(Hs + tau * 288 + lane * 4) = cvt_pk_nv(hr, hi); }
            }
            if (false) {
                asm volatile("s_waitcnt lgkmcnt(0)" ::: "memory");
#pragma unroll
                for (int mt = 0; mt < ((dry & 2) ? 0 : 2); ++mt) { f32x4 ay = {0.f, 0.f, 0.f, 0.f};
#pragma unroll
                    for (int ks = 0; ks < 4; ++ks) { const bf16x8 hf = *(const LAS bf16x8*)(Hs + (16 * mt + (lane & 15)) * 288 + (32 * ks + 8 * (lane >> 4)) * 2);
                        ay = __builtin_amdgcn_mfma_f32_16x16x32_bf16(Cf[ks], hf, ay, 0, 0, 0); }
                    u32x2 o; o.x = pk2(ay[0], ay[1]); o.y = pk2(ay[2], ay[3]);
                    if (!dry) *(GAS u32x2*)(Yp + urow(ti, 16 * mt + (lane & 15)) * D + 16 * g + 4 * (lane >> 4)) = o; else if (o.x == 0x12345678u) *(GAS u32x2*)(Yp) = o; }
                asm volatile("s_waitcnt lgkmcnt(0)" ::: "memory");
            }
#pragma unroll
            for (int k = 0; k + 1 < NPF; ++k) uq[k] = uq[k + 1];
            uq[NPF - 1] = unew;
        }
        unsigned dx = 0;
#pragma unroll 1
        for (int ti = 8; ti < 136; ++ti) {
            const bf16x8 unew = *(const GAS bf16x8*)(U + urow(ti + NPF < 136 ? ti + NPF : 135, tau_a) * D + coff);
            const bf16x8 u0 = uq[0];
            f32x16 z16;
#pragma unroll
            for (int i = 0; i < 16; ++i) z16[i] = 0.f;
            float bur[32], bui[32];
            if (dry & 4) {
#pragma unroll
                for (int r = 0; r < 32; ++r) { bur[r] = __builtin_bit_cast(float, (int)u0[0]) * 1e-30f; bui[r] = bur[r]; } }
            else {
            f32x16 aR0 = __builtin_amdgcn_mfma_f32_32x32x16_bf16(u0, Bf[0][0], z16, 0, 0, 0), aR1 = __builtin_amdgcn_mfma_f32_32x32x16_bf16(u0, Bf[0][1], z16, 0, 0, 0);
            f32x16 aI0 = __builtin_amdgcn_mfma_f32_32x32x16_bf16(u0, Bf[1][0], z16, 0, 0, 0), aI1 = __builtin_amdgcn_mfma_f32_32x32x16_bf16(u0, Bf[1][1], z16, 0, 0, 0);
#pragma unroll
            for (int r = 0; r < 16; ++r) {
                const float fa = aR0[r], fb = aR1[r], fc = aI0[r], fd = aI1[r];
                auto sr = __builtin_amdgcn_permlane32_swap(__float_as_uint(fa), __float_as_uint(fb), false, false);
                auto si = __builtin_amdgcn_permlane32_swap(__float_as_uint(fc), __float_as_uint(fd), false, false);
                const unsigned sr0 = sr[0], sr1 = sr[1], si0 = si[0], si1 = si[1];
                const int tA = (r & 3) + 8 * (r >> 2);
                bur[tA] = __uint_as_float(sr0); bur[tA + 4] = __uint_as_float(sr1); bui[tA] = __uint_as_float(si0); bui[tA + 4] = __uint_as_float(si1); }
            }
#pragma unroll
            for (int tau = 0; tau < 32; ++tau) {
                if (dry & 1) { hr = bur[tau]; hi = bui[tau]; } else {
                const float t1 = __builtin_fmaf(lr, hr, bur[tau]), t2 = __builtin_fmaf(lr, hi, bui[tau]);
                const float nhr = __builtin_fmaf(-li, hi, t1), nhi = __builtin_fmaf(li, hr, t2);
                hr = nhr; hi = nhi; }
                { if (!(dry & 8)) *(LAS unsigned*)(Hs + tau * 288 + lane * 4) = cvt_pk_nv(hr, hi); else if (dry & 32) dx ^= cvt_pk_nv(hr, hi); }
            }
            {
                asm volatile("s_waitcnt lgkmcnt(0)" ::: "memory");
#pragma unroll
                for (int mt = 0; mt < ((dry & 2) ? 0 : 2); ++mt) { f32x4 ay = {0.f, 0.f, 0.f, 0.f};
#pragma unroll
                    for (int ks = 0; ks < 4; ++ks) { const bf16x8 hf = *(const LAS bf16x8*)(Hs + (16 * mt + (lane & 15)) * 288 + (32 * ks + 8 * (lane >> 4)) * 2);
                        ay = __builtin_amdgcn_mfma_f32_16x16x32_bf16(Cf[ks], hf, ay, 0, 0, 0); }
                    u32x2 o; o.x = pk2(ay[0], ay[1]); o.y = pk2(ay[2], ay[3]);
                    if (!dry) *(GAS u32x2*)(Yp + urow(ti, 16 * mt + (lane & 15)) * D + 16 * g + 4 * (lane >> 4)) = o; else if (o.x == 0x12345678u) *(GAS u32x2*)(Yp) = o; }
                asm volatile("s_waitcnt lgkmcnt(0)" ::: "memory");
            }
#pragma unroll
            for (int k = 0; k + 1 < NPF; ++k) uq[k] = uq[k + 1];
            uq[NPF - 1] = unew;
        }
        if (dry && dx == 0x12345678u) *(LAS unsigned*)(Hs) = dx;
#undef urow
    }
}
__device__ __forceinline__ void p_s5_pipe(Frame& F) {
    if (F.wave >= 4) {
        const float* const* in = F.in; LAS float* scr = (LAS float*)(F.lds + 8 * S5_HS + (F.wave - 4) * 8448); f32x4 va[8];
#pragma unroll 1
        for (int it = CVT_P10 + F.c * 4 + (F.wave - 4); it < CVT_NITEMS; it += F.G * 4) { const TItem ta = p0_decode(in, F.ws, it); p0_item_load(va, ta, F.lane); p0_item_store(va, ta, scr, F.lane); __builtin_amdgcn_s_sleep(127); }
        return; }
    const int lane = F.lane, w = F.wave;
    const bf16* U = (const bf16*)(F.ws + WS_U);
    LAS unsigned char* Hs0 = F.lds + w * 2 * S5_HS;
    for (int sq = F.c * 4 + w; sq < 1024; sq += F.G * 4) {
        const int g = sq & 127, db = sq >> 7, dir = db >> 2, b = db & 3, pg = dir * 128 + g;
        const float step = __expf(F.in[I_SLOG][pg]);
        float lr, li;
        { const float ar = F.in[I_SARE][pg * 64 + lane], ai = F.in[I_SAIM][pg * 64 + lane]; const float er = expf(ar * step); float sn, cs; sincosf(ai * step, &sn, &cs); lr = er * cs; li = er * sn; }
        bf16x8 Bf[2][2];
#pragma unroll
        for (int ph = 0; ph < 2; ++ph) { const int p = 32 * ph + (lane & 31), hh = lane >> 5;
            const float ar = F.in[I_SARE][pg * 64 + p], ai = F.in[I_SAIM][pg * 64 + p]; const float er = expf(ar * step); float sn, cs; sincosf(ai * step, &sn, &cs);
            const float nr = er * cs - 1.0f, ni = er * sn, dn = 1.0f / (ar * ar + ai * ai); const float cr = (nr * ar + ni * ai) * dn, ci = (ni * ar - nr * ai) * dn;
            const float* br = F.in[I_SBRE] + ((size_t)pg * 64 + p) * 16 + 8 * hh; const float* bi = F.in[I_SBIM] + ((size_t)pg * 64 + p) * 16 + 8 * hh;
            unsigned wr_[4], wi_[4];
#pragma unroll
            for (int j = 0; j < 4; ++j) { const float r0 = br[2 * j], r1 = br[2 * j + 1], i0 = bi[2 * j], i1 = bi[2 * j + 1];
                wr_[j] = pk2(cr * r0 - ci * i0, cr * r1 - ci * i1); wi_[j] = pk2(cr * i0 + ci * r0, cr * i1 + ci * r1); }
            Bf[0][ph] = __builtin_bit_cast(bf16x8, (u32x4){wr_[0], wr_[1], wr_[2], wr_[3]}); Bf[1][ph] = __builtin_bit_cast(bf16x8, (u32x4){wi_[0], wi_[1], wi_[2], wi_[3]}); }
        bf16x8 Cf[4];
#pragma unroll
        for (int ks = 0; ks < 4; ++ks) { const int hp = lane & 15, p0 = 16 * ks + 4 * (lane >> 4);
            const float* crp = F.in[I_SCRE] + ((size_t)pg * 16 + hp) * 64 + p0; const float* cip = F.in[I_SCIM] + ((size_t)pg * 16 + hp) * 64 + p0;
            Cf[ks] = __builtin_bit_cast(bf16x8, (u32x4){pk2(crp[0], -cip[0]), pk2(crp[1], -cip[1]), pk2(crp[2], -cip[2]), pk2(crp[3], -cip[3])}); }
        bf16* Yp = (bf16*)(F.ws + (dir ? WS_YB : WS_YF));
        float hr = 0.f, hi = 0.f;
#define urow(ti_, tau_) s5_row((ti_), (tau_), b, dir)
        const int tau_a = lane & 31, coff = 16 * g + 8 * (lane >> 5);
        constexpr int NPF = 3;
        bf16x8 uq[NPF];
#pragma unroll
        for (int k = 0; k < NPF; ++k) uq[k] = *(const GAS bf16x8*)(U + urow(1 + k, tau_a) * D + coff);
        f32x16 z16;
#pragma unroll
        for (int i = 0; i < 16; ++i) z16[i] = 0.f;
        float bur[32], bui[32];
        f32x16 aR0, aR1, aI0, aI1;
#define S5_BPROJ(uf) do { aR0 = __builtin_amdgcn_mfma_f32_32x32x16_bf16(uf, Bf[0][0], z16, 0, 0, 0); aR1 = __builtin_amdgcn_mfma_f32_32x32x16_bf16(uf, Bf[0][1], z16, 0, 0, 0); \
            aI0 = __builtin_amdgcn_mfma_f32_32x32x16_bf16(uf, Bf[1][0], z16, 0, 0, 0); aI1 = __builtin_amdgcn_mfma_f32_32x32x16_bf16(uf, Bf[1][1], z16, 0, 0, 0); } while (0)
#define S5_SWAPS() do { _Pragma("unroll") for (int r = 0; r < 16; ++r) { \
            const float fa = aR0[r], fb = aR1[r], fc = aI0[r], fd = aI1[r];     \
            auto sr = __builtin_amdgcn_permlane32_swap(__float_as_uint(fa), __float_as_uint(fb), false, false); \
            auto si = __builtin_amdgcn_permlane32_swap(__float_as_uint(fc), __float_as_uint(fd), false, false); \
            const unsigned sr0 = sr[0], sr1 = sr[1], si0 = si[0], si1 = si[1]; const int tA = (r & 3) + 8 * (r >> 2); \
            bur[tA] = __uint_as_float(sr0); bur[tA + 4] = __uint_as_float(sr1); bui[tA] = __uint_as_float(si0); bui[tA + 4] = __uint_as_float(si1); } } while (0)
#define S5_SCAN(HS, OUT) do { _Pragma("unroll") for (int tau = 0; tau < 32; ++tau) { \
            const float t1 = __builtin_fmaf(lr, hr, bur[tau]), t2 = __builtin_fmaf(lr, hi, bui[tau]); \
            const float nhr = __builtin_fmaf(-li, hi, t1), nhi = __builtin_fmaf(li, hr, t2); hr = nhr; hi = nhi; \
            if (OUT) *(LAS unsigned*)((HS) + tau * 288 + lane * 4) = cvt_pk_nv(hr, hi); } } while (0)
        { const bf16x8 ufirst = *(const GAS bf16x8*)(U + urow(0, tau_a) * D + coff); S5_BPROJ(ufirst); S5_SWAPS(); }
#pragma unroll 1
        for (int ti = 0; ti < 8; ++ti) {
            const bf16x8 unew = *(const GAS bf16x8*)(U + urow(ti + 1 + NPF < 136 ? ti + 1 + NPF : 135, tau_a) * D + coff);
            const bf16x8 un = uq[0];
            S5_BPROJ(un);
            S5_SCAN(Hs0, false);
            S5_SWAPS();
#pragma unroll
            for (int k = 0; k + 1 < NPF; ++k) uq[k] = uq[k + 1];
            uq[NPF - 1] = unew;
        }
        f32x4 ay0 = {0.f, 0.f, 0.f, 0.f}, ay1 = ay0;
#pragma unroll 1
        for (int ti = 8; ti < 136; ++ti) {
            const bf16x8 unew = *(const GAS bf16x8*)(U + urow(ti + 1 + NPF < 136 ? ti + 1 + NPF : 135, tau_a) * D + coff);
            const bf16x8 un = uq[0];
            LAS unsigned char* hcur = Hs0 + (ti & 1) * S5_HS; const LAS unsigned char* hprev = Hs0 + ((ti - 1) & 1) * S5_HS;
            S5_BPROJ(un);
            S5_SCAN(hcur, true);
            if (ti > 8) {
                asm volatile("s_waitcnt lgkmcnt(0)" ::: "memory");
                ay0 = (f32x4){0.f, 0.f, 0.f, 0.f}; ay1 = ay0;
#pragma unroll
                for (int ks = 0; ks < 4; ++ks) { const bf16x8 h0 = *(const LAS bf16x8*)(hprev + (lane & 15) * 288 + (32 * ks + 8 * (lane >> 4)) * 2), h1 = *(const LAS bf16x8*)(hprev + (16 + (lane & 15)) * 288 + (32 * ks + 8 * (lane >> 4)) * 2);
                    ay0 = __builtin_amdgcn_mfma_f32_16x16x32_bf16(Cf[ks], h0, ay0, 0, 0, 0); ay1 = __builtin_amdgcn_mfma_f32_16x16x32_bf16(Cf[ks], h1, ay1, 0, 0, 0); } }
            S5_SWAPS();
            if (ti > 8) { u32x2 o0, o1; o0.x = pk2(ay0[0], ay0[1]); o0.y = pk2(ay0[2], ay0[3]); o1.x = pk2(ay1[0], ay1[1]); o1.y = pk2(ay1[2], ay1[3]);
                *(GAS u32x2*)(Yp + urow(ti - 1, lane & 15) * D + 16 * g + 4 * (lane >> 4)) = o0; *(GAS u32x2*)(Yp + urow(ti - 1, 16 + (lane & 15)) * D + 16 * g + 4 * (lane >> 4)) = o1; }
#pragma unroll
            for (int k = 0; k + 1 < NPF; ++k) uq[k] = uq[k + 1];
            uq[NPF - 1] = unew;
        }
        {
            const LAS unsigned char* hprev = Hs0 + (135 & 1) * S5_HS;
            asm volatile("s_waitcnt lgkmcnt(0)" ::: "memory");
            ay0 = (f32x4){0.f, 0.f, 0.f, 0.f}; ay1 = ay0;
#pragma unroll
            for (int ks = 0; ks < 4; ++ks) { const bf16x8 h0 = *(const LAS bf16x8*)(hprev + (lane & 15) * 288 + (32 * ks + 8 * (lane >> 4)) * 2), h1 = *(const LAS bf16x8*)(hprev + (16 + (lane & 15)) * 288 + (32 * ks + 8 * (lane >> 4)) * 2);
                ay0 = __builtin_amdgcn_mfma_f32_16x16x32_bf16(Cf[ks], h0, ay0, 0, 0, 0); ay1 = __builtin_amdgcn_mfma_f32_16x16x32_bf16(Cf[ks], h1, ay1, 0, 0, 0); }
            u32x2 o0, o1; o0.x = pk2(ay0[0], ay0[1]); o0.y = pk2(ay0[2], ay0[3]); o1.x = pk2(ay1[0], ay1[1]); o1.y = pk2(ay1[2], ay1[3]);
            *(GAS u32x2*)(Yp + urow(135, lane & 15) * D + 16 * g + 4 * (lane >> 4)) = o0; *(GAS u32x2*)(Yp + urow(135, 16 + (lane & 15)) * D + 16 * g + 4 * (lane >> 4)) = o1;
            asm volatile("s_waitcnt lgkmcnt(0)" ::: "memory");
        }
#undef S5_BPROJ
#undef S5_SWAPS
#undef S5_SCAN
#undef urow
    }
}
__device__ __forceinline__ float gelu_tanh(float x) { const float u = 0.7978845608028654f * (x + 0.044715f * x * x * x); const float e = __expf(2.0f * u); const float th = 1.0f - 2.0f / (e + 1.0f); return 0.5f * x * (1.0f + th); }
__device__ __forceinline__ void p_s5_gelu(Frame& F) {
    const bf16* U = (const bf16*)(F.ws + WS_U); const bf16* YF = (const bf16*)(F.ws + WS_YF); const bf16* YB = (const bf16*)(F.ws + WS_YB); bf16* Gb = (bf16*)(F.ws + WS_G);
    const float* dsk = F.in[I_SD];
    const size_t n8 = (size_t)TL * D / 8, stride = (size_t)F.G * NTHR;
    for (size_t i = (size_t)F.c * NTHR + F.tid; i < n8; i += stride) {
        const u32x4 u = *(const GAS u32x4*)(U + 8 * i), a = *(const GAS u32x4*)(YF + 8 * i), b = *(const GAS u32x4*)(YB + 8 * i);
        const int c = (int)((8 * i) & 2047); const f32x4 d0 = *(const GAS f32x4*)(dsk + c), d1 = *(const GAS f32x4*)(dsk + c + 4);
        const unsigned uw[4] = {u.x, u.y, u.z, u.w}, aw[4] = {a.x, a.y, a.z, a.w}, bw[4] = {b.x, b.y, b.z, b.w}; const float dv[8] = {d0[0], d0[1], d0[2], d0[3], d1[0], d1[1], d1[2], d1[3]}; unsigned ow[4];
#pragma unroll
        for (int p = 0; p < 4; ++p) { const float y0 = dv[2 * p] * bflo(uw[p]) + bflo(aw[p]) + bflo(bw[p]), y1 = dv[2 * p + 1] * bfhi(uw[p]) + bfhi(aw[p]) + bfhi(bw[p]);
            ow[p] = pk2(gelu_tanh(y0), gelu_tanh(y1)); }
        *(GAS u32x4*)(Gb + 8 * i) = (u32x4){ow[0], ow[1], ow[2], ow[3]};
    }
}
#ifndef MK_N_LAUNCHES
#define MK_N_LAUNCHES 1
#endif
constexpr int N_PHASES = 17;

__device__ __forceinline__ void moe_rowtab(Frame& F, int nrb) {
    const LAS int* rb_e = (const LAS int*)(F.lds + TAB_OFF); const LAS int* rbfirst = rb_e + 168; const LAS int* cnt = rbfirst + 33;
    LAS unsigned* rowtab = (LAS unsigned*)(F.lds + ROWTAB_OFF); const int* list = (const int*)(F.ws + WS_LIST);
    const int nu = nrb * 8, h = F.tid >> 8, sl = F.tid & 255; int tok[4]; bool ok[4];
#pragma unroll
    for (int j = 0; j < 4; ++j) { const int i = 2 * j + h; const int L0 = i * F.G + F.c; const int L = L0 < nu ? L0 : nu - 1;
        const int rbi = L >> 3, e = rb_e[rbi], rbl = rbi - rbfirst[e]; const int slot = rbl * 256 + sl; const bool v = slot < cnt[e];
        tok[j] = ((const GAS int*)list)[(size_t)e * TT + (v ? slot : 0)]; ok[j] = v; }
#pragma unroll
    for (int j = 0; j < 4; ++j) { const int i = 2 * j + h; if (i * F.G + F.c < nu) rowtab[i * 256 + sl] = ok[j] ? (unsigned)tok[j] * (unsigned)(D * 2) : 0u; }
    __syncthreads();
}

__global__ void __launch_bounds__(NTHR, 2) mega_fwd(Params P) {
    extern __shared__ __attribute__((aligned(16))) unsigned char lds_raw[];
    Frame F;
    F.lds = (LAS unsigned char*)lds_raw; F.ws = P.ws; F.ctl = (unsigned*)(P.ws + WS_CTL); F.in = P.in; F.out = P.out;
    F.tid = threadIdx.x; F.lane = F.tid & 63; F.wave = __builtin_amdgcn_readfirstlane(F.tid >> 6); F.G = gridDim.x; F.c = blockIdx.x;
    volatile LAS unsigned* MISC = (volatile LAS unsigned*)(F.lds + MISC_OFF);
    if (F.tid < 4) MISC[F.tid] = 0u;
    __syncthreads();
    XcdBarrier bar; bar.bar = F.ctl + CW_BAR; bar.x = 0; bar.st = MISC;
    if (MK_N_LAUNCHES == 1) bar = xcd_barrier_post(F.ctl + CW_BAR, MISC);
    const int lo = P.ph_lo, hi = P.ph_hi;
#define IN(k) (lo <= (k) && (k) < hi)
#define SEAM(k) do { if (IN(k) && IN((k) + 1)) xcd_barrier(bar); } while (0)
#ifndef PROBE_REP
#define PROBE_REP -1
#endif
    const size_t TS2048 = (size_t)256 * 2048 * 2, TS1024 = (size_t)256 * 1024 * 2;

#ifndef PROBE_N
#define PROBE_N 1
#endif
#ifndef PROBE_DRY
#define PROBE_DRY 0
#endif
#ifndef PROBE_SEL
#define PROBE_SEL 0
#endif
#ifndef PROBE_F
#define PROBE_F 4
#endif
#define STAMP(k) do { if (PROBE_SEL != 0 && blockIdx.x == 0) { int t_ = threadIdx.x; asm volatile("" : "+v"(t_)); if (t_ == 0) ((volatile LAS unsigned long long*)(F.lds + MISC_OFF + 128))[k] = __builtin_amdgcn_s_memrealtime(); } } while (0)
#define REFRESH() do { int t_ = threadIdx.x; asm volatile("" : "+v"(t_)); F.tid = t_; F.lane = t_ & 63; } while (0)
#define RUN(k, ...) if (IN(k)) { STAMP(k); REFRESH(); __VA_ARGS__ if (PROBE_REP == (k)) { _Pragma("unroll 1") for (int rep_ = 0; rep_ < PROBE_N; ++rep_) { xcd_barrier(bar); __VA_ARGS__ } } } SEAM(k);
#ifndef USE_TAILS
#define USE_TAILS 0
#endif
#define TAIL(nunits_, chunks_) do { if (!USE_TAILS) break; const int nu_ = (nunits_), mx_ = (nu_ + F.G - 1) / F.G, my_ = nu_ > F.c ? (nu_ - F.c + F.G - 1) / F.G : 0; if (my_ < mx_) cvt_pull(F, CVT_NITEMS, (chunks_), true); } while (0)
    RUN(0, { _Pragma("unroll 1") for (int st = 0; st < 3; ++st) { const int odd = F.c & 1; const int part = odd ? (st == 0 ? 1 : (st == 1 ? 0 : 2)) : (st == 0 ? 0 : (st == 1 ? 2 : 1));
        if (part == 0) p0_adaln(F); else if (part == 1) p0_filter(F); else cvt_weights(F, 0, CVT_DENSE, F.c * NWAVES + F.wave, F.G * NWAVES, (LAS float*)(F.lds + F.wave * 8448));
        __syncthreads(); REFRESH(); } })
    if (IN(1)) { _Pragma("unroll 1") for (int sub = 0; sub < 2; ++sub) {
        if (sub == 0) { STAMP(1); REFRESH(); p_norm1_l0(F); if (F.c < 96) p4_ctx_handoff(F, CW_P1, 96u); REFRESH(); } else { STAMP(2); REFRESH(); }
        pg8::P2Order S; S.D.init(F.ws + WS_WIN, F.ws + WS_U, 6144, TL, 2048, F.G, F.c); S.sub = sub;
        pg8::EpiZT E{(bf16*)(F.ws + WS_ZT), ZLD, F.in[I_HBIN]};
        pg8::gemm_phase<pg8::EpiZT, pg8::P2Order, false>(F.lds, 2048, S, E, nullptr);
        xcd_barrier(bar); } }
#ifndef USE_CONV4
#define USE_CONV4 1
#endif
#if USE_CONV4
#ifdef PROBE_CONVONLY
    RUN(3, p_conv_mix(F); xcd_barrier(bar); REFRESH(); p_conv_mix(F, false);)
#else
    RUN(3, p_conv_mix(F);)
#endif
#else
    RUN(3, p_conv(F);)
#endif
    if (IN(4)) { _Pragma("unroll 1") for (int sub = 0; sub < 2; ++sub) {
        if (sub == 0) { STAMP(4); REFRESH(); p_transpose_yx(F); if (F.c < 32) p4_ctx_handoff(F); REFRESH(); } else { STAMP(5); REFRESH(); }
        pg8::P5Order S; S.D.init(F.ws + WS_YX, F.ws + WS_WOUT, TL, 2048, 2048, F.G, F.c); S.sub = sub;
        pg8::EpiRes E{F.in[I_X], F.out, MODP(F, 0, 0) + 4096, F.in[I_CTX], (float*)(F.ws + WS_XC), MODP(F, 0, 4) + 4096, 12288, F.in[I_HBOUT]};
        pg8::gemm_phase<pg8::EpiRes, pg8::P5Order, false>(F.lds, 2048, S, E, nullptr);
        xcd_barrier(bar); } }
#define MOE_PHASES(l, P_R, P_GU, P_DN, NTOK, LIM_GU, LIM_DN) \
    RUN(P_R, if (!USE_CONV4) { cvt_drain(F, 2 * (l), LIM_GU); REFRESH(); } p_router(F, (l), (NTOK)); if (PROBE_DRY) { xcd_barrier(bar); REFRESH(); p_router(F, (l), (NTOK), PROBE_DRY); }) \
    RUN(P_GU, { if (!USE_CONV4) { cvt_drain(F, 2 * (l) + 1, LIM_DN); REFRESH(); } const int nrb = moe_tables(F, (l)); moe_rowtab(F, nrb); \
        pg8::MoeOrder S{(const char*)(F.ws + WS_U), (const char*)(F.ws + WS_WGU) + (size_t)(l) * 32 * 2048 * 2048 * 2, (const LAS int*)(F.lds + TAB_OFF), nrb, 8, F.G, F.c, 0, TS2048, (size_t)2048 * 2048 * 2, true}; \
        pg8::EpiGU E{(bf16*)(F.ws + WS_H), 1024}; \
        pg8::gemm_phase<pg8::EpiGU, pg8::MoeOrder, true>(F.lds, 2048, S, E, (const LAS unsigned*)(F.lds + ROWTAB_OFF)); TAIL(nrb * 8, 12); }) \
    RUN(P_DN, { const int nrb = moe_tables_cached(F, (l)); \
        pg8::MoeOrder S{(const char*)(F.ws + WS_H), (const char*)(F.ws + WS_WD) + (size_t)(l) * 32 * 2048 * 1024 * 2, (const LAS int*)(F.lds + TAB_OFF), nrb, 8, F.G, F.c, TS1024, TS1024, (size_t)2048 * 1024 * 2, false}; \
        pg8::EpiBf E{(bf16*)(F.ws + WS_EO), 2048}; \
        pg8::gemm_phase<pg8::EpiBf, pg8::MoeOrder, false>(F.lds, 1024, S, E, nullptr); TAIL(nrb * 8, 6); })
    MOE_PHASES(0, 6, 7, 8, TT, CVT_GU0, CVT_D0)
    RUN(9, p_comb_norm1_l1(F);)
#ifndef USE_S5_PIPE
#define USE_S5_PIPE 0
#endif
#if USE_S5_PIPE
    RUN(10, p_s5_pipe(F);)
#else
    RUN(10, p_s5(F); if (PROBE_DRY) { xcd_barrier(bar); REFRESH(); p_s5(F, PROBE_DRY); })
#endif
    RUN(11, p_s5_gelu(F);)
    RUN(12, {
        pg8::DenseOrder S; S.init(F.ws + WS_G, F.ws + WS_W12, TL, 4096, 2048, F.G, F.c);
        pg8::EpiGlu E{F.out, MODP(F, 1, 0) + 4096, 12288, F.in[I_SB1], F.in[I_SB2]};
        pg8::gemm_phase<pg8::EpiGlu, pg8::DenseOrder, false>(F.lds, 2048, S, E, nullptr); TAIL(64 * 16, 12); })
    MOE_PHASES(1, 13, 14, 15, TL, CVT_GU1, CVT_NITEMS)
    if (IN(16)) { STAMP(16); REFRESH(); p_final(F); }
    if (PROBE_SEL != 0) {
        asm volatile("s_waitcnt vmcnt(0)" ::: "memory"); __syncthreads();
        int tq_ = threadIdx.x; asm volatile("" : "+v"(tq_));
        if (blockIdx.x == 0 && tq_ == 0) { volatile LAS unsigned long long* ts = (volatile LAS unsigned long long*)(F.lds + MISC_OFF + 128);
            const unsigned long long tend = __builtin_amdgcn_s_memrealtime(); unsigned long long sum = 0;
            for (int k = 0; k < 17; ++k) if ((PROBE_SEL >> k) & 1) sum += (k < 16 ? ts[k + 1] : tend) - ts[k];
            while (__builtin_amdgcn_s_memrealtime() - tend < (unsigned long long)PROBE_F * sum) __builtin_amdgcn_s_sleep(8); }
    }
#undef IN
#undef SEAM
}

extern "C" void kernel_launch(void* const* d_in, const int* in_sizes, int n_in, void* d_out, int out_size, void* d_ws, size_t ws_size, hipStream_t stream) {
    static int grid = 0;
    if (grid == 0) {
        if (n_in != 40 || out_size != TL * D || ws_size < WS_END) { fprintf(stderr, "kernel_launch: unexpected shapes (n_in %d, out %d, ws %zu)\n", n_in, out_size, ws_size); grid = -1; return; }
        int dev = 0, cus = 0, per_cu = 0;
        if (hipGetDevice(&dev) != hipSuccess || hipDeviceGetAttribute(&cus, hipDeviceAttributeMultiprocessorCount, dev) != hipSuccess) { grid = -1; return; }
        if (hipFuncSetAttribute((const void*)mega_fwd, hipFuncAttributeMaxDynamicSharedMemorySize, LDS_BYTES) != hipSuccess) { fprintf(stderr, "kernel_launch: hipFuncSetAttribute failed\n"); grid = -1; return; }
        if (hipOccupancyMaxActiveBlocksPerMultiprocessor(&per_cu, (const void*)mega_fwd, NTHR, LDS_BYTES) != hipSuccess || per_cu < 1) { fprintf(stderr, "kernel_launch: occupancy query reports %d blocks per CU\n", per_cu); }
        (void)hipGetLastError();
        if (cus < 128) { fprintf(stderr, "kernel_launch: needs at least 128 CUs\n"); grid = -1; return; }
        grid = cus;
    }
    if (grid < 0) return;
    (void)hipMemsetAsync((char*)d_ws + WS_CTL, 0, CTL_BYTES, stream);
    Params p{};
    for (int i = 0; i < 40; ++i) p.in[i] = (const float*)d_in[i];
    p.out = (float*)d_out; p.ws = (unsigned char*)d_ws;
#if MK_N_LAUNCHES == 1
    p.ph_lo = 0; p.ph_hi = N_PHASES;
    hipLaunchKernelGGL(mega_fwd, dim3(grid), dim3(NTHR), LDS_BYTES, stream, p);
#else
    for (int k = 0; k < N_PHASES; ++k) { p.ph_lo = k; p.ph_hi = k + 1; hipLaunchKernelGGL(mega_fwd, dim3(grid), dim3(NTHR), LDS_BYTES, stream, p); }
#endif
}
```

```cpp
#ifndef MK_N_LAUNCHES
#define MK_N_LAUNCHES 1
#endif
#include <hip/hip_runtime.h>
#include <cstdio>
#include <cstdint>

#define LAS __attribute__((address_space(3)))
#define GAS __attribute__((address_space(1)))
typedef unsigned short bf16;
typedef short bf16x8 __attribute__((ext_vector_type(8)));
typedef float f32x4 __attribute__((ext_vector_type(4)));
typedef float f32x2 __attribute__((ext_vector_type(2)));
typedef float f32x16 __attribute__((ext_vector_type(16)));
typedef unsigned u32x4 __attribute__((ext_vector_type(4)));
typedef unsigned u32x2 __attribute__((ext_vector_type(2)));

constexpr int D = 2048, NB = 4, SL = 4096, CL = 256, TL = NB * SL  , TC = NB * CL  , TT = TL + TC  ;
constexpr int NE = 32, DE = 1024, NRB_MAX = 168, ZLD = TT;
constexpr float EPS = 1e-6f;
constexpr int NWAVES = 8, NTHR = 512;

constexpr size_t MiB = 1u << 20;
constexpr size_t WS_CTL = 0, CTL_BYTES = 1 * MiB;
constexpr size_t WS_MOD = 1 * MiB;
constexpr size_t WS_LIST = 2 * MiB;
constexpr size_t WS_TOKPOS = 5 * MiB;
constexpr size_t WS_GATE = 5 * MiB + 512 * 1024;
constexpr size_t WS_WRT = 4 * MiB + 256 * 1024;
constexpr size_t WS_KRN = 6 * MiB;
constexpr size_t WS_KRC = 38 * MiB;
constexpr size_t WS_WIN = 40 * MiB;
constexpr size_t WS_WOUT = 64 * MiB;
constexpr size_t WS_W12 = 72 * MiB;
constexpr size_t WS_WGU = 88 * MiB;
constexpr size_t WS_WD = 600 * MiB;
constexpr size_t WS_XC = 856 * MiB;
constexpr size_t WS_U = 864 * MiB;
constexpr size_t WS_ZT = 932 * MiB;
constexpr size_t WS_YXT = 1138 * MiB;
constexpr size_t WS_YX = 1207 * MiB;
constexpr size_t WS_H = 1275 * MiB;
constexpr size_t WS_EO = 1359 * MiB;
constexpr size_t WS_END = 1527 * MiB;
constexpr size_t WS_YF = WS_ZT, WS_YB = WS_ZT + 64 * MiB, WS_G = WS_ZT + 128 * MiB;

constexpr int CW_TMO = 0;
constexpr int CW_BAR = 4096;
constexpr int CW_P4 = 3072;
constexpr int CW_CVTQ = 2048;
constexpr int CW_CNT = 8192;

constexpr int LDS_BYTES = 147456;
constexpr int ROWTAB_OFF = 131072;
constexpr int TAB_OFF = 139264;
constexpr int MISC_OFF = 141312;

#define LDS_WAIT() asm volatile("s_waitcnt lgkmcnt(0)" ::: "memory")
#define VM_WAIT() asm volatile("s_waitcnt vmcnt(0)" ::: "memory")
#define LDS_BARRIER() do { asm volatile("s_waitcnt lgkmcnt(0)" ::: "memory"); __builtin_amdgcn_s_barrier(); asm volatile("" ::: "memory"); } while (0)
__device__ __forceinline__ unsigned f2bf(float f) { unsigned u = __builtin_bit_cast(unsigned, f); return (u + 0x7fffu + ((u >> 16) & 1u)) >> 16; }
typedef __bf16 bf16x2_t __attribute__((ext_vector_type(2)));
__device__ __forceinline__ unsigned pk2(float lo, float hi) { const f32x2 v = {lo, hi}; const bf16x2_t b = __builtin_convertvector(v, bf16x2_t); return __builtin_bit_cast(unsigned, b); }
__device__ __forceinline__ float bf2f(unsigned short b) { return __builtin_bit_cast(float, ((unsigned)b) << 16); }
__device__ __forceinline__ float bflo(unsigned w) { return __builtin_bit_cast(float, w << 16); }
__device__ __forceinline__ float bfhi(unsigned w) { return __builtin_bit_cast(float, w & 0xffff0000u); }
__device__ __forceinline__ float wave_sum(float v) {
#pragma unroll
    for (int o = 1; o < 64; o <<= 1) v += __shfl_xor(v, o);
    return v;
}
__device__ __forceinline__ float sigmoidf_(float x) { return 1.0f / (1.0f + __expf(-x)); }
__device__ __forceinline__ float siluf_(float x) { return x / (1.0f + __expf(-x)); }

#define XB_TMO      128
#define XB_XCNT(j)  (256  + 64 * (j))
#define XB_XSUB(j)  (1280 + 64 * (j))
#define XB_XGEN(j)  (2304 + 64 * (j))
#define XB_TOP      3328
#define XB_TOPGEN   3392
#define XCD_BAR_WORDS 3456
#define XB_SPIN_CAP (1u << 18)
__device__ __forceinline__ unsigned xb_ld(unsigned* p)              { return __hip_atomic_load(p, __ATOMIC_RELAXED, __HIP_MEMORY_SCOPE_AGENT); }
__device__ __forceinline__ unsigned xb_add(unsigned* p, unsigned v) { return __hip_atomic_fetch_add(p, v, __ATOMIC_RELAXED, __HIP_MEMORY_SCOPE_AGENT); }
__device__ __forceinline__ unsigned xb_xcc_id() { return (unsigned)__builtin_amdgcn_s_getreg((3 << 11) | 20) & 0xFu; }
#define XB_SPIN(cond, bar) do { unsigned _sp = 0; while (cond) { __builtin_amdgcn_s_sleep(1); \
    if ((++_sp & 255u) == 0u) { if (xb_ld(&(bar)[XB_TMO])) break; if (_sp > XB_SPIN_CAP) { atomicAdd(&(bar)[XB_TMO], 1u); break; } } } } while (0)
struct XcdBarrier { unsigned* bar; unsigned x; volatile LAS unsigned* st; };
__device__ __forceinline__ XcdBarrier xcd_barrier_post(unsigned* bar, volatile LAS unsigned* st) {
    XcdBarrier b; b.bar = bar; b.x = xb_xcc_id(); b.st = st;
    if (threadIdx.x == 0) (void)xb_add(&bar[XB_XCNT(b.x)], 1u);
    return b;
}
__device__ __forceinline__ void xcd_barrier_complete(unsigned* bar, unsigned x, unsigned& nloc, unsigned& nx) {
    const unsigned G = gridDim.x * gridDim.y * gridDim.z;
    unsigned sum, cnt, mine, sp = 0u;
    for (;;) {
        sum = 0u; cnt = 0u; mine = 0u;
#pragma unroll
        for (unsigned j = 0; j < 16; ++j) { const unsigned c = xb_ld(&bar[XB_XCNT(j)]); sum += c; cnt += (c > 0u) ? 1u : 0u; mine = (j == x) ? c : mine; }
        if (sum == G) break;
        __builtin_amdgcn_s_sleep(1);
        if ((++sp & 255u) == 0u) { if (xb_ld(&bar[XB_TMO])) break; if (sp > XB_SPIN_CAP) { atomicAdd(&bar[XB_TMO], 1u); break; } }
    }
    nloc = mine > 0u ? mine : 1u; nx = cnt > 0u ? cnt : 1u;
}
__device__ __forceinline__ void xcd_barrier(const XcdBarrier& b) {
    asm volatile("s_waitcnt vmcnt(0)" ::: "memory");
    __syncthreads();
    if (threadIdx.x == 0) {
        unsigned* bar = b.bar;
        __builtin_amdgcn_s_waitcnt(0);
        unsigned nloc = b.st[0], nx = b.st[1];
        if (nloc == 0u) { xcd_barrier_complete(bar, b.x, nloc, nx); b.st[0] = nloc; b.st[1] = nx; }
        const unsigned old = xb_add(&bar[XB_XSUB(b.x)], 1u);
        const unsigned gen = old / nloc;
        if (old + 1u == (gen + 1u) * nloc) {
            __builtin_amdgcn_fence(__ATOMIC_RELEASE, "agent");
            asm volatile("s_waitcnt vmcnt(0)" ::: "memory");
            const unsigned og = xb_add(&bar[XB_TOP], 1u);
            const unsigned tg = og / nx;
            if (og + 1u == (tg + 1u) * nx) xb_add(&bar[XB_TOPGEN], 1u);
            else XB_SPIN(xb_ld(&bar[XB_TOPGEN]) == tg, bar);
            __builtin_amdgcn_fence(__ATOMIC_ACQUIRE, "agent");
            xb_add(&bar[XB_XGEN(b.x)], 1u);
            asm volatile("s_waitcnt vmcnt(0)" ::: "memory");
        } else {
            XB_SPIN(xb_ld(&bar[XB_XGEN(b.x)]) == gen, bar);
            __builtin_amdgcn_fence(__ATOMIC_ACQUIRE, "agent");
            asm volatile("s_waitcnt vmcnt(0)" ::: "memory");
        }
    }
    __syncthreads();
}
namespace pg8 {
constexpr int BM = 256, BK = 64, HALF = 128, HTB = HALF * BK * 2, STAGE_BYTES = 8 * HTB, NXCD = 8, WGM = 8;
__device__ __forceinline__ int lds_byte(int r, int c) { const int st = (r >> 4) * 2 + (c >> 5), rr = r & 15, cc = c & 31, ob = rr * 64 + cc * 2; return st * 1024 + (ob ^ (((ob >> 9) & 1) << 5)); }
__device__ __forceinline__ void stage_rc(int b, int& R, int& C) { const int st = b / 1024, sb = b % 1024, swz = sb ^ (((sb >> 9) & 1) << 5); R = (st >> 1) * 16 + swz / 64; C = (st & 1) * 32 + (swz % 64) / 2; }
__device__ __forceinline__ int perm32(int rho) { const int n = rho >> 4, i = rho & 15; return 8 * (i >> 2) + 4 * n + (i & 3); }

struct Unit { const char* A; const char* B; int pm, pn, ui; };

struct DenseOrder {
    const char* A; const char* B; int nM, nN, nwg, G, c; size_t tstep;
    __device__ __forceinline__ void init(const void* A_, const void* B_, int M, int N, int K, int G_, int c_) { A = (const char*)A_; B = (const char*)B_; nM = M / BM; nN = N / BM; nwg = nM * nN; G = G_; c = c_; tstep = (size_t)BM * K * 2; }
    __device__ __forceinline__ bool next(int i, Unit& u) const {
        const long L = (long)i * G + c; if (L >= nwg) return false;
        int wgid = (int)L; { const int q = nwg / NXCD, r = nwg % NXCD, xcd = wgid % NXCD, off = wgid / NXCD; wgid = (xcd < r ? xcd * (q + 1) : r * (q + 1) + (xcd - r) * q) + off; }
        const int nig = WGM * nN, gid = wgid / nig, fm = gid * WGM, gsz = (nM - fm) < WGM ? (nM - fm) : WGM;
        u.pm = fm + ((wgid % nig) % gsz); u.pn = (wgid % nig) / gsz; u.ui = i;
        u.A = A + (size_t)u.pm * tstep; u.B = B + (size_t)u.pn * tstep; return true;
    }
};
struct P5Order {
    DenseOrder D; int sub;
    __device__ __forceinline__ bool next(int i, Unit& u) const {
        if (sub == 0) { if (i > 0 || D.c >= 32) return false; u.pm = TL / BM + (D.c >> 3); u.pn = D.c & 7; u.ui = 0; u.A = D.A + (size_t)u.pm * D.tstep; u.B = D.B + (size_t)u.pn * D.tstep; return true; }
        return D.next(i, u);
    }
};
struct MoeOrder {
    const char* A; const char* B; const LAS int* rb_e; int nrb, nN, G, c; size_t tstepA, tstepB, estepB; bool gather;
    __device__ __forceinline__ bool next(int i, Unit& u) const {
        const int L = i * G + c; if (L >= nrb * nN) return false;
        const int rbi = L / nN, pn = L - rbi * nN; const int e = rb_e[rbi];
        u.pm = rbi; u.pn = pn; u.ui = i; u.A = gather ? A : A + (size_t)rbi * tstepA; u.B = B + (size_t)e * estepB + (size_t)pn * tstepB; return true;
    }
};

__device__ __forceinline__ unsigned cvt_pk_bf16(float lo, float hi) { return pk2(lo, hi); }

typedef f32x4 Acc[2][2][4][2];

struct EpiZT {
    static constexpr bool PERM = true;
    bf16* O; int ldc; const float* bias;
    __device__ __forceinline__ void operator()(const Acc& acc, const Unit& u, int wr, int wc, int fr, int fq) const {
        const int row0 = u.pm * BM + wr * 64 + fr, col0 = u.pn * BM + wc * 32 + 8 * fq;
        float bvv[2][4];
#pragma unroll
        for (int ai = 0; ai < 2; ++ai)
#pragma unroll
            for (int m = 0; m < 4; ++m) bvv[ai][m] = bias[row0 + ai * HALF + m * 16];
#pragma unroll
        for (int ai = 0; ai < 2; ++ai)
#pragma unroll
            for (int m = 0; m < 4; ++m) { const int r = row0 + ai * HALF + m * 16; const float bv = bvv[ai][m]; bf16* rowp = O + (size_t)r * ldc + col0;
#pragma unroll
                for (int bj = 0; bj < 2; ++bj) { const f32x4 v0 = acc[ai][bj][m][0] + bv, v1 = acc[ai][bj][m][1] + bv;
                    u32x4 w; w.x = cvt_pk_bf16(v0[0], v0[1]); w.y = cvt_pk_bf16(v0[2], v0[3]); w.z = cvt_pk_bf16(v1[0], v1[1]); w.w = cvt_pk_bf16(v1[2], v1[3]);
                    *(u32x4*)(rowp + bj * HALF) = w; } }
    }
};
struct EpiBf {
    static constexpr bool PERM = true;
    bf16* O; int ldc;
    __device__ __forceinline__ void operator()(const Acc& acc, const Unit& u, int wr, int wc, int fr, int fq) const {
        const int row0 = u.pm * BM + wr * 64 + fr, col0 = u.pn * BM + wc * 32 + 8 * fq;
#pragma unroll
        for (int ai = 0; ai < 2; ++ai)
#pragma unroll
            for (int m = 0; m < 4; ++m) { bf16* rowp = O + (size_t)(row0 + ai * HALF + m * 16) * ldc + col0;
#pragma unroll
                for (int bj = 0; bj < 2; ++bj) { const f32x4 v0 = acc[ai][bj][m][0], v1 = acc[ai][bj][m][1];
                    u32x4 w; w.x = cvt_pk_bf16(v0[0], v0[1]); w.y = cvt_pk_bf16(v0[2], v0[3]); w.z = cvt_pk_bf16(v1[0], v1[1]); w.w = cvt_pk_bf16(v1[2], v1[3]);
                    *(u32x4*)(rowp + bj * HALF) = w; } }
    }
};
struct EpiGU {
    static constexpr bool PERM = true;
    bf16* O; int ldc;
    __device__ __forceinline__ void operator()(const Acc& acc, const Unit& u, int wr, int wc, int fr, int fq) const {
        const int row0 = u.pm * BM + wr * 64 + fr, col0 = u.pn * HALF + wc * 32 + 8 * fq;
#pragma unroll
        for (int ai = 0; ai < 2; ++ai)
#pragma unroll
            for (int m = 0; m < 4; ++m) { bf16* rowp = O + (size_t)(row0 + ai * HALF + m * 16) * ldc + col0;
                f32x4 h0, h1;
#pragma unroll
                for (int j = 0; j < 4; ++j) { h0[j] = siluf_(acc[ai][0][m][0][j]) * acc[ai][1][m][0][j]; h1[j] = siluf_(acc[ai][0][m][1][j]) * acc[ai][1][m][1][j]; }
                u32x4 w; w.x = cvt_pk_bf16(h0[0], h0[1]); w.y = cvt_pk_bf16(h0[2], h0[3]); w.z = cvt_pk_bf16(h1[0], h1[1]); w.w = cvt_pk_bf16(h1[2], h1[3]);
                *(u32x4*)rowp = w; }
    }
};
struct EpiRes {
    static constexpr bool PERM = false;
    const float* base_l; float* out_l; const float* gate_l;
    const float* base_c; float* out_c; const float* gate_c; int gstride; const float* bias;
    __device__ __forceinline__ void operator()(const Acc& acc, const Unit& u, int wr, int wc, int fr, int fq) const {
        const bool isc = u.pm >= TL / BM; const int prow = isc ? u.pm - TL / BM : u.pm;
        const float* base = isc ? base_c : base_l; float* out = isc ? out_c : out_l; const float* gate = isc ? gate_c : gate_l + (size_t)(u.pm / (SL / BM)) * gstride;
        const int row0 = prow * BM + wr * 64 + fr, col0 = u.pn * BM + wc * 32 + 4 * fq;
        f32x4 bv[2][2], gv[2][2];
#pragma unroll
        for (int bj = 0; bj < 2; ++bj)
#pragma unroll
            for (int n = 0; n < 2; ++n) { bv[bj][n] = *(const f32x4*)(bias + col0 + bj * HALF + n * 16); gv[bj][n] = *(const f32x4*)(gate + col0 + bj * HALF + n * 16); }
#pragma unroll
        for (int ai = 0; ai < 2; ++ai)
#pragma unroll
            for (int mh = 0; mh < 2; ++mh) { f32x4 bs[2][2][2];
#pragma unroll
                for (int mm = 0; mm < 2; ++mm) { const size_t off = (size_t)(row0 + ai * HALF + (2 * mh + mm) * 16) * D + col0;
#pragma unroll
                    for (int bj = 0; bj < 2; ++bj)
#pragma unroll
                        for (int n = 0; n < 2; ++n) bs[mm][bj][n] = *(const f32x4*)(base + off + bj * HALF + n * 16); }
#pragma unroll
                for (int mm = 0; mm < 2; ++mm) { const int m = 2 * mh + mm; const size_t off = (size_t)(row0 + ai * HALF + m * 16) * D + col0;
#pragma unroll
                    for (int bj = 0; bj < 2; ++bj)
#pragma unroll
                        for (int n = 0; n < 2; ++n) *(f32x4*)(out + off + bj * HALF + n * 16) = bs[mm][bj][n] + gv[bj][n] * (acc[ai][bj][m][n] + bv[bj][n]); }
                asm volatile("" ::: "memory"); }
    }
};
struct EpiGlu {
    static constexpr bool PERM = false;
    float* x; const float* gate; int gstride; const float* b1; const float* b2;
    __device__ __forceinline__ void operator()(const Acc& acc, const Unit& u, int wr, int wc, int fr, int fq) const {
        const float* g = gate + (size_t)(u.pm / (SL / BM)) * gstride;
        const int row0 = u.pm * BM + wr * 64 + fr, col0 = u.pn * HALF + wc * 32 + 4 * fq;
        f32x4 b1v[2], b2v[2], gv[2];
#pragma unroll
        for (int n = 0; n < 2; ++n) { b1v[n] = *(const f32x4*)(b1 + col0 + n * 16); b2v[n] = *(const f32x4*)(b2 + col0 + n * 16); gv[n] = *(const f32x4*)(g + col0 + n * 16); }
#define EG_LOAD(bs_, q_) do { _Pragma("unroll") for (int mm = 0; mm < 2; ++mm) _Pragma("unroll") for (int n = 0; n < 2; ++n) \
            bs_[mm][n] = *(const f32x4*)(x + (size_t)(row0 + ((q_) >> 1) * HALF + (2 * ((q_) & 1) + mm) * 16) * D + col0 + n * 16); asm volatile("" ::: "memory"); } while (0)
#define EG_STORE(bs_, q_) do { _Pragma("unroll") for (int mm = 0; mm < 2; ++mm) { const int m_ = 2 * ((q_) & 1) + mm; float* rowp = x + (size_t)(row0 + ((q_) >> 1) * HALF + m_ * 16) * D + col0; \
            _Pragma("unroll") for (int n = 0; n < 2; ++n) { const f32x4 a = acc[(q_) >> 1][0][m_][n] + b1v[n], b = acc[(q_) >> 1][1][m_][n] + b2v[n]; f32x4 o; \
                _Pragma("unroll") for (int j = 0; j < 4; ++j) o[j] = a[j] * sigmoidf_(b[j]); \
                *(f32x4*)(rowp + n * 16) = bs_[mm][n] + gv[n] * o; } } asm volatile("" ::: "memory"); } while (0)
        f32x4 bsA[2][2], bsB[2][2], bsC[2][2];
        EG_LOAD(bsA, 0); EG_LOAD(bsB, 1); EG_LOAD(bsC, 2); EG_STORE(bsA, 0); EG_LOAD(bsA, 3); EG_STORE(bsB, 1); EG_STORE(bsC, 2); EG_STORE(bsA, 3);
#undef EG_LOAD
#undef EG_STORE
    }
};

template <class Epi, class Sched, bool GATHER>
__device__ __forceinline__ void gemm_phase(LAS unsigned char* lds, const int K, const Sched& S, const Epi& E, const LAS unsigned* rowtab) {
    const int tid = threadIdx.x, wid = __builtin_amdgcn_readfirstlane(tid >> 6), lane = tid & 63, wr = wid >> 2, wc = wid & 3, fr = lane & 15, fq = lane >> 4;
    const int nt = K / BK;
    unsigned voffB[2]; unsigned cv[2][2], nv[2][2]; int Rr[2], Cc[2];
    const size_t kstep = (size_t)(BK * 2);
    const size_t hstep = (size_t)HALF * K * 2;
#pragma unroll
    for (int i = 0; i < 2; ++i) { int R, C; stage_rc(tid * 16 + i * 8192, R, C); const int Rb = Epi::PERM ? ((R & ~31) + perm32(R & 31)) : R;
        Rr[i] = R; Cc[i] = C; voffB[i] = (unsigned)(Rb * K + C) * 2u;
        if constexpr (!GATHER) { cv[0][i] = (unsigned)(R * K + C) * 2u; cv[1][i] = cv[0][i] + (unsigned)hstep; } }
    const unsigned ldsw = (unsigned)wid * 1024u;
    const int aoff = lds_byte(wr * 64 + fr, fq * 8), boff = lds_byte(wc * 32 + fr, fq * 8);
#define PG8_SA(b, h) (((b) * 2 + (h)) * HTB)
#define PG8_SB(b, h) ((4 + (b) * 2 + (h)) * HTB)
#define PG8_STAGE(bufoff, gbase, voff) do { _Pragma("unroll") for (int _i = 0; _i < 2; ++_i) \
        __builtin_amdgcn_global_load_lds((const unsigned*)((const char*)(gbase) + (voff)[_i]), (LAS unsigned*)(lds + (bufoff) + ldsw + _i * 8192), 16, 0, 0); } while (0)
#define PG8_LDROWS(dst, uix) do { _Pragma("unroll") for (int _h = 0; _h < 2; ++_h) _Pragma("unroll") for (int _i = 0; _i < 2; ++_i) \
        dst[_h][_i] = rowtab[(uix) * 256 + _h * 128 + Rr[_i]] + (unsigned)(Cc[_i] * 2); } while (0)
#define PG8_LDA(dst, b, h) do { _Pragma("unroll") for (int m = 0; m < 4; ++m) _Pragma("unroll") for (int k = 0; k < 2; ++k) dst[m][k] = *(const LAS bf16x8*)(lds + PG8_SA(b, h) + aoff + m * 2048 + k * 1024); } while (0)
#define PG8_LDB(dst, b, h) do { _Pragma("unroll") for (int n = 0; n < 2; ++n) _Pragma("unroll") for (int k = 0; k < 2; ++k) dst[n][k] = *(const LAS bf16x8*)(lds + PG8_SB(b, h) + boff + n * 2048 + k * 1024); } while (0)
#define PG8_MMA(ai, bj, At, Bt) do { __builtin_amdgcn_s_setprio(1); _Pragma("unroll") for (int m = 0; m < 4; ++m) _Pragma("unroll") for (int n = 0; n < 2; ++n) _Pragma("unroll") for (int k = 0; k < 2; ++k) \
        acc[ai][bj][m][n] = __builtin_amdgcn_mfma_f32_16x16x32_bf16(Bt[n][k], At[m][k], acc[ai][bj][m][n], 0, 0, 0); __builtin_amdgcn_s_setprio(0); } while (0)
#define PG8_WAIT_V(n) asm volatile("s_waitcnt vmcnt(" #n ")" ::: "memory")
#define PG8_WAIT_L(n) asm volatile("s_waitcnt lgkmcnt(" #n ")" ::: "memory")
#define PG8_BAR __builtin_amdgcn_s_barrier()
#define PG8_SCHED __builtin_amdgcn_sched_barrier(0)
    Unit cur, nxt; int ui = 0;
    if (!S.next(0, cur)) return;
    Acc acc;
#pragma unroll
    for (int a = 0; a < 2; ++a)
#pragma unroll
        for (int b = 0; b < 2; ++b)
#pragma unroll
            for (int m = 0; m < 4; ++m)
#pragma unroll
                for (int n = 0; n < 2; ++n) acc[a][b][m][n] = (f32x4){0.f, 0.f, 0.f, 0.f};
    bf16x8 At[4][2], B0[2][2], B1[2][2];
    const char* cA = cur.A; const char* cB = cur.B;
    if constexpr (GATHER) { PG8_LDROWS(cv, cur.ui); PG8_WAIT_L(0); }
    PG8_STAGE(PG8_SB(0, 0), cB, voffB); PG8_STAGE(PG8_SB(0, 1), cB + hstep, voffB); PG8_STAGE(PG8_SA(0, 0), cA, cv[0]); PG8_STAGE(PG8_SA(0, 1), cA, cv[1]);
    if (wr == 1) PG8_BAR;
    PG8_WAIT_V(2); PG8_BAR;
    PG8_STAGE(PG8_SB(1, 0), cB + kstep, voffB); PG8_STAGE(PG8_SA(1, 0), cA + kstep, cv[0]); PG8_STAGE(PG8_SB(1, 1), cB + hstep + kstep, voffB);
    PG8_WAIT_V(6); PG8_BAR;
    for (;;) {
        const bool has_next = S.next(ui + 1, nxt);
        const char* nA = has_next ? nxt.A : cA; const char* nB = has_next ? nxt.B : cB;
        for (int t = 0; t < nt; t += 2) {
            const bool last = (t == nt - 2);
            const char* a1 = cA + (size_t)(t + 1) * kstep;
            const char* a2 = last ? nA : cA + (size_t)(t + 2) * kstep; const char* b2 = last ? nB : cB + (size_t)(t + 2) * kstep;
            const char* a3 = a2 + kstep; const char* b3 = b2 + kstep;
            if constexpr (GATHER) { if (last) { PG8_LDROWS(nv, has_next ? nxt.ui : cur.ui); } else {
#pragma unroll
                for (int h = 0; h < 2; ++h)
#pragma unroll
                    for (int i = 0; i < 2; ++i) nv[h][i] = cv[h][i]; } }
            else {
#pragma unroll
                for (int h = 0; h < 2; ++h)
#pragma unroll
                    for (int i = 0; i < 2; ++i) nv[h][i] = cv[h][i]; }
            PG8_LDB(B0, 0, 0); PG8_LDB(B1, 0, 1); PG8_SCHED; PG8_LDA(At, 0, 0); PG8_STAGE(PG8_SA(1, 1), a1, cv[1]);
            PG8_WAIT_V(8); PG8_WAIT_L(0); PG8_BAR; PG8_MMA(0, 0, At, B0); PG8_MMA(0, 1, At, B1); PG8_BAR; PG8_SCHED;
            PG8_LDA(At, 0, 1); PG8_STAGE(PG8_SB(0, 0), b2, voffB); PG8_STAGE(PG8_SB(0, 1), b2 + hstep, voffB); PG8_STAGE(PG8_SA(0, 0), a2, nv[0]);
            PG8_WAIT_V(8); PG8_WAIT_L(0); PG8_BAR; PG8_MMA(1, 0, At, B0); PG8_MMA(1, 1, At, B1); PG8_BAR; PG8_SCHED;
            PG8_LDB(B0, 1, 0); PG8_LDB(B1, 1, 1); PG8_SCHED; PG8_LDA(At, 1, 0); PG8_STAGE(PG8_SA(0, 1), a2, nv[1]);
            PG8_WAIT_V(8); PG8_WAIT_L(0); PG8_BAR; PG8_MMA(0, 0, At, B0); PG8_MMA(0, 1, At, B1); PG8_BAR; PG8_SCHED;
            PG8_LDA(At, 1, 1); PG8_STAGE(PG8_SB(1, 0), b3, voffB); PG8_STAGE(PG8_SB(1, 1), b3 + hstep, voffB); PG8_STAGE(PG8_SA(1, 0), a3, nv[0]);
            PG8_WAIT_V(8); PG8_WAIT_L(0); PG8_BAR; PG8_MMA(1, 0, At, B0); PG8_MMA(1, 1, At, B1); PG8_BAR; PG8_SCHED;
        }
        if (wr == 0) PG8_BAR;
        E(acc, cur, wr, wc, fr, fq);
        if (!has_next) break;
#pragma unroll
        for (int a = 0; a < 2; ++a)
#pragma unroll
            for (int b = 0; b < 2; ++b)
#pragma unroll
                for (int m = 0; m < 4; ++m)
#pragma unroll
                    for (int n = 0; n < 2; ++n) acc[a][b][m][n] = (f32x4){0.f, 0.f, 0.f, 0.f};
        cur = nxt; cA = nA; cB = nB; ++ui;
        if constexpr (GATHER) {
#pragma unroll
            for (int h = 0; h < 2; ++h)
#pragma unroll
                for (int i = 0; i < 2; ++i) cv[h][i] = nv[h][i]; }
        if (wr == 1) PG8_BAR;
    }
    PG8_WAIT_V(0);
    PG8_BAR;
#undef PG8_SA
#undef PG8_SB
#undef PG8_STAGE
#undef PG8_LDROWS
#undef PG8_LDA
#undef PG8_LDB
#undef PG8_MMA
#undef PG8_WAIT_V
#undef PG8_WAIT_L
#undef PG8_BAR
#undef PG8_SCHED
}
}
struct Params { const float* in[40]; float* out; unsigned char* ws; int ph_lo, ph_hi; };
enum { I_X = 0, I_C, I_CTX, I_CCTX, I_ADAW, I_ADAB, I_NORMG, I_FINALG, I_HWIN, I_HBIN, I_HCW, I_HCB, I_FW1, I_FB1, I_FW2, I_FB2, I_FW3, I_FREQ, I_SKIP, I_HWOUT, I_HBOUT,
       I_SARE, I_SAIM, I_SLOG, I_SBRE, I_SBIM, I_SCRE, I_SCIM, I_SD, I_SW1, I_SB1, I_SW2, I_SB2, I_MWG, I_MBG, I_MWE, I_MBE, I_MGATE, I_MUP, I_MDOWN };

struct Frame {
    LAS unsigned char* lds; unsigned* ctl; unsigned char* ws; const float* const* in; float* out;
    int tid, lane, wave, G, c;
};
#define MODP(F, l, r) ((const float*)((F).ws + WS_MOD) + ((size_t)(l) * 5 + (r)) * 12288)

struct TItem { const float* src; bf16* dst; int N, K; };
__device__ __forceinline__ void p0_item_load(f32x4 (&v)[8], const TItem& t, int lane) {
#pragma unroll
    for (int i = 0; i < 8; ++i) v[i] = *(const GAS f32x4*)(t.src + (size_t)(8 * i + (lane >> 3)) * t.N + 4 * (lane & 7));
}
__device__ __forceinline__ void p0_item_store(const f32x4 (&v)[8], const TItem& t, LAS float* scr, int lane) {
#pragma unroll
    for (int i = 0; i < 8; ++i) { LAS float* s = scr + (8 * i + (lane >> 3)) * 33 + 4 * (lane & 7); s[0] = v[i][0]; s[1] = v[i][1]; s[2] = v[i][2]; s[3] = v[i][3]; }
    LDS_WAIT(); asm volatile("" ::: "memory");
    const int c = lane & 7;
#pragma unroll
    for (int j = 0; j < 4; ++j) { const int n = (lane >> 3) + 8 * j; const LAS float* s = scr + (8 * c) * 33 + n;
        u32x4 o; o.x = pk2(s[0 * 33], s[1 * 33]); o.y = pk2(s[2 * 33], s[3 * 33]); o.z = pk2(s[4 * 33], s[5 * 33]); o.w = pk2(s[6 * 33], s[7 * 33]);
        *(GAS u32x4*)(t.dst + (size_t)n * t.K + 8 * c) = o; }
    LDS_WAIT(); asm volatile("" ::: "memory");
}
__device__ __forceinline__ TItem p0_job(const float* W, int K, int N, bf16* WT, bool ilv, int ilv_off, int idx) {
    const int nblk = N / 32, kb = idx / nblk, nb = idx - kb * nblk, n0 = 32 * nb, k0 = 64 * kb;
    const int drow0 = ilv ? ((n0 >> 7) * 256 + ilv_off + (n0 & 127)) : n0;
    TItem t; t.src = W + (size_t)k0 * N + n0; t.dst = WT + (size_t)drow0 * K + k0; t.N = N; t.K = K; return t;
}
__device__ __forceinline__ TItem p0_decode(const float* const* in, unsigned char* ws, int it) {
    constexpr int N_IN = 32 * 192, N_SQ = 32 * 64, N_E = 1024, N_L = 96 * N_E;
    int r = it;
    if (r < N_IN) return p0_job(in[I_HWIN], 2048, 6144, (bf16*)(ws + WS_WIN), false, 0, r); r -= N_IN;
    if (r < N_SQ) return p0_job(in[I_HWOUT], 2048, 2048, (bf16*)(ws + WS_WOUT), false, 0, r); r -= N_SQ;
    if (r < N_SQ) return p0_job(in[I_SW1], 2048, 2048, (bf16*)(ws + WS_W12), true, 0, r); r -= N_SQ;
    if (r < N_SQ) return p0_job(in[I_SW2], 2048, 2048, (bf16*)(ws + WS_W12), true, 128, r); r -= N_SQ;
    const int l = r / N_L; int q = r - l * N_L;
    if (q < 64 * N_E) { const int e = q / (2 * N_E), w2 = q - e * 2 * N_E, which = w2 / N_E, idx = w2 - which * N_E, le = l * 32 + e;
        return p0_job((which ? in[I_MUP] : in[I_MGATE]) + (size_t)le * 2048 * 1024, 2048, 1024, (bf16*)(ws + WS_WGU) + (size_t)le * 2048 * 2048, true, which ? 128 : 0, idx); }
    q -= 64 * N_E; const int e = q / N_E, idx = q - e * N_E, le = l * 32 + e;
    return p0_job(in[I_MDOWN] + (size_t)le * 1024 * 2048, 1024, 2048, (bf16*)(ws + WS_WD) + (size_t)le * 2048 * 1024, false, 0, idx);
}

__device__ __forceinline__ void p0_adaln(Frame& F) {
    const float* const* in = F.in;
    for (int i = F.c * NTHR + F.tid; i < 2 * 48 * 2048; i += F.G * NTHR) { const int l = i / (48 * 2048), rr = i - l * 48 * 2048, n = rr >> 11, k = rr & 2047;
        ((float*)(F.ws + WS_WRT))[i] = n < 4 ? in[I_MWG][((size_t)l * 2048 + k) * 4 + n] : (n < 36 ? in[I_MWE][((size_t)l * 2048 + k) * 32 + (n - 4)] : 0.f); }
    {
        LAS float* sl = (LAS float*)F.lds;
        for (int i = F.tid; i < 2048 * 5; i += NTHR) { const int r = i / 2048, k = i - r * 2048; const float cv = r < 4 ? in[I_C][r * 2048 + k] : in[I_CCTX][k]; sl[k * 8 + r] = siluf_(cv); }
        __syncthreads();
        LAS float* red = (LAS float*)(F.lds + 65536);
        for (int it = F.c; it < 256; it += F.G) {
            const int l = it >> 7, cbase = 96 * (it & 127); const float* Wl = in[I_ADAW] + (size_t)l * 2048 * 12288;
            const unsigned woff = (unsigned)(cbase + (F.lane & 31));
            float a[3][5];
#pragma unroll
            for (int gq = 0; gq < 3; ++gq)
#pragma unroll
                for (int r = 0; r < 5; ++r) a[gq][r] = 0.f;
            const int kbase = 256 * F.wave + (F.lane >> 5);
#pragma unroll 1
            for (int k0 = 0; k0 < 128; k0 += 8) {
                float wv[8][3];
#pragma unroll
                for (int kk = 0; kk < 8; ++kk)
#pragma unroll
                    for (int gq = 0; gq < 3; ++gq) wv[kk][gq] = Wl[(unsigned)(kbase + 2 * (k0 + kk)) * 12288u + woff + 32u * gq];
#pragma unroll
                for (int kk = 0; kk < 8; ++kk) { const int k = kbase + 2 * (k0 + kk); const f32x4 sv = *(const LAS f32x4*)(sl + k * 8); const float s4 = sl[k * 8 + 4];
#pragma unroll
                    for (int gq = 0; gq < 3; ++gq) { a[gq][0] += sv[0] * wv[kk][gq]; a[gq][1] += sv[1] * wv[kk][gq]; a[gq][2] += sv[2] * wv[kk][gq]; a[gq][3] += sv[3] * wv[kk][gq]; a[gq][4] += s4 * wv[kk][gq]; } }
            }
#pragma unroll
            for (int gq = 0; gq < 3; ++gq)
#pragma unroll
                for (int r = 0; r < 5; ++r) { float v = a[gq][r]; v += __shfl_xor(v, 32); if (F.lane < 32) red[((F.wave * 3 + gq) * 5 + r) * 32 + F.lane] = v; }
            __syncthreads();
            if (F.tid < 480) { float sum = 0.f;
#pragma unroll
                for (int w = 0; w < 8; ++w) sum += red[w * 480 + F.tid];
                const int gq = F.tid / 160, r = (F.tid % 160) >> 5, col = cbase + 32 * gq + (F.tid & 31);
                ((float*)(F.ws + WS_MOD))[((size_t)l * 5 + r) * 12288 + col] = sum + in[I_ADAB][l * 12288 + col]; }
            __syncthreads();
        }
    }
}
__device__ __forceinline__ void p0_filter(Frame& F, int dry = 0) {
    const float* const* in = F.in;
    {
        LAS float* zf = (LAS float*)F.lds;
        LAS float* h1 = (LAS float*)(F.lds + 20480);
        LAS float* h2T = (LAS float*)(F.lds + 57344);
        LAS float* w1s = (LAS float*)(F.lds + 94208);
        LAS float* w2s = (LAS float*)(F.lds + 102656);
        LAS float* vs = (LAS float*)(F.lds + 119040);
        for (int i = F.tid; i < 33 * 64; i += NTHR) w1s[i] = in[I_FW1][i];
        for (int i = F.tid; i < 64 * 64; i += NTHR) w2s[i] = in[I_FW2][i];
        if (F.tid < 64) { vs[F.tid] = in[I_FB1][F.tid]; vs[64 + F.tid] = in[I_FB2][F.tid]; vs[128 + F.tid] = in[I_FREQ][F.tid]; }
        for (int it = F.c; it < 256; it += F.G) {
            const int pb = it >> 3, cb = it & 7, pbase = pb * 136;
            if (!(dry & 1)) {
            for (int i = F.tid; i < 136 * 33; i += NTHR) { const int p = i / 33, m = i - p * 33; const int gp = pbase + p; const int Lq = gp < SL ? SL : CL, j = gp < SL ? gp : gp - SL;
                float v;
                if (m == 0) v = (float)j / (float)(Lq - 1);
                else { const int mm = (m - 1) & 15; const float band = 1e-4f + (float)mm * ((15.0f - 1e-4f) / 15.0f); const float w = (6.283185307179586f / (float)Lq) * (float)j; const float a = band * w;
                    v = (m <= 16) ? __cosf(a) : -__sinf(a); }
                zf[i] = v; }
            __syncthreads();
            {
                const int o = F.tid & 63, pq = F.tid >> 6; float sacc[17];
#pragma unroll
                for (int i = 0; i < 17; ++i) sacc[i] = vs[o];
#pragma unroll 3
                for (int m = 0; m < 33; ++m) { const float w = w1s[m * 64 + o];
#pragma unroll
                    for (int i = 0; i < 17; ++i) sacc[i] += zf[(pq + 8 * i) * 33 + m] * w; }
                const float fr = vs[128 + o];
#pragma unroll
                for (int i = 0; i < 17; ++i) h1[(pq + 8 * i) * 64 + o] = __sinf(fr * sacc[i]); }
            __syncthreads();
            {
                const int o = F.tid & 63, pq = F.tid >> 6; float sacc[17];
#pragma unroll
                for (int i = 0; i < 17; ++i) sacc[i] = vs[64 + o];
#pragma unroll 2
                for (int m4 = 0; m4 < 16; ++m4) { const float w0 = w2s[(4 * m4) * 64 + o], w1 = w2s[(4 * m4 + 1) * 64 + o], w2 = w2s[(4 * m4 + 2) * 64 + o], w3 = w2s[(4 * m4 + 3) * 64 + o];
#pragma unroll
                    for (int i = 0; i < 17; ++i) { const f32x4 hv = *(const LAS f32x4*)(h1 + (pq + 8 * i) * 64 + 4 * m4); sacc[i] += (hv[0] * w0 + hv[1] * w1) + (hv[2] * w2 + hv[3] * w3); } }
                const float fr = vs[128 + o];
#pragma unroll
                for (int i = 0; i < 17; ++i) h2T[o * 136 + pq + 8 * i] = __sinf(fr * sacc[i]); }
            }
            __syncthreads();
            const int cg = F.tid & 127, pg = F.tid >> 7, c0 = 512 * cb + 4 * cg, p0 = 34 * pg;
            f32x4 acc[34];
#pragma unroll
            for (int i = 0; i < 34; ++i) acc[i] = (f32x4){0.f, 0.f, 0.f, 0.f};
            const float* w3 = in[I_FW3] + c0;
            f32x4 wq[2];
#pragma unroll
            for (int k = 0; k < 2; ++k) wq[k] = *(const GAS f32x4*)(w3 + (size_t)k * 4096);
#pragma unroll 1
            for (int o0 = 0; o0 < ((dry & 2) ? 2 : 64); o0 += 2) {
                f32x4 wn[2];
#pragma unroll
                for (int k = 0; k < 2; ++k) { const int on = o0 + 2 + k; wn[k] = *(const GAS f32x4*)(w3 + (size_t)(on < 64 ? on : 63) * 4096); }
#pragma unroll
                for (int k = 0; k < 2; ++k) {
#pragma unroll
                    for (int i = 0; i < 17; ++i) { const f32x2 hv = *(const LAS f32x2*)(h2T + (o0 + k) * 136 + p0 + 2 * i); acc[2 * i] += wq[k] * hv[0]; acc[2 * i + 1] += wq[k] * hv[1]; } }
#pragma unroll
                for (int k = 0; k < 2; ++k) wq[k] = wn[k];
            }
            const int d0 = c0 & 2047;
            const float dstep = ((-15.350567286626973f) - (-3.0701134573253945f)) / 2047.0f;
            float delta[4];
#pragma unroll
            for (int q = 0; q < 4; ++q) delta[q] = fabsf(-3.0701134573253945f + (float)(d0 + q) * dstep);
            LAS unsigned char* T = F.lds;
#pragma unroll 1
            for (int hf = 0; hf < ((dry & 4) ? 0 : 2); ++hf) {
                __syncthreads();
                if ((cg >> 6) == hf) {
#pragma unroll
                    for (int i = 0; i < 17; ++i) { const int gp = pbase + p0 + 2 * i; const bool lat = gp < SL; const int Lq = lat ? SL : CL, j = lat ? gp : gp - SL;
                        const float t0 = (float)j / (float)(Lq - 1), t1 = (float)(j + 1) / (float)(Lq - 1);
#pragma unroll
                        for (int q = 0; q < 4; ++q)
                            *(LAS unsigned*)(T + (4 * (cg & 63) + q) * 276 + (p0 + 2 * i) * 2) = pk2(acc[2 * i][q] * __expf(-t0 * delta[q]), acc[2 * i + 1][q] * __expf(-t1 * delta[q])); } }
                __syncthreads();
                for (int idx = F.tid; idx < 256 * 17; idx += NTHR) { const int col = idx / 17, k = idx - col * 17; const LAS unsigned* sp = (const LAS unsigned*)(T + col * 276 + 16 * k);
                    const u32x4 o = {sp[0], sp[1], sp[2], sp[3]};
                    const int c = 512 * cb + 256 * hf + col, dirn = c >> 11, dd = c & 2047, gp0 = pbase + 8 * k;
                    bf16* dst = gp0 < SL ? (bf16*)(F.ws + WS_KRN) + ((size_t)dd * 2 + dirn) * SL + gp0 : (bf16*)(F.ws + WS_KRC) + ((size_t)dd * 2 + dirn) * CL + (gp0 - SL);
                    if (!dry) *(GAS u32x4*)dst = o; else if (o.x == 0x12345678u) *(GAS u32x4*)dst = o; }
            }
            __syncthreads();
        }
    }
}
constexpr int CVT_DENSE = 32 * 192 + 3 * 32 * 64, CVT_GU0 = CVT_DENSE + 65536, CVT_D0 = CVT_GU0 + 32768, CVT_GU1 = CVT_D0 + 65536, CVT_NITEMS = CVT_D0 + 98304;
constexpr int CVT_CHUNK = 8;
#ifndef CVT_P10_ITEMS
#define CVT_P10_ITEMS 30720
#endif
constexpr int CVT_T2 = 15360;
constexpr int CVT_P10 = CVT_NITEMS - CVT_P10_ITEMS;
constexpr int CVT_P3_END = CVT_P10 - CVT_T2;
__device__ __forceinline__ void cvt_weights(Frame& F, int lo, int hi, int wi, int nw, LAS float* scr) {
    const float* const* in = F.in;
    f32x4 va[8], vb[8];
    int it = lo + wi;
    TItem ta = p0_decode(in, F.ws, it < hi ? it : hi - 1), tb;
    p0_item_load(va, ta, F.lane);
#pragma unroll 1
    for (; it < hi; it += 2 * nw) {
        const int ib = it + nw, ia = it + 2 * nw;
        tb = p0_decode(in, F.ws, ib < hi ? ib : hi - 1); p0_item_load(vb, tb, F.lane);
        p0_item_store(va, ta, scr, F.lane);
        ta = p0_decode(in, F.ws, ia < hi ? ia : hi - 1); p0_item_load(va, ta, F.lane);
        if (ib < hi) p0_item_store(vb, tb, scr, F.lane);
    }
}
constexpr int CVT_WG = 128, CVT_TAIL = 32;
__device__ __forceinline__ void cvt_pull(Frame& F, int limit, int max_chunks, bool tail) {
    { int t_ = threadIdx.x; asm volatile("" : "+v"(t_)); F.tid = t_; F.lane = t_ & 63; }
    unsigned* q = F.ctl + CW_CVTQ; LAS float* scr = (LAS float*)(F.lds + F.wave * 8448); volatile LAS int* slot = (volatile LAS int*)(F.lds + MISC_OFF + 64);
    const int csz = tail ? CVT_TAIL : CVT_WG;
#pragma unroll 1
    for (int n = 0; n < max_chunks; ++n) {
        __syncthreads();
        if (F.tid == 0) { int b = CVT_NITEMS; bool go = (int)xb_ld(q) + CVT_DENSE < limit;
            if (go && tail) { const unsigned nloc = ((volatile LAS unsigned*)(F.lds + MISC_OFF))[0]; if (nloc != 0u && (xb_ld(F.ctl + CW_BAR + XB_XSUB(xb_xcc_id())) % nloc) != 0u) go = false; }
            if (go) b = (int)xb_add(q, (unsigned)csz) + CVT_DENSE; slot[0] = b; }
        __syncthreads();
        const int base = slot[0];
        if (base >= CVT_NITEMS) break;
        cvt_weights(F, base, base + csz < CVT_NITEMS ? base + csz : CVT_NITEMS, F.wave, NWAVES, scr);
    }
    __syncthreads();
}
__device__ __forceinline__ void cvt_drain(Frame& F, int d, int limit) {
    unsigned* q = F.ctl + CW_CVTQ; volatile LAS int* slot = (volatile LAS int*)(F.lds + MISC_OFF + 64);
    __syncthreads();
    if (F.tid == 0) { const unsigned cur = xb_ld(q); unsigned expect = 0u;
        const bool won = __hip_atomic_compare_exchange_strong(F.ctl + CW_CVTQ + 64 * (1 + d), &expect, cur + 1u, __ATOMIC_RELAXED, __ATOMIC_RELAXED, __HIP_MEMORY_SCOPE_AGENT);
        const unsigned snap = won ? cur : expect - 1u;
        __hip_atomic_fetch_max(q, (unsigned)(limit - CVT_DENSE), __ATOMIC_RELAXED, __HIP_MEMORY_SCOPE_AGENT);
        slot[0] = (int)snap + CVT_DENSE; }
    __syncthreads();
    const int q0 = slot[0];
    if (q0 < limit) cvt_weights(F, q0, limit, F.c * NWAVES + F.wave, F.G * NWAVES, (LAS float*)(F.lds + F.wave * 8448));
    __syncthreads();
}
struct Row { f32x4 v[8]; };
__device__ __forceinline__ void row_load(Row& r, const float* p, int lane) {
#pragma unroll
    for (int i = 0; i < 8; ++i) r.v[i] = *(const GAS f32x4*)(p + 4 * lane + 256 * i);
}
__device__ __forceinline__ float row_rstd(const Row& r) {
    float s = 0.f;
#pragma unroll
    for (int i = 0; i < 8; ++i) s += (r.v[i][0] * r.v[i][0] + r.v[i][1] * r.v[i][1]) + (r.v[i][2] * r.v[i][2] + r.v[i][3] * r.v[i][3]);
    return 1.0f / sqrtf(wave_sum(s) * (1.0f / D) + EPS);
}
__device__ __forceinline__ void row_norm_mod_store(const Row& r, float rstd, const float* g, const float* sh, const float* sc, bf16* o, int lane) {
    f32x4 mv[8], hv[8];
#pragma unroll
    for (int i = 0; i < 8; ++i) { const int c = 4 * lane + 256 * i;
        const f32x4 gv = *(const GAS f32x4*)(g + c), sv = *(const GAS f32x4*)(sc + c); hv[i] = *(const GAS f32x4*)(sh + c); mv[i] = gv * (sv + 1.0f); }
    asm volatile("" ::: "memory");
#pragma unroll
    for (int i = 0; i < 8; ++i) { const int c = 4 * lane + 256 * i;
        const f32x4 y = (r.v[i] * rstd) * mv[i] + hv[i];
        u32x2 w; w.x = pk2(y[0], y[1]); w.y = pk2(y[2], y[3]); *(GAS u32x2*)(o + c) = w; }
}
__device__ __forceinline__ int moe_pos(const LAS int* rbfirst, int packed) { return 256 * rbfirst[packed >> 20] + (packed & 0xfffff); }
__device__ __forceinline__ void row_add_moe(Row& r, const float* gt, const bf16* eo, int p0, int p1, float g0, float g1, int lane) {
#pragma unroll
    for (int i = 0; i < 8; ++i) { const int c = 4 * lane + 256 * i;
        const u32x2 a = *(const GAS u32x2*)(eo + (size_t)p0 * D + c), b = *(const GAS u32x2*)(eo + (size_t)p1 * D + c); const f32x4 gv = *(const GAS f32x4*)(gt + c);
        f32x4 m; m[0] = g0 * bflo(a.x) + g1 * bflo(b.x); m[1] = g0 * bfhi(a.x) + g1 * bfhi(b.x); m[2] = g0 * bflo(a.y) + g1 * bflo(b.y); m[3] = g0 * bfhi(a.y) + g1 * bfhi(b.y);
        r.v[i] += gv * m; }
}
__device__ __forceinline__ void row_store(const Row& r, float* p, int lane) {
#pragma unroll
    for (int i = 0; i < 8; ++i) *(GAS f32x4*)(p + 4 * lane + 256 * i) = r.v[i];
}
__device__ __forceinline__ int moe_tables_cached(Frame& F, int l);
__device__ __forceinline__ int moe_tables(Frame& F, int l) {
    LAS int* rb_e = (LAS int*)(F.lds + TAB_OFF); LAS int* rbfirst = rb_e + 168; LAS int* cnt = rbfirst + 33;
    __syncthreads();
    if (F.tid < 64) {
        const int e = F.tid & 31; const int c = (int)xb_ld(F.ctl + CW_CNT + (l * 32 + e) * 64); const int n = (c + 255) >> 8;
        int incl = n;
#pragma unroll
        for (int d = 1; d < 32; d <<= 1) { const int t = __shfl_up(incl, d, 64); if (F.tid >= d) incl += t; }
        if (F.tid < 32) { const int first = incl - n; cnt[e] = c; rbfirst[e] = first; for (int k = 0; k < n; ++k) rb_e[first + k] = e; if (e == 31) rbfirst[32] = incl; }
    }
    __syncthreads();
    return rbfirst[32];
}
__device__ __forceinline__ int moe_tables_cached(Frame& F, int l) {
    if (MK_N_LAUNCHES != 1) return moe_tables(F, l);
    return ((const LAS int*)(F.lds + TAB_OFF))[168 + 32];
}

__device__ __forceinline__ void p_norm1_l0(Frame& F) {
    const int gw = F.c * NWAVES + F.wave, NGW = F.G * NWAVES;
    for (int r = gw; r < TT; r += NGW) {
        const bool lat = r < TL; const float* src = lat ? F.in[I_X] + (size_t)r * D : F.in[I_CTX] + (size_t)(r - TL) * D; const float* mod = MODP(F, 0, lat ? (r >> 12) : 4);
        Row row; row_load(row, src, F.lane); const float rstd = row_rstd(row);
        row_norm_mod_store(row, rstd, F.in[I_NORMG], mod, mod + 2048, (bf16*)(F.ws + WS_U) + (size_t)r * D, F.lane);
    }
}
__device__ __forceinline__ void p_comb_norm1_l1(Frame& F) {
    moe_tables_cached(F, 0);
    const LAS int* rbfirst = (const LAS int*)(F.lds + TAB_OFF) + 168;
    const int gw = F.c * NWAVES + F.wave, NGW = F.G * NWAVES;
    const int* tokpos = (const int*)(F.ws + WS_TOKPOS); const float* gates = (const float*)(F.ws + WS_GATE);
    for (int r = gw; r < TT; r += NGW) {
        const bool lat = r < TL; float* xp = lat ? F.out + (size_t)r * D : (float*)(F.ws + WS_XC) + (size_t)(r - TL) * D; const int mr = lat ? (r >> 12) : 4;
        Row row; row_load(row, xp, F.lane);
        const int p0 = moe_pos(rbfirst, tokpos[2 * r]), p1 = moe_pos(rbfirst, tokpos[2 * r + 1]);
        row_add_moe(row, MODP(F, 0, mr) + 10240, (const bf16*)(F.ws + WS_EO), p0, p1, gates[2 * r], gates[2 * r + 1], F.lane);
        row_store(row, xp, F.lane);
        const float rstd = row_rstd(row); const float* mod = MODP(F, 1, mr);
        row_norm_mod_store(row, rstd, F.in[I_NORMG] + 2 * D, mod, mod + 2048, (bf16*)(F.ws + WS_U) + (size_t)r * D, F.lane);
    }
}
__device__ __forceinline__ void p_final(Frame& F) {
    moe_tables_cached(F, 1);
    const LAS int* rbfirst = (const LAS int*)(F.lds + TAB_OFF) + 168;
    const int gw = F.c * NWAVES + F.wave, NGW = F.G * NWAVES;
    const int* tokpos = (const int*)(F.ws + WS_TOKPOS); const float* gates = (const float*)(F.ws + WS_GATE);
    for (int r = gw; r < TL; r += NGW) {
        float* xp = F.out + (size_t)r * D;
        Row row; row_load(row, xp, F.lane);
        const int p0 = moe_pos(rbfirst, tokpos[2 * r]), p1 = moe_pos(rbfirst, tokpos[2 * r + 1]);
        row_add_moe(row, MODP(F, 1, r >> 12) + 10240, (const bf16*)(F.ws + WS_EO), p0, p1, gates[2 * r], gates[2 * r + 1], F.lane);
        const float rstd = row_rstd(row);
#pragma unroll
        for (int i = 0; i < 8; ++i) { const int c = 4 * F.lane + 256 * i; const f32x4 gv = *(const GAS f32x4*)(F.in[I_FINALG] + c); row.v[i] = row.v[i] * rstd * gv; }
        row_store(row, xp, F.lane);
    }
}

__device__ __forceinline__ void p_router(Frame& F, int l, int ntok, int dry = 0) {
    constexpr int PITCH = 2056;
    LAS float* xt = (LAS float*)F.lds;
    LAS float* red = (LAS float*)F.lds;
    LAS float* lg = (LAS float*)(F.lds + 132096);
    const float* wrt = (const float*)(F.ws + WS_WRT) + (size_t)l * 48 * 2048;
    const float* g = F.in[I_NORMG] + (size_t)(l * 2 + 1) * D;
    int* list = (int*)(F.ws + WS_LIST); int* tokpos = (int*)(F.ws + WS_TOKPOS); float* gates = (float*)(F.ws + WS_GATE);
    const int ntile = ntok / 16;
#define ROUTER_XP(t0_) ((t0_) + 2 * F.wave < TL ? F.out + (size_t)((t0_) + 2 * F.wave) * D : (const float*)(F.ws + WS_XC) + (size_t)((t0_) + 2 * F.wave - TL) * D)
    Row ra, rb;
    { const int tf = F.c < ntile ? F.c : ntile - 1; const float* xp = ROUTER_XP(tf * 16); row_load(ra, xp, F.lane); row_load(rb, xp + D, F.lane); }
    LAS float* lbias = lg + 768;
    if (F.tid < 48) lbias[F.tid] = F.tid < 4 ? F.in[I_MBG][l * 4 + F.tid] : (F.tid < 36 ? F.in[I_MBE][l * 32 + F.tid - 4] : 0.f);
    int pr_r = -1, pr_e0 = 0, pr_e1 = 0; unsigned pr_s0 = 0, pr_s1 = 0; float pr_g0 = 0.f, pr_g1 = 0.f;
    f32x4 mvs[8], hvs[8];
#define ROUTER_MOD(tile_) do { const int r0_ = (tile_) * 16 + 2 * F.wave; const float* mod_ = MODP(F, l, r0_ < TL ? (r0_ >> 12) : 4); \
        _Pragma("unroll") for (int i = 0; i < 8; ++i) { const int c = 4 * F.lane + 256 * i; \
            const f32x4 gv = *(const GAS f32x4*)(g + c), sv = *(const GAS f32x4*)(mod_ + 8192 + c); hvs[i] = *(const GAS f32x4*)(mod_ + 6144 + c); mvs[i] = gv * (sv + 1.0f); } } while (0)
    { const int tf = F.c < ntile ? F.c : ntile - 1; ROUTER_MOD(tf); }
#define ROUTER_FINISH() do { if (pr_r >= 0) { list[(size_t)pr_e0 * TT + pr_s0] = pr_r; list[(size_t)pr_e1 * TT + pr_s1] = pr_r; \
        tokpos[2 * pr_r] = (pr_e0 << 20) | (int)pr_s0; tokpos[2 * pr_r + 1] = (pr_e1 << 20) | (int)pr_s1; gates[2 * pr_r] = pr_g0; gates[2 * pr_r + 1] = pr_g1; pr_r = -1; } } while (0)
    LDS_BARRIER();
#pragma unroll 1
    for (int tile = F.c; tile < ntile; tile += F.G) {
        const int t0 = tile * 16;
        {
            const int r0 = t0 + 2 * F.wave;
            if (!(dry & 4)) {
            const float rsa = row_rstd(ra), rsb = row_rstd(rb);
            bf16* oa = (bf16*)(F.ws + WS_U) + (size_t)r0 * D; LAS float* xa = xt + (2 * F.wave) * PITCH;
#pragma unroll
            for (int i = 0; i < 8; ++i) { const int c = 4 * F.lane + 256 * i;
                const f32x4 mv = mvs[i], hv = hvs[i];
                const f32x4 ya = (ra.v[i] * rsa) * mv + hv, yb = (rb.v[i] * rsb) * mv + hv;
                u32x2 wa; wa.x = pk2(ya[0], ya[1]); wa.y = pk2(ya[2], ya[3]); if (!dry) *(GAS u32x2*)(oa + c) = wa;
                u32x2 wb; wb.x = pk2(yb[0], yb[1]); wb.y = pk2(yb[2], yb[3]); if (!dry) *(GAS u32x2*)(oa + D + c) = wb;
                *(LAS f32x4*)(xa + c) = ya; *(LAS f32x4*)(xa + PITCH + c) = yb; } } }
        ROUTER_FINISH();
        const int tk = F.lane & 15, kq = F.lane >> 4, kb = 256 * F.wave + 4 * kq; const LAS float* ap = xt + tk * PITCH + kb;
        const float* bp = wrt + (size_t)tk * 2048 + kb;
        f32x4 wq[4][3];
#pragma unroll
        for (int s = 0; s < 4; ++s)
#pragma unroll
            for (int nt = 0; nt < 3; ++nt) wq[s][nt] = *(const GAS f32x4*)(bp + (size_t)nt * 16 * 2048 + 16 * s);
        LDS_BARRIER();
        f32x4 a0 = {0.f, 0.f, 0.f, 0.f}, a1 = a0, a2 = a0;
#define ROUTER_MMA(S0_) do { _Pragma("unroll") for (int s = 0; s < 4; ++s) { const f32x4 av = *(const LAS f32x4*)(ap + 16 * ((S0_) + s)); \
            _Pragma("unroll") for (int j = 0; j < 4; ++j) { a0 = __builtin_amdgcn_mfma_f32_16x16x4f32(av[j], wq[s][0][j], a0, 0, 0, 0); a1 = __builtin_amdgcn_mfma_f32_16x16x4f32(av[j], wq[s][1][j], a1, 0, 0, 0); \
                a2 = __builtin_amdgcn_mfma_f32_16x16x4f32(av[j], wq[s][2][j], a2, 0, 0, 0); } } } while (0)
#pragma unroll 1
        for (int S0 = 0; S0 < 12; S0 += 4) {
            f32x4 wn[4][3];
#pragma unroll
            for (int s = 0; s < 4; ++s)
#pragma unroll
                for (int nt = 0; nt < 3; ++nt) wn[s][nt] = *(const GAS f32x4*)(bp + (size_t)nt * 16 * 2048 + 16 * (S0 + 4 + s));
            ROUTER_MMA(S0);
#pragma unroll
            for (int s = 0; s < 4; ++s)
#pragma unroll
                for (int nt = 0; nt < 3; ++nt) wq[s][nt] = wn[s][nt];
        }
        { const int tn = tile + F.G < ntile ? tile + F.G : tile; const float* xp = ROUTER_XP(tn * 16); row_load(ra, xp, F.lane); row_load(rb, xp + D, F.lane); }
        ROUTER_MMA(12);
#undef ROUTER_MMA
        LDS_BARRIER();
        { LAS float* rp = red + F.wave * 768;
#pragma unroll
          for (int j = 0; j < 4; ++j) { const int tk = 4 * (F.lane >> 4) + j; rp[tk * 48 + (F.lane & 15)] = a0[j]; rp[tk * 48 + 16 + (F.lane & 15)] = a1[j]; rp[tk * 48 + 32 + (F.lane & 15)] = a2[j]; } }
        LDS_BARRIER();
        for (int i = F.tid; i < 768; i += NTHR) { float s = 0.f;
#pragma unroll
            for (int w = 0; w < 8; ++w) s += red[w * 768 + i];
            s += lbias[i % 48]; lg[i] = s; }
        LDS_BARRIER();
        { const int tn = tile + F.G < ntile ? tile + F.G : tile; ROUTER_MOD(tn); }
        if (F.tid < 16 && !(dry & 2)) { const LAS float* q = lg + F.tid * 48; const int r = t0 + F.tid;
            int gi = 0; float gm = q[0];
#pragma unroll
            for (int k = 1; k < 4; ++k) if (q[k] > gm) { gm = q[k]; gi = k; }
            float gs = 0.f;
#pragma unroll
            for (int k = 0; k < 4; ++k) gs += __expf(q[k] - gm);
            const float ptop = 1.0f / gs;
            const LAS float* e = q + 4 + 8 * gi; int i0 = 0; float v0 = e[0];
#pragma unroll
            for (int k = 1; k < 8; ++k) if (e[k] > v0) { v0 = e[k]; i0 = k; }
            int i1 = -1; float v1 = -3.0e38f;
#pragma unroll
            for (int k = 0; k < 8; ++k) if (k != i0 && e[k] > v1) { v1 = e[k]; i1 = k; }
            const float x1 = __expf(v1 - v0), den = 1.0f / (1.0f + x1);
            const int e0 = gi * 8 + i0, e1 = gi * 8 + i1;
            if (!dry) {
            pr_s0 = xb_add(F.ctl + CW_CNT + (l * 32 + e0) * 64, 1u); pr_s1 = xb_add(F.ctl + CW_CNT + (l * 32 + e1) * 64, 1u);
            pr_r = r; pr_e0 = e0; pr_e1 = e1; pr_g0 = ptop * den; pr_g1 = ptop * x1 * den; }
            else { ((volatile LAS float*)lg)[F.tid * 48 + 40] = ptop * den + (float)(e0 + e1); } }
    }
    ROUTER_FINISH();
#undef ROUTER_FINISH
#undef ROUTER_MOD
#undef ROUTER_XP
}
constexpr int CV_KR = 0, CV_KRC = 16384, CV_ZERO = 17408, CV_V = 17920, CV_VB = 10272, CV_VJ = 640, CV_VC = 59008, CV_VCB = 544, CV_RED = 61184;
__device__ __forceinline__ float conv3(float zm, float z0, float zp, float w0, float w1, float w2, float cb) { return zm * w0 + z0 * w1 + zp * w2 + cb; }
template <int NV> struct ZChunk { u32x4 v[NV]; unsigned short hl, hr; };
template <int NV>
__device__ __forceinline__ void zchunk_load(ZChunk<NV>& z, const bf16* zrow, int col0, int t0, int Lseq) {
#pragma unroll
    for (int i = 0; i < NV; ++i) z.v[i] = *(const GAS u32x4*)(zrow + col0 + 8 * i);
    z.hl = zrow[t0 > 0 ? col0 - 1 : col0];
    z.hr = zrow[(t0 + 8 * NV < Lseq) ? col0 + 8 * NV : col0];
}
template <int NV>
__device__ __forceinline__ void zchunk_conv3(const ZChunk<NV>& zc, int t0, int Lseq, float w0, float w1, float w2, float cb, float* out) {
    float z[8 * NV + 2];
    z[0] = t0 > 0 ? bf2f(zc.hl) : 0.f;
    z[8 * NV + 1] = (t0 + 8 * NV < Lseq) ? bf2f(zc.hr) : 0.f;
#pragma unroll
    for (int i = 0; i < NV; ++i) { const u32x4 w = zc.v[i];
        z[1 + 8 * i] = bflo(w.x); z[2 + 8 * i] = bfhi(w.x); z[3 + 8 * i] = bflo(w.y); z[4 + 8 * i] = bfhi(w.y); z[5 + 8 * i] = bflo(w.z); z[6 + 8 * i] = bfhi(w.z); z[7 + 8 * i] = bflo(w.w); z[8 + 8 * i] = bfhi(w.w); }
#pragma unroll
    for (int i = 0; i < 8 * NV; ++i) out[i] = conv3(z[i], z[i + 1], z[i + 2], w0, w1, w2, cb);
}
#define CV_MMA8(acc, d, bfr) do { \
    unsigned o_[7]; _Pragma("unroll") for (int m_ = 0; m_ < 7; ++m_) o_[m_] = __builtin_amdgcn_alignbit(d[m_ + 1], d[m_], 16); \
    _Pragma("unroll") for (int q_ = 0; q_ < 4; ++q_) { \
        u32x4 fe_ = {d[4 - q_], d[5 - q_], d[6 - q_], d[7 - q_]}; u32x4 fo_ = {o_[3 - q_], o_[4 - q_], o_[5 - q_], o_[6 - q_]}; \
        acc[2 * q_] = __builtin_amdgcn_mfma_f32_16x16x32_bf16(__builtin_bit_cast(bf16x8, fe_), bfr, acc[2 * q_], 0, 0, 0); \
        acc[2 * q_ + 1] = __builtin_amdgcn_mfma_f32_16x16x32_bf16(__builtin_bit_cast(bf16x8, fo_), bfr, acc[2 * q_ + 1], 0, 0, 0); } } while (0)

struct ConvPre { u32x4 kf, kb, kc; ZChunk<4> zv, zx; ZChunk<1> cv, cx; };
__device__ __forceinline__ void conv_issue(ConvPre& P, Frame& F, int d) {
    const int tid = F.tid; const bf16* ZT = (const bf16*)(F.ws + WS_ZT);
    const bf16* kn = (const bf16*)(F.ws + WS_KRN) + (size_t)d * 2 * SL; const bf16* kc = (const bf16*)(F.ws + WS_KRC) + (size_t)d * 2 * CL;
    P.kf = *(const GAS u32x4*)(kn + 8 * tid); P.kb = *(const GAS u32x4*)(kn + SL + 8 * tid);
    P.kc = *(const GAS u32x4*)(kc + ((tid >> 5) & 1) * CL + 8 * (tid & 31));
    { const int b = tid >> 7, t0 = (tid & 127) * 32, col0 = b * SL + t0;
      zchunk_load<4>(P.zv, ZT + (size_t)(4096 + d) * ZLD, col0, t0, SL); zchunk_load<4>(P.zx, ZT + (size_t)(2048 + d) * ZLD, col0, t0, SL); }
    { const int b = (tid >> 5) & 3, t0 = (tid & 31) * 8, col0 = TL + b * CL + t0;
      zchunk_load<1>(P.cv, ZT + (size_t)(4096 + d) * ZLD, col0, t0, CL); zchunk_load<1>(P.cx, ZT + (size_t)(2048 + d) * ZLD, col0, t0, CL); }
}

__device__ __forceinline__ void p_conv(Frame& F) {
    LAS unsigned char* lds = F.lds;
    const bf16* ZT = (const bf16*)(F.ws + WS_ZT); bf16* YXT = (bf16*)(F.ws + WS_YXT);
    const float* cw = F.in[I_HCW]; const float* cbp = F.in[I_HCB];
    const int tid = F.tid, lane = F.lane, w = F.wave, g = w & 1, q = w >> 1, r = lane & 15, h4 = lane >> 4, Isub = r >> 2, bb = r & 3;
    for (int i = tid; i < 128; i += NTHR) ((LAS unsigned*)(lds + CV_ZERO))[i] = 0u;
    ConvPre P;
    if (F.c < D) conv_issue(P, F, F.c);
#pragma unroll 1
    for (int d = F.c; d < D; d += F.G) {
        __syncthreads();
        float nl = 0.f, nc = 0.f;
        { LAS bf16* KR = (LAS bf16*)(lds + CV_KR);
          const unsigned fwv[4] = {P.kf.x, P.kf.y, P.kf.z, P.kf.w}, bwv[4] = {P.kb.x, P.kb.y, P.kb.z, P.kb.w};
#pragma unroll
          for (int e = 0; e < 8; ++e) { const int j = 8 * tid + e; const unsigned short fv = (unsigned short)(fwv[e >> 1] >> (16 * (e & 1))), bv = (unsigned short)(bwv[e >> 1] >> (16 * (e & 1)));
              KR[SL - j] = fv; nl += fabsf(bf2f(fv));
              if (j > 0) { KR[SL + j] = bv; nl += fabsf(bf2f(bv)); } }
          if (tid == 0) KR[0] = 0;
          if (tid < 64) { LAS bf16* KC = (LAS bf16*)(lds + CV_KRC); const int dirn = tid >> 5, j0 = 8 * (tid & 31);
              const unsigned cv4[4] = {P.kc.x, P.kc.y, P.kc.z, P.kc.w};
#pragma unroll
              for (int e = 0; e < 8; ++e) { const int j = j0 + e; const unsigned short v = (unsigned short)(cv4[e >> 1] >> (16 * (e & 1)));
                  if (dirn == 0) { KC[CL - j] = v; nc += fabsf(bf2f(v)); } else if (j > 0) { KC[CL + j] = v; nc += fabsf(bf2f(v)); } }
              if (tid == 0) KC[0] = 0; } }
        { const int chv = 4096 + d, chx = 2048 + d;
          const float v0 = cw[chv], v1 = cw[6144 + chv], v2 = cw[12288 + chv], vb = cbp[chv], x0 = cw[chx], x1 = cw[6144 + chx], x2 = cw[12288 + chx], xb = cbp[chx];
          { const int b = tid >> 7, t0 = (tid & 127) * 32; float zv[32], zx[32];
            zchunk_conv3<4>(P.zv, t0, SL, v0, v1, v2, vb, zv); zchunk_conv3<4>(P.zx, t0, SL, x0, x1, x2, xb, zx);
            LAS unsigned char* dst = lds + CV_V + b * CV_VB + (t0 >> 8) * CV_VJ + (t0 & 255) * 2;
#pragma unroll
            for (int i = 0; i < 4; ++i) { u32x4 o; o.x = pk2(zv[8 * i] * zx[8 * i], zv[8 * i + 1] * zx[8 * i + 1]); o.y = pk2(zv[8 * i + 2] * zx[8 * i + 2], zv[8 * i + 3] * zx[8 * i + 3]);
                o.z = pk2(zv[8 * i + 4] * zx[8 * i + 4], zv[8 * i + 5] * zx[8 * i + 5]); o.w = pk2(zv[8 * i + 6] * zx[8 * i + 6], zv[8 * i + 7] * zx[8 * i + 7]); *(LAS u32x4*)(dst + 16 * i) = o; } }
          { const int b = (tid >> 5) & 3, t0 = (tid & 31) * 8; float zv[8], zx[8];
            zchunk_conv3<1>(P.cv, t0, CL, v0, v1, v2, vb, zv); zchunk_conv3<1>(P.cx, t0, CL, x0, x1, x2, xb, zx);
            u32x4 o; o.x = pk2(zv[0] * zx[0], zv[1] * zx[1]); o.y = pk2(zv[2] * zx[2], zv[3] * zx[3]); o.z = pk2(zv[4] * zx[4], zv[5] * zx[5]); o.w = pk2(zv[6] * zx[6], zv[7] * zx[7]);
            if (tid < 128) *(LAS u32x4*)(lds + CV_VC + b * CV_VCB + t0 * 2) = o; } }
        nl = wave_sum(nl); nc = wave_sum(nc);
        if (lane == 0) { ((LAS float*)(lds + CV_RED))[w] = nl; ((LAS float*)(lds + CV_RED))[8 + w] = nc; }
        __syncthreads();
        const int I_ep = 4 * q + Isub, t0l = 256 * I_ep + 128 * g + 32 * h4, col0l = bb * SL + t0l, t0c = 128 * g + 32 * h4, col0c = TL + bb * CL + t0c;
        ZChunk<4> xl_, xc_;
        zchunk_load<4>(xl_, ZT + (size_t)d * ZLD, col0l, t0l, SL);
        { const int dn = d + F.G; conv_issue(P, F, dn < D ? dn : d); }
        float inv_l = 0.f, inv_c = ((LAS float*)(lds + CV_RED))[8];
#pragma unroll
        for (int i = 0; i < 8; ++i) inv_l += ((LAS float*)(lds + CV_RED))[i];
        inv_l = 1.0f / inv_l; inv_c = 1.0f / inv_c;
        const float skip = F.in[I_SKIP][d];
        const float c0 = cw[d], c1 = cw[6144 + d], c2 = cw[12288 + d], cb0 = cbp[d];
        {
            f32x4 acc[8];
#pragma unroll
            for (int i = 0; i < 8; ++i) acc[i] = (f32x4){0.f, 0.f, 0.f, 0.f};
#define CV_BASES(dl_, ap_, bp_) do { const int J_ = 4 * q + Isub - (dl_); const bool v_ = (J_ >= 0) && (J_ <= 15); \
                bp_ = v_ ? lds + CV_V + bb * CV_VB + J_ * CV_VJ + h4 * 16 : lds + CV_ZERO + h4 * 16; \
                ap_ = lds + CV_KR + (SL - 256 * (dl_) - 128 * g - 8 * r + 8 * h4 - 8) * 2; } while (0)
            const LAS unsigned char *ap, *bp, *apn, *bpn;
            CV_BASES(4 * q - 15, ap, bp);
            u32x4 ca = *(const LAS u32x4*)(ap), cbv = *(const LAS u32x4*)(ap + 16); bf16x8 bfr = *(const LAS bf16x8*)(bp);
#pragma unroll 1
            for (int dl = 4 * q - 15; dl <= 4 * q + 3; ++dl) {
                { const int dn_ = dl < 4 * q + 3 ? dl + 1 : dl; CV_BASES(dn_, apn, bpn); }
#pragma unroll
                for (int kk = 0; kk < 8; ++kk) {
                    const LAS unsigned char* an_ = kk < 7 ? ap + 64 * (kk + 1) : apn; const LAS unsigned char* bn_ = kk < 7 ? bp + 64 * (kk + 1) : bpn;
                    const u32x4 can = *(const LAS u32x4*)(an_), cbn = *(const LAS u32x4*)(an_ + 16); const bf16x8 bfn = *(const LAS bf16x8*)(bn_);
                    __builtin_amdgcn_sched_barrier(0);
                    const unsigned dd[8] = {ca.x, ca.y, ca.z, ca.w, cbv.x, cbv.y, cbv.z, cbv.w};
                    CV_MMA8(acc, dd, bfr);
                    __builtin_amdgcn_sched_barrier(0);
                    ca = can; cbv = cbn; bfr = bfn;
                }
                ap = apn; bp = bpn;
            }
#undef CV_BASES
            float x0c[32]; zchunk_conv3<4>(xl_, t0l, SL, c0, c1, c2, cb0, x0c);
            const LAS unsigned char* vp = lds + CV_V + bb * CV_VB + I_ep * CV_VJ + (128 * g + 32 * h4) * 2;
#pragma unroll
            for (int i = 0; i < 4; ++i) { const u32x4 vv = *(const LAS u32x4*)(vp + 16 * i); const unsigned vw[4] = {vv.x, vv.y, vv.z, vv.w}; unsigned ow[4];
#pragma unroll
                for (int p = 0; p < 4; ++p) { const int e0 = 8 * i + 2 * p, e1 = e0 + 1;
                    const float y0 = (acc[e0 & 7][e0 >> 3] * inv_l + skip * bflo(vw[p])) * x0c[e0], y1 = (acc[e1 & 7][e1 >> 3] * inv_l + skip * bfhi(vw[p])) * x0c[e1];
                    ow[p] = pk2(y0, y1); }
                *(GAS u32x4*)(YXT + (size_t)d * ZLD + col0l + 8 * i) = (u32x4){ow[0], ow[1], ow[2], ow[3]}; }
        }
        zchunk_load<4>(xc_, ZT + (size_t)d * ZLD, col0c, t0c, CL);
        if (w < 2) {
            f32x4 acc[8];
#pragma unroll
            for (int i = 0; i < 8; ++i) acc[i] = (f32x4){0.f, 0.f, 0.f, 0.f};
            const bool valid = Isub == 0;
            const LAS unsigned char* bp = valid ? lds + CV_VC + bb * CV_VCB + h4 * 16 : lds + CV_ZERO + h4 * 16;
            const int xb = CL - 128 * g - 8 * r + 8 * h4;
            const LAS unsigned char* ap = lds + CV_KRC + (xb - 8) * 2;
#pragma unroll
            for (int kk = 0; kk < 8; ++kk) {
                const u32x4 ca = *(const LAS u32x4*)(ap + 64 * kk), cbv = *(const LAS u32x4*)(ap + 64 * kk + 16);
                const bf16x8 bfr = *(const LAS bf16x8*)(bp + 64 * kk);
                const unsigned dd[8] = {ca.x, ca.y, ca.z, ca.w, cbv.x, cbv.y, cbv.z, cbv.w};
                CV_MMA8(acc, dd, bfr);
            }
            float x0c[32]; zchunk_conv3<4>(xc_, t0c, CL, c0, c1, c2, cb0, x0c);
            const LAS unsigned char* vp = lds + CV_VC + bb * CV_VCB + t0c * 2;
            u32x4 outv[4];
#pragma unroll
            for (int i = 0; i < 4; ++i) { const u32x4 vv = *(const LAS u32x4*)(vp + 16 * i); const unsigned vw[4] = {vv.x, vv.y, vv.z, vv.w}; unsigned ow[4];
#pragma unroll
                for (int p = 0; p < 4; ++p) { const int e0 = 8 * i + 2 * p, e1 = e0 + 1;
                    const float y0 = (acc[e0 & 7][e0 >> 3] * inv_c + skip * bflo(vw[p])) * x0c[e0], y1 = (acc[e1 & 7][e1 >> 3] * inv_c + skip * bfhi(vw[p])) * x0c[e1];
                    ow[p] = pk2(y0, y1); }
                outv[i] = (u32x4){ow[0], ow[1], ow[2], ow[3]}; }
            if (valid) {
#pragma unroll
                for (int i = 0; i < 4; ++i) *(GAS u32x4*)(YXT + (size_t)d * ZLD + col0c + 8 * i) = outv[i]; }
        }
    }
}

__device__ __forceinline__ void p_conv_mix(Frame& F, bool do_cvt = true) {
    LAS unsigned char* lds = F.lds;
    const bf16* ZT = (const bf16*)(F.ws + WS_ZT); bf16* YXT = (bf16*)(F.ws + WS_YXT);
    const float* cw = F.in[I_HCW]; const float* cbp = F.in[I_HCB];
    const int tid = F.tid, lane = F.lane, w = F.wave, g = w & 1, r = lane & 15, h4 = lane >> 4, Isub = r >> 2, bb = r & 3;
    for (int i = tid; i < 128; i += NTHR) ((LAS unsigned*)(lds + CV_ZERO))[i] = 0u;
    ConvPre P;
    if (F.c < D) conv_issue(P, F, F.c);
    const int cw_i = F.c * 4 + (w - 4), cw_n = F.G * 4; int cvt_pos = CVT_DENSE;
    const int nch = (D - F.c + F.G - 1) / F.G; const int cvt_per = ((CVT_P3_END - CVT_DENSE + cw_n - 1) / cw_n + nch - 1) / nch * cw_n;
#pragma unroll 1
    for (int d = F.c; d < D; d += F.G) {
        LDS_BARRIER();
        float nl = 0.f, nc = 0.f;
        { LAS bf16* KR = (LAS bf16*)(lds + CV_KR);
          const unsigned fwv[4] = {P.kf.x, P.kf.y, P.kf.z, P.kf.w}, bwv[4] = {P.kb.x, P.kb.y, P.kb.z, P.kb.w};
#pragma unroll
          for (int e = 0; e < 8; ++e) { const int j = 8 * tid + e; const unsigned short fv = (unsigned short)(fwv[e >> 1] >> (16 * (e & 1))), bv = (unsigned short)(bwv[e >> 1] >> (16 * (e & 1)));
              KR[SL - j] = fv; nl += fabsf(bf2f(fv));
              if (j > 0) { KR[SL + j] = bv; nl += fabsf(bf2f(bv)); } }
          if (tid == 0) KR[0] = 0;
          if (tid < 64) { LAS bf16* KC = (LAS bf16*)(lds + CV_KRC); const int dirn = tid >> 5, j0 = 8 * (tid & 31);
              const unsigned cv4[4] = {P.kc.x, P.kc.y, P.kc.z, P.kc.w};
#pragma unroll
              for (int e = 0; e < 8; ++e) { const int j = j0 + e; const unsigned short v = (unsigned short)(cv4[e >> 1] >> (16 * (e & 1)));
                  if (dirn == 0) { KC[CL - j] = v; nc += fabsf(bf2f(v)); } else if (j > 0) { KC[CL + j] = v; nc += fabsf(bf2f(v)); } }
              if (tid == 0) KC[0] = 0; } }
        { const int chv = 4096 + d, chx = 2048 + d;
          const float v0 = cw[chv], v1 = cw[6144 + chv], v2 = cw[12288 + chv], vb = cbp[chv], x0 = cw[chx], x1 = cw[6144 + chx], x2 = cw[12288 + chx], xb = cbp[chx];
          { const int b = tid >> 7, t0 = (tid & 127) * 32; float zv[32], zx[32];
            zchunk_conv3<4>(P.zv, t0, SL, v0, v1, v2, vb, zv); zchunk_conv3<4>(P.zx, t0, SL, x0, x1, x2, xb, zx);
            LAS unsigned char* dst = lds + CV_V + b * CV_VB + (t0 >> 8) * CV_VJ + (t0 & 255) * 2;
#pragma unroll
            for (int i = 0; i < 4; ++i) { u32x4 o; o.x = pk2(zv[8 * i] * zx[8 * i], zv[8 * i + 1] * zx[8 * i + 1]); o.y = pk2(zv[8 * i + 2] * zx[8 * i + 2], zv[8 * i + 3] * zx[8 * i + 3]);
                o.z = pk2(zv[8 * i + 4] * zx[8 * i + 4], zv[8 * i + 5] * zx[8 * i + 5]); o.w = pk2(zv[8 * i + 6] * zx[8 * i + 6], zv[8 * i + 7] * zx[8 * i + 7]); *(LAS u32x4*)(dst + 16 * i) = o; } }
          { const int b = (tid >> 5) & 3, t0 = (tid & 31) * 8; float zv[8], zx[8];
            zchunk_conv3<1>(P.cv, t0, CL, v0, v1, v2, vb, zv); zchunk_conv3<1>(P.cx, t0, CL, x0, x1, x2, xb, zx);
            u32x4 o; o.x = pk2(zv[0] * zx[0], zv[1] * zx[1]); o.y = pk2(zv[2] * zx[2], zv[3] * zx[3]); o.z = pk2(zv[4] * zx[4], zv[5] * zx[5]); o.w = pk2(zv[6] * zx[6], zv[7] * zx[7]);
            if (tid < 128) *(LAS u32x4*)(lds + CV_VC + b * CV_VCB + t0 * 2) = o; } }
        nl = wave_sum(nl); nc = wave_sum(nc);
        if (lane == 0) { ((LAS float*)(lds + CV_RED))[w] = nl; ((LAS float*)(lds + CV_RED))[8 + w] = nc; }
        LDS_BARRIER();
        { const int dn = d + F.G; conv_issue(P, F, dn < D ? dn : d); }
        float inv_l = 0.f, inv_c = ((LAS float*)(lds + CV_RED))[8];
#pragma unroll
        for (int i = 0; i < 8; ++i) inv_l += ((LAS float*)(lds + CV_RED))[i];
        inv_l = 1.0f / inv_l; inv_c = 1.0f / inv_c;
        const float skip = F.in[I_SKIP][d];
        const float c0 = cw[d], c1 = cw[6144 + d], c2 = cw[12288 + d], cb0 = cbp[d];
        if (w >= 4) { const int lo = cvt_pos, hi = cvt_pos + cvt_per < CVT_P3_END ? cvt_pos + cvt_per : CVT_P3_END; if (lo < hi && do_cvt) cvt_weights(F, lo, hi, cw_i, cw_n, (LAS float*)(lds + 65536 + (w - 4) * 8448)); }
        else
#pragma unroll 1
        for (int qi = 0; qi < 2; ++qi) {
            const int q = (w >> 1) + 2 * qi;
            const int I_ep = 4 * q + Isub, t0l = 256 * I_ep + 128 * g + 32 * h4, col0l = bb * SL + t0l;
            ZChunk<4> xl_; zchunk_load<4>(xl_, ZT + (size_t)d * ZLD, col0l, t0l, SL);
            f32x4 acc[8];
#pragma unroll
            for (int i = 0; i < 8; ++i) acc[i] = (f32x4){0.f, 0.f, 0.f, 0.f};
#define CV_BASES(dl_, ap_, bp_) do { const int J_ = 4 * q + Isub - (dl_); const bool v_ = (J_ >= 0) && (J_ <= 15); \
                bp_ = v_ ? lds + CV_V + bb * CV_VB + J_ * CV_VJ + h4 * 16 : lds + CV_ZERO + h4 * 16; \
                ap_ = lds + CV_KR + (SL - 256 * (dl_) - 128 * g - 8 * r + 8 * h4 - 8) * 2; } while (0)
            const LAS unsigned char *ap, *bp, *apn, *bpn;
            CV_BASES(4 * q - 15, ap, bp);
            u32x4 ca = *(const LAS u32x4*)(ap), cbv = *(const LAS u32x4*)(ap + 16); bf16x8 bfr = *(const LAS bf16x8*)(bp);
#pragma unroll 1
            for (int dl = 4 * q - 15; dl <= 4 * q + 3; ++dl) {
                { const int dn_ = dl < 4 * q + 3 ? dl + 1 : dl; CV_BASES(dn_, apn, bpn); }
#pragma unroll
                for (int kk = 0; kk < 8; ++kk) {
                    const LAS unsigned char* an_ = kk < 7 ? ap + 64 * (kk + 1) : apn; const LAS unsigned char* bn_ = kk < 7 ? bp + 64 * (kk + 1) : bpn;
                    const u32x4 can = *(const LAS u32x4*)(an_), cbn = *(const LAS u32x4*)(an_ + 16); const bf16x8 bfn = *(const LAS bf16x8*)(bn_);
                    __builtin_amdgcn_sched_barrier(0);
                    const unsigned dd[8] = {ca.x, ca.y, ca.z, ca.w, cbv.x, cbv.y, cbv.z, cbv.w};
                    CV_MMA8(acc, dd, bfr);
                    __builtin_amdgcn_sched_barrier(0);
                    ca = can; cbv = cbn; bfr = bfn;
                }
                ap = apn; bp = bpn;
            }
#undef CV_BASES
            float x0c[32]; zchunk_conv3<4>(xl_, t0l, SL, c0, c1, c2, cb0, x0c);
            const LAS unsigned char* vp = lds + CV_V + bb * CV_VB + I_ep * CV_VJ + (128 * g + 32 * h4) * 2;
#pragma unroll
            for (int i = 0; i < 4; ++i) { const u32x4 vv = *(const LAS u32x4*)(vp + 16 * i); const unsigned vw[4] = {vv.x, vv.y, vv.z, vv.w}; unsigned ow[4];
#pragma unroll
                for (int p = 0; p < 4; ++p) { const int e0 = 8 * i + 2 * p, e1 = e0 + 1;
                    const float y0 = (acc[e0 & 7][e0 >> 3] * inv_l + skip * bflo(vw[p])) * x0c[e0], y1 = (acc[e1 & 7][e1 >> 3] * inv_l + skip * bfhi(vw[p])) * x0c[e1];
                    ow[p] = pk2(y0, y1); }
                *(GAS u32x4*)(YXT + (size_t)d * ZLD + col0l + 8 * i) = (u32x4){ow[0], ow[1], ow[2], ow[3]}; }
        }
        cvt_pos += cvt_per;
        if (w < 2) {
            const int t0c = 128 * g + 32 * h4, col0c = TL + bb * CL + t0c;
            ZChunk<4> xc_; zchunk_load<4>(xc_, ZT + (size_t)d * ZLD, col0c, t0c, CL);
            f32x4 acc[8];
#pragma unroll
            for (int i = 0; i < 8; ++i) acc[i] = (f32x4){0.f, 0.f, 0.f, 0.f};
            const bool valid = Isub == 0;
            const LAS unsigned char* bp = valid ? lds + CV_VC + bb * CV_VCB + h4 * 16 : lds + CV_ZERO + h4 * 16;
            const int xb = CL - 128 * g - 8 * r + 8 * h4;
            const LAS unsigned char* ap = lds + CV_KRC + (xb - 8) * 2;
#pragma unroll
            for (int kk = 0; kk < 8; ++kk) {
                const u32x4 ca = *(const LAS u32x4*)(ap + 64 * kk), cbv = *(const LAS u32x4*)(ap + 64 * kk + 16);
                const bf16x8 bfr = *(const LAS bf16x8*)(bp + 64 * kk);
                const unsigned dd[8] = {ca.x, ca.y, ca.z, ca.w, cbv.x, cbv.y, cbv.z, cbv.w};
                CV_MMA8(acc, dd, bfr);
            }
            float x0c[32]; zchunk_conv3<4>(xc_, t0c, CL, c0, c1, c2, cb0, x0c);
            const LAS unsigned char* vp = lds + CV_VC + bb * CV_VCB + t0c * 2;
            u32x4 outv[4];
#pragma unroll
            for (int i = 0; i < 4; ++i) { const u32x4 vv = *(const LAS u32x4*)(vp + 16 * i); const unsigned vw[4] = {vv.x, vv.y, vv.z, vv.w}; unsigned ow[4];
#pragma unroll
                for (int p = 0; p < 4; ++p) { const int e0 = 8 * i + 2 * p, e1 = e0 + 1;
                    const float y0 = (acc[e0 & 7][e0 >> 3] * inv_c + skip * bflo(vw[p])) * x0c[e0], y1 = (acc[e1 & 7][e1 >> 3] * inv_c + skip * bfhi(vw[p])) * x0c[e1];
                    ow[p] = pk2(y0, y1); }
                outv[i] = (u32x4){ow[0], ow[1], ow[2], ow[3]}; }
            if (valid) {
#pragma unroll
                for (int i = 0; i < 4; ++i) *(GAS u32x4*)(YXT + (size_t)d * ZLD + col0c + 8 * i) = outv[i]; }
        }
    }
}

constexpr int CV_BAR4 = 61312;
__device__ __forceinline__ void bar4(volatile LAS unsigned* cnt, unsigned target, int lane) {
    asm volatile("s_waitcnt lgkmcnt(0)" ::: "memory");
    if (lane == 0) __hip_atomic_fetch_add((LAS unsigned*)cnt, 1u, __ATOMIC_RELAXED, __HIP_MEMORY_SCOPE_WORKGROUP);
    while (*cnt < target) __builtin_amdgcn_s_sleep(1);
    asm volatile("" ::: "memory");
}
struct ConvPre4 { u32x4 kf[2], kb[2], kc; ZChunk<4> zv[2], zx[2]; ZChunk<1> cv, cx; };
__device__ __forceinline__ void conv4_issue(ConvPre4& P, Frame& F, int d) {
    const int tid = F.tid; const bf16* ZT = (const bf16*)(F.ws + WS_ZT);
    const bf16* kn = (const bf16*)(F.ws + WS_KRN) + (size_t)d * 2 * SL; const bf16* kc = (const bf16*)(F.ws + WS_KRC) + (size_t)d * 2 * CL;
#pragma unroll
    for (int h = 0; h < 2; ++h) { P.kf[h] = *(const GAS u32x4*)(kn + 16 * tid + 8 * h); P.kb[h] = *(const GAS u32x4*)(kn + SL + 16 * tid + 8 * h); }
    P.kc = *(const GAS u32x4*)(kc + ((tid >> 5) & 1) * CL + 8 * (tid & 31));
    { const int b = tid >> 6, t0 = (tid & 63) * 64;
#pragma unroll
      for (int h = 0; h < 2; ++h) { zchunk_load<4>(P.zv[h], ZT + (size_t)(4096 + d) * ZLD, b * SL + t0 + 32 * h, t0 + 32 * h, SL); zchunk_load<4>(P.zx[h], ZT + (size_t)(2048 + d) * ZLD, b * SL + t0 + 32 * h, t0 + 32 * h, SL); } }
    { const int b = (tid >> 5) & 3, t0 = (tid & 31) * 8, col0 = TL + b * CL + t0;
      zchunk_load<1>(P.cv, ZT + (size_t)(4096 + d) * ZLD, col0, t0, CL); zchunk_load<1>(P.cx, ZT + (size_t)(2048 + d) * ZLD, col0, t0, CL); }
}
__device__ __forceinline__ void p_conv4(Frame& F) {
    LAS unsigned char* lds = F.lds;
    for (int i = F.tid; i < 128; i += NTHR) ((LAS unsigned*)(lds + CV_ZERO))[i] = 0u;
    if (F.tid == 0) *(volatile LAS unsigned*)(lds + CV_BAR4) = 0u;
    __syncthreads();
    if (F.wave >= 4) {
        cvt_weights(F, CVT_DENSE, CVT_NITEMS, F.c * 4 + (F.wave - 4), F.G * 4, (LAS float*)(lds + 65536 + (F.wave - 4) * 8448)); return; }
    const bf16* ZT = (const bf16*)(F.ws + WS_ZT); bf16* YXT = (bf16*)(F.ws + WS_YXT);
    const float* cw = F.in[I_HCW]; const float* cbp = F.in[I_HCB];
    const int tid = F.tid, lane = F.lane, w = F.wave, g = w & 1, r = lane & 15, h4 = lane >> 4, Isub = r >> 2, bb = r & 3;
    volatile LAS unsigned* b4 = (volatile LAS unsigned*)(lds + CV_BAR4); unsigned nb4 = 0;
    ConvPre4 P;
    if (F.c < D) conv4_issue(P, F, F.c);
#pragma unroll 1
    for (int d = F.c; d < D; d += F.G) {
        nb4 += 4; bar4(b4, nb4, lane);
        float nl = 0.f, nc = 0.f;
        { LAS bf16* KR = (LAS bf16*)(lds + CV_KR);
#pragma unroll
          for (int h = 0; h < 2; ++h) { const unsigned fwv[4] = {P.kf[h].x, P.kf[h].y, P.kf[h].z, P.kf[h].w}, bwv[4] = {P.kb[h].x, P.kb[h].y, P.kb[h].z, P.kb[h].w};
#pragma unroll
              for (int e = 0; e < 8; ++e) { const int j = 16 * tid + 8 * h + e; const unsigned short fv = (unsigned short)(fwv[e >> 1] >> (16 * (e & 1))), bv = (unsigned short)(bwv[e >> 1] >> (16 * (e & 1)));
                  KR[SL - j] = fv; nl += fabsf(bf2f(fv));
                  if (j > 0) { KR[SL + j] = bv; nl += fabsf(bf2f(bv)); } } }
          if (tid == 0) KR[0] = 0;
          if (tid < 64) { LAS bf16* KC = (LAS bf16*)(lds + CV_KRC); const int dirn = tid >> 5, j0 = 8 * (tid & 31);
              const unsigned cv4[4] = {P.kc.x, P.kc.y, P.kc.z, P.kc.w};
#pragma unroll
              for (int e = 0; e < 8; ++e) { const int j = j0 + e; const unsigned short v = (unsigned short)(cv4[e >> 1] >> (16 * (e & 1)));
                  if (dirn == 0) { KC[CL - j] = v; nc += fabsf(bf2f(v)); } else if (j > 0) { KC[CL + j] = v; nc += fabsf(bf2f(v)); } }
              if (tid == 0) KC[0] = 0; } }
        { const int chv = 4096 + d, chx = 2048 + d;
          const float v0 = cw[chv], v1 = cw[6144 + chv], v2 = cw[12288 + chv], vb = cbp[chv], x0 = cw[chx], x1 = cw[6144 + chx], x2 = cw[12288 + chx], xb = cbp[chx];
#pragma unroll
          for (int h = 0; h < 2; ++h) { const int b = tid >> 6, t0 = (tid & 63) * 64 + 32 * h; float zv[32], zx[32];
            zchunk_conv3<4>(P.zv[h], t0, SL, v0, v1, v2, vb, zv); zchunk_conv3<4>(P.zx[h], t0, SL, x0, x1, x2, xb, zx);
            LAS unsigned char* dst = lds + CV_V + b * CV_VB + (t0 >> 8) * CV_VJ + (t0 & 255) * 2;
#pragma unroll
            for (int i = 0; i < 4; ++i) { u32x4 o; o.x = pk2(zv[8 * i] * zx[8 * i], zv[8 * i + 1] * zx[8 * i + 1]); o.y = pk2(zv[8 * i + 2] * zx[8 * i + 2], zv[8 * i + 3] * zx[8 * i + 3]);
                o.z = pk2(zv[8 * i + 4] * zx[8 * i + 4], zv[8 * i + 5] * zx[8 * i + 5]); o.w = pk2(zv[8 * i + 6] * zx[8 * i + 6], zv[8 * i + 7] * zx[8 * i + 7]); *(LAS u32x4*)(dst + 16 * i) = o; } }
          { const int b = (tid >> 5) & 3, t0 = (tid & 31) * 8; float zv[8], zx[8];
            zchunk_conv3<1>(P.cv, t0, CL, v0, v1, v2, vb, zv); zchunk_conv3<1>(P.cx, t0, CL, x0, x1, x2, xb, zx);
            u32x4 o; o.x = pk2(zv[0] * zx[0], zv[1] * zx[1]); o.y = pk2(zv[2] * zx[2], zv[3] * zx[3]); o.z = pk2(zv[4] * zx[4], zv[5] * zx[5]); o.w = pk2(zv[6] * zx[6], zv[7] * zx[7]);
            if (tid < 128) *(LAS u32x4*)(lds + CV_VC + b * CV_VCB + t0 * 2) = o; } }
        nl = wave_sum(nl); nc = wave_sum(nc);
        if (lane == 0) { ((LAS float*)(lds + CV_RED))[w] = nl; ((LAS float*)(lds + CV_RED))[8 + w] = nc; }
        nb4 += 4; bar4(b4, nb4, lane);
        { const int dn = d + F.G; conv4_issue(P, F, dn < D ? dn : d); }
        float inv_l = 0.f, inv_c = ((LAS float*)(lds + CV_RED))[8];
#pragma unroll
        for (int i = 0; i < 4; ++i) inv_l += ((LAS float*)(lds + CV_RED))[i];
        inv_l = 1.0f / inv_l; inv_c = 1.0f / inv_c;
        const float skip = F.in[I_SKIP][d];
        const float c0 = cw[d], c1 = cw[6144 + d], c2 = cw[12288 + d], cb0 = cbp[d];
#pragma unroll 1
        for (int qi = 0; qi < 2; ++qi) {
            const int q = (w >> 1) + 2 * qi;
            const int I_ep = 4 * q + Isub, t0l = 256 * I_ep + 128 * g + 32 * h4, col0l = bb * SL + t0l;
            ZChunk<4> xl_; zchunk_load<4>(xl_, ZT + (size_t)d * ZLD, col0l, t0l, SL);
            f32x4 acc[8];
#pragma unroll
            for (int i = 0; i < 8; ++i) acc[i] = (f32x4){0.f, 0.f, 0.f, 0.f};
#define CV_BASES(dl_, ap_, bp_) do { const int J_ = 4 * q + Isub - (dl_); const bool v_ = (J_ >= 0) && (J_ <= 15); \
                bp_ = v_ ? lds + CV_V + bb * CV_VB + J_ * CV_VJ + h4 * 16 : lds + CV_ZERO + h4 * 16; \
                ap_ = lds + CV_KR + (SL - 256 * (dl_) - 128 * g - 8 * r + 8 * h4 - 8) * 2; } while (0)
            const LAS unsigned char *ap, *bp, *apn, *bpn;
            CV_BASES(4 * q - 15, ap, bp);
            u32x4 ca = *(const LAS u32x4*)(ap), cbv = *(const LAS u32x4*)(ap + 16); bf16x8 bfr = *(const LAS bf16x8*)(bp);
#pragma unroll 1
            for (int dl = 4 * q - 15; dl <= 4 * q + 3; ++dl) {
                { const int dn_ = dl < 4 * q + 3 ? dl + 1 : dl; CV_BASES(dn_, apn, bpn); }
#pragma unroll
                for (int kk = 0; kk < 8; ++kk) {
                    const LAS unsigned char* an_ = kk < 7 ? ap + 64 * (kk + 1) : apn; const LAS unsigned char* bn_ = kk < 7 ? bp + 64 * (kk + 1) : bpn;
                    const u32x4 can = *(const LAS u32x4*)(an_), cbn = *(const LAS u32x4*)(an_ + 16); const bf16x8 bfn = *(const LAS bf16x8*)(bn_);
                    __builtin_amdgcn_sched_barrier(0);
                    const unsigned dd[8] = {ca.x, ca.y, ca.z, ca.w, cbv.x, cbv.y, cbv.z, cbv.w};
                    CV_MMA8(acc, dd, bfr);
                    __builtin_amdgcn_sched_barrier(0);
                    ca = can; cbv = cbn; bfr = bfn;
                }
                ap = apn; bp = bpn;
            }
#undef CV_BASES
            float x0c[32]; zchunk_conv3<4>(xl_, t0l, SL, c0, c1, c2, cb0, x0c);
            const LAS unsigned char* vp = lds + CV_V + bb * CV_VB + I_ep * CV_VJ + (128 * g + 32 * h4) * 2;
#pragma unroll
            for (int i = 0; i < 4; ++i) { const u32x4 vv = *(const LAS u32x4*)(vp + 16 * i); const unsigned vw[4] = {vv.x, vv.y, vv.z, vv.w}; unsigned ow[4];
#pragma unroll
                for (int p = 0; p < 4; ++p) { const int e0 = 8 * i + 2 * p, e1 = e0 + 1;
                    const float y0 = (acc[e0 & 7][e0 >> 3] * inv_l + skip * bflo(vw[p])) * x0c[e0], y1 = (acc[e1 & 7][e1 >> 3] * inv_l + skip * bfhi(vw[p])) * x0c[e1];
                    ow[p] = pk2(y0, y1); }
                *(GAS u32x4*)(YXT + (size_t)d * ZLD + col0l + 8 * i) = (u32x4){ow[0], ow[1], ow[2], ow[3]}; }
        }
        if (w < 2) {
            const int t0c = 128 * g + 32 * h4, col0c = TL + bb * CL + t0c;
            ZChunk<4> xc_; zchunk_load<4>(xc_, ZT + (size_t)d * ZLD, col0c, t0c, CL);
            f32x4 acc[8];
#pragma unroll
            for (int i = 0; i < 8; ++i) acc[i] = (f32x4){0.f, 0.f, 0.f, 0.f};
            const bool valid = Isub == 0;
            const LAS unsigned char* bp = valid ? lds + CV_VC + bb * CV_VCB + h4 * 16 : lds + CV_ZERO + h4 * 16;
            const int xb = CL - 128 * g - 8 * r + 8 * h4;
            const LAS unsigned char* ap = lds + CV_KRC + (xb - 8) * 2;
#pragma unroll
            for (int kk = 0; kk < 8; ++kk) {
                const u32x4 ca = *(const LAS u32x4*)(ap + 64 * kk), cbv = *(const LAS u32x4*)(ap + 64 * kk + 16);
                const bf16x8 bfr = *(const LAS bf16x8*)(bp + 64 * kk);
                const unsigned dd[8] = {ca.x, ca.y, ca.z, ca.w, cbv.x, cbv.y, cbv.z, cbv.w};
                CV_MMA8(acc, dd, bfr);
            }
            float x0c[32]; zchunk_conv3<4>(xc_, t0c, CL, c0, c1, c2, cb0, x0c);
            const LAS unsigned char* vp = lds + CV_VC + bb * CV_VCB + t0c * 2;
            u32x4 outv[4];
#pragma unroll
            for (int i = 0; i < 4; ++i) { const u32x4 vv = *(const LAS u32x4*)(vp + 16 * i); const unsigned vw[4] = {vv.x, vv.y, vv.z, vv.w}; unsigned ow[4];
#pragma unroll
                for (int p = 0; p < 4; ++p) { const int e0 = 8 * i + 2 * p, e1 = e0 + 1;
                    const float y0 = (acc[e0 & 7][e0 >> 3] * inv_c + skip * bflo(vw[p])) * x0c[e0], y1 = (acc[e1 & 7][e1 >> 3] * inv_c + skip * bfhi(vw[p])) * x0c[e1];
                    ow[p] = pk2(y0, y1); }
                outv[i] = (u32x4){ow[0], ow[1], ow[2], ow[3]}; }
            if (valid) {
#pragma unroll
                for (int i = 0; i < 4; ++i) *(GAS u32x4*)(YXT + (size_t)d * ZLD + col0c + 8 * i) = outv[i]; }
        }
    }
}

__device__ __forceinline__ void p_transpose_yx(Frame& F) {
    const bf16* src = (const bf16*)(F.ws + WS_YXT); bf16* dst = (bf16*)(F.ws + WS_YX);
    LAS unsigned short* scr = (LAS unsigned short*)(F.lds + F.wave * 8704);
    const bool cw = F.c < 32; const int lane = F.lane;
    const int gw = (cw ? F.c : F.c - 32) * NWAVES + F.wave, NGW = (cw ? 32 : F.G - 32) * NWAVES;
    const int ntb = cw ? TC / 64 : TL / 64, tb0 = cw ? TL / 64 : 0, NTILES = (D / 64) * ntb;
    for (int it = gw; it < NTILES; it += NGW) {
        const int cb = it / ntb, tb = tb0 + it - cb * ntb, c0 = 64 * cb, tk0 = 64 * tb;
        u32x4 v[8];
#pragma unroll
        for (int i = 0; i < 8; ++i) v[i] = *(const GAS u32x4*)(src + (size_t)(c0 + 8 * i + (lane >> 3)) * ZLD + tk0 + 8 * (lane & 7));
#pragma unroll
        for (int i = 0; i < 8; ++i) { LAS unsigned* s = (LAS unsigned*)(scr + (8 * i + (lane >> 3)) * 68 + 8 * (lane & 7)); s[0] = v[i].x; s[1] = v[i].y; s[2] = v[i].z; s[3] = v[i].w; }
        LDS_WAIT(); asm volatile("" ::: "memory");
#pragma unroll
        for (int j = 0; j < 8; ++j) { const int tk = 8 * j + (lane >> 3), cc = 8 * (lane & 7); unsigned short e[8];
#pragma unroll
            for (int k = 0; k < 8; ++k) e[k] = scr[(cc + k) * 68 + tk];
            u32x4 o; o.x = e[0] | ((unsigned)e[1] << 16); o.y = e[2] | ((unsigned)e[3] << 16); o.z = e[4] | ((unsigned)e[5] << 16); o.w = e[6] | ((unsigned)e[7] << 16);
            *(GAS u32x4*)(dst + (size_t)(tk0 + tk) * D + c0 + cc) = o; }
        LDS_WAIT(); asm volatile("" ::: "memory");
    }
}
__device__ __forceinline__ void p4_ctx_handoff(Frame& F) {
    asm volatile("s_waitcnt vmcnt(0)" ::: "memory");
    __syncthreads();
    if (threadIdx.x == 0) {
        __builtin_amdgcn_fence(__ATOMIC_RELEASE, "agent");
        asm volatile("s_waitcnt vmcnt(0)" ::: "memory");
        (void)xb_add(F.ctl + CW_P4, 1u);
        unsigned sp = 0u; while (xb_ld(F.ctl + CW_P4) < 32u) { __builtin_amdgcn_s_sleep(1); if (++sp > (1u << 22)) break; }
        __builtin_amdgcn_fence(__ATOMIC_ACQUIRE, "agent");
        asm volatile("s_waitcnt vmcnt(0)" ::: "memory");
    }
    __syncthreads();
}
constexpr int S5_HS = 9216;
__device__ __forceinline__ unsigned cvt_pk_nv(float lo, float hi) { return pk2(lo, hi); }
__device__ __forceinline__ float fma_asm(float a, float b, float c) { float d; asm("v_fma_f32 %0, %1, %2, %3" : "=v"(d) : "v"(a), "v"(b), "v"(c)); return d; }
__device__ __forceinline__ size_t s5_row(int ti, int tau, int b, int dir) {
    if (ti < 8) { const int pos = 32 * ti + tau; return (size_t)(TL + b * CL + (dir ? CL - 1 - pos : pos)); }
    const int pos = 32 * (ti - 8) + tau; return (size_t)(b * SL + (dir ? SL - 1 - pos : pos));
}
__device__ __forceinline__ void p_s5(Frame& F, int dry = 0) {
    if (F.wave >= 4 && dry) return;
    if (F.wave >= 4) {
        const float* const* in = F.in; LAS float* scr = (LAS float*)(F.lds + 4 * S5_HS + (F.wave - 4) * 8448); f32x4 va[8];
#pragma unroll 1
        for (int it = CVT_P10 + F.c * 4 + (F.wave - 4); it < CVT_NITEMS; it += F.G * 4) { const TItem ta = p0_decode(in, F.ws, it); p0_item_load(va, ta, F.lane); p0_item_store(va, ta, scr, F.lane); __builtin_amdgcn_s_sleep(127); }
        return; }
    const int lane = F.lane, w = F.wave;
    const bf16* U = (const bf16*)(F.ws + WS_U);
    LAS unsigned char* Hs = F.lds + w * S5_HS;
    for (int sq = F.c * 4 + w; sq < 1024; sq += F.G * 4) {
        const int g = sq & 127, db = sq >> 7, dir = db >> 2, b = db & 3, pg = dir * 128 + g;
        const float step = __expf(F.in[I_SLOG][pg]);
        float lr, li;
        { const float ar = F.in[I_SARE][pg * 64 + lane], ai = F.in[I_SAIM][pg * 64 + lane]; const float er = expf(ar * step); float sn, cs; sincosf(ai * step, &sn, &cs); lr = er * cs; li = er * sn; }
        bf16x8 Bf[2][2];
#pragma unroll
        for (int ph = 0; ph < 2; ++ph) { const int p = 32 * ph + (lane & 31), hh = lane >> 5;
            const float ar = F.in[I_SARE][pg * 64 + p], ai = F.in[I_SAIM][pg * 64 + p]; const float er = expf(ar * step); float sn, cs; sincosf(ai * step, &sn, &cs);
            const float nr = er * cs - 1.0f, ni = er * sn, dn = 1.0f / (ar * ar + ai * ai); const float cr = (nr * ar + ni * ai) * dn, ci = (ni * ar - nr * ai) * dn;
            const float* br = F.in[I_SBRE] + ((size_t)pg * 64 + p) * 16 + 8 * hh; const float* bi = F.in[I_SBIM] + ((size_t)pg * 64 + p) * 16 + 8 * hh;
            unsigned wr_[4], wi_[4];
#pragma unroll
            for (int j = 0; j < 4; ++j) { const float r0 = br[2 * j], r1 = br[2 * j + 1], i0 = bi[2 * j], i1 = bi[2 * j + 1];
                wr_[j] = pk2(cr * r0 - ci * i0, cr * r1 - ci * i1); wi_[j] = pk2(cr * i0 + ci * r0, cr * i1 + ci * r1); }
            Bf[0][ph] = __builtin_bit_cast(bf16x8, (u32x4){wr_[0], wr_[1], wr_[2], wr_[3]}); Bf[1][ph] = __builtin_bit_cast(bf16x8, (u32x4){wi_[0], wi_[1], wi_[2], wi_[3]}); }
        bf16x8 Cf[4];
#pragma unroll
        for (int ks = 0; ks < 4; ++ks) { const int hp = lane & 15, p0 = 16 * ks + 4 * (lane >> 4);
            const float* crp = F.in[I_SCRE] + ((size_t)pg * 16 + hp) * 64 + p0; const float* cip = F.in[I_SCIM] + ((size_t)pg * 16 + hp) * 64 + p0;
            Cf[ks] = __builtin_bit_cast(bf16x8, (u32x4){pk2(crp[0], -cip[0]), pk2(crp[1], -cip[1]), pk2(crp[2], -cip[2]), pk2(crp[3], -cip[3])}); }
        bf16* Yp = (bf16*)(F.ws + (dir ? WS_YB : WS_YF));
        float hr = 0.f, hi = 0.f; const float nli = -li;
#define urow(ti_, tau_) s5_row((ti_), (tau_), b, dir)
        const int tau_a = lane & 31, coff = 16 * g + 8 * (lane >> 5);
        constexpr int NPF = 2;
        bf16x8 uq[NPF];
#pragma unroll
        for (int k = 0; k < NPF; ++k) uq[k] = *(const GAS bf16x8*)(U + urow(k, tau_a) * D + coff);
#pragma unroll 1
        for (int ti = 0; ti < 8; ++ti) {
            const bf16x8 unew = *(const GAS bf16x8*)(U + urow(ti + NPF < 136 ? ti + NPF : 135, tau_a) * D + coff);
            const bf16x8 u0 = uq[0];
            f32x16 z16;
#pragma unroll
            for (int i = 0; i < 16; ++i) z16[i] = 0.f;
            float bur[32], bui[32];
            if (dry & 4) {
#pragma unroll
                for (int r = 0; r < 32; ++r) { bur[r] = __builtin_bit_cast(float, (int)u0[0]) * 1e-30f; bui[r] = bur[r]; } }
            else {
            f32x16 aR0 = __builtin_amdgcn_mfma_f32_32x32x16_bf16(u0, Bf[0][0], z16, 0, 0, 0), aR1 = __builtin_amdgcn_mfma_f32_32x32x16_bf16(u0, Bf[0][1], z16, 0, 0, 0);
            f32x16 aI0 = __builtin_amdgcn_mfma_f32_32x32x16_bf16(u0, Bf[1][0], z16, 0, 0, 0), aI1 = __builtin_amdgcn_mfma_f32_32x32x16_bf16(u0, Bf[1][1], z16, 0, 0, 0);
#pragma unroll
            for (int r = 0; r < 16; ++r) {
                const float fa = aR0[r], fb = aR1[r], fc = aI0[r], fd = aI1[r];
                auto sr = __builtin_amdgcn_permlane32_swap(__float_as_uint(fa), __float_as_uint(fb), false, false);
                auto si = __builtin_amdgcn_permlane32_swap(__float_as_uint(fc), __float_as_uint(fd), false, false);
                const unsigned sr0 = sr[0], sr1 = sr[1], si0 = si[0], si1 = si[1];
                const int tA = (r & 3) + 8 * (r >> 2);
                bur[tA] = __uint_as_float(sr0); bur[tA + 4] = __uint_as_float(sr1); bui[tA] = __uint_as_float(si0); bui[tA + 4] = __uint_as_float(si1); }
            }
#pragma unroll
            for (int tau = 0; tau < 32; ++tau) {
                if (dry & 1) { hr = bur[tau]; hi = bui[tau]; } else {
                const float t1 = __builtin_fmaf(lr, hr, bur[tau]), t2 = __builtin_fmaf(lr, hi, bui[tau]);
                const float nhr = __builtin_fmaf(-li, hi, t1), nhi = __builtin_fmaf(li, hr, t2);
                hr = nhr; hi = nhi; }
                if (false) { if (!(dry & 8)) *(LAS unsigned*)(Hs + tau * 288 + lane * 4) = cvt_pk_nv(hr, hi); }
            }
            if (false) {
                asm volatile("s_waitcnt lgkmcnt(0)" ::: "memory");
#pragma unroll
                for (int mt = 0; mt < ((dry & 2) ? 0 : 2); ++mt) { f32x4 ay = {0.f, 0.f, 0.f, 0.f};
#pragma unroll
                    for (int ks = 0; ks < 4; ++ks) { const bf16x8 hf = *(const LAS bf16x8*)(Hs + (16 * mt + (lane & 15)) * 288 + (32 * ks + 8 * (lane >> 4)) * 2);
                        ay = __builtin_amdgcn_mfma_f32_16x16x32_bf16(Cf[ks], hf, ay, 0, 0, 0); }
                    u32x2 o; o.x = pk2(ay[0], ay[1]); o.y = pk2(ay[2], ay[3]);
                    if (!dry) *(GAS u32x2*)(Yp + urow(ti, 16 * mt + (lane & 15)) * D + 16 * g + 4 * (lane >> 4)) = o; else if (o.x == 0x12345678u) *(GAS u32x2*)(Yp) = o; }
                asm volatile("s_waitcnt lgkmcnt(0)" ::: "memory");
            }
#pragma unroll
            for (int k = 0; k + 1 < NPF; ++k) uq[k] = uq[k + 1];
            uq[NPF - 1] = unew;
        }
        unsigned dx = 0;
#pragma unroll 1
        for (int ti = 8; ti < 136; ++ti) {
            const bf16x8 unew = *(const GAS bf16x8*)(U + urow(ti + NPF < 136 ? ti + NPF : 135, tau_a) * D + coff);
            const bf16x8 u0 = uq[0];
            f32x16 z16;
#pragma unroll
            for (int i = 0; i < 16; ++i) z16[i] = 0.f;
            float bur[32], bui[32];
            if (dry & 4) {
#pragma unroll
                for (int r = 0; r < 32; ++r) { bur[r] = __builtin_bit_cast(float, (int)u0[0]) * 1e-30f; bui[r] = bur[r]; } }
            else {
            f32x16 aR0 = __builtin_amdgcn_mfma_f32_32x32x16_bf16(u0, Bf[0][0], z16, 0, 0, 0), aR1 = __builtin_amdgcn_mfma_f32_32x32x16_bf16(u0, Bf[0][1], z16, 0, 0, 0);
            f32x16 aI0 = __builtin_amdgcn_mfma_f32_32x32x16_bf16(u0, Bf[1][0], z16, 0, 0, 0), aI1 = __builtin_amdgcn_mfma_f32_32x32x16_bf16(u0, Bf[1][1], z16, 0, 0, 0);
#pragma unroll
            for (int r = 0; r < 16; ++r) {
                const float fa = aR0[r], fb = aR1[r], fc = aI0[r], fd = aI1[r];
                auto sr = __builtin_amdgcn_permlane32_swap(__float_as_uint(fa), __float_as_uint(fb), false, false);
                auto si = __builtin_amdgcn_permlane32_swap(__float_as_uint(fc), __float_as_uint(fd), false, false);
                const unsigned sr0 = sr[0], sr1 = sr[1], si0 = si[0], si1 = si[1];
                const int tA = (r & 3) + 8 * (r >> 2);
                bur[tA] = __uint_as_float(sr0); bur[tA + 4] = __uint_as_float(sr1); bui[tA] = __uint_as_float(si0); bui[tA + 4] = __uint_as_float(si1); }
            }
#pragma unroll
            for (int tau = 0; tau < 32; ++tau) {
                if (dry & 1) { hr = bur[tau]; hi = bui[tau]; } else {
                const float t1 = __builtin_fmaf(lr, hr, bur[tau]), t2 = __builtin_fmaf(lr, hi, bui[tau]);
                const float nhr = __builtin_fmaf(-li, hi, t1), nhi = __builtin_fmaf(li, hr, t2);
                hr = nhr; hi = nhi; }
                { if (!(dry & 8)) *(LAS unsigned*)(Hs + tau * 288 + lane * 4) = cvt_pk_nv(hr, hi); else if (dry & 32) dx ^= cvt_pk_nv(hr, hi); }
            }
            {
                asm volatile("s_waitcnt lgkmcnt(0)" ::: "memory");
#pragma unroll
                for (int mt = 0; mt < ((dry & 2) ? 0 : 2); ++mt) { f32x4 ay = {0.f, 0.f, 0.f, 0.f};
#pragma unroll
                    for (int ks = 0; ks < 4; ++ks) { const bf16x8 hf = *(const LAS bf16x8*)(Hs + (16 * mt + (lane & 15)) * 288 + (32 * ks + 8 * (lane >> 4)) * 2);
                        ay = __builtin_amdgcn_mfma_f32_16x16x32_bf16(Cf[ks], hf, ay, 0, 0, 0); }
                    u32x2 o; o.x = pk2(ay[0], ay[1]); o.y = pk2(ay[2], ay[3]);
                    if (!dry) *(GAS u32x2*)(Yp + urow(ti, 16 * mt + (lane & 15)) * D + 16 * g + 4 * (lane >> 4)) = o; else if (o.x == 0x12345678u) *(GAS u32x2*)(Yp) = o; }
                asm volatile("s_waitcnt lgkmcnt(0)" ::: "memory");
            }
#pragma unroll
            for (int k = 0; k + 1 < NPF; ++k) uq[k] = uq[k + 1];
            uq[NPF - 1] = unew;
        }
        if (dry && dx == 0x12345678u) *(LAS unsigned*)(Hs) = dx;
#undef urow
    }
}
__device__ __forceinline__ void p_s5_pipe(Frame& F) {
    if (F.wave >= 4) {
        const float* const* in = F.in; LAS float* scr = (LAS float*)(F.lds + 8 * S5_HS + (F.wave - 4) * 8448); f32x4 va[8];
#pragma unroll 1
        for (int it = CVT_P10 + F.c * 4 + (F.wave - 4); it < CVT_NITEMS; it += F.G * 4) { const TItem ta = p0_decode(in, F.ws, it); p0_item_load(va, ta, F.lane); p0_item_store(va, ta, scr, F.lane); __builtin_amdgcn_s_sleep(127); }
        return; }
    const int lane = F.lane, w = F.wave;
    const bf16* U = (const bf16*)(F.ws + WS_U);
    LAS unsigned char* Hs0 = F.lds + w * 2 * S5_HS;
    for (int sq = F.c * 4 + w; sq < 1024; sq += F.G * 4) {
        const int g = sq & 127, db = sq >> 7, dir = db >> 2, b = db & 3, pg = dir * 128 + g;
        const float step = __expf(F.in[I_SLOG][pg]);
        float lr, li;
        { const float ar = F.in[I_SARE][pg * 64 + lane], ai = F.in[I_SAIM][pg * 64 + lane]; const float er = expf(ar * step); float sn, cs; sincosf(ai * step, &sn, &cs); lr = er * cs; li = er * sn; }
        bf16x8 Bf[2][2];
#pragma unroll
        for (int ph = 0; ph < 2; ++ph) { const int p = 32 * ph + (lane & 31), hh = lane >> 5;
            const float ar = F.in[I_SARE][pg * 64 + p], ai = F.in[I_SAIM][pg * 64 + p]; const float er = expf(ar * step); float sn, cs; sincosf(ai * step, &sn, &cs);
            const float nr = er * cs - 1.0f, ni = er * sn, dn = 1.0f / (ar * ar + ai * ai); const float cr = (nr * ar + ni * ai) * dn, ci = (ni * ar - nr * ai) * dn;
            const float* br = F.in[I_SBRE] + ((size_t)pg * 64 + p) * 16 + 8 * hh; const float* bi = F.in[I_SBIM] + ((size_t)pg * 64 + p) * 16 + 8 * hh;
            unsigned wr_[4], wi_[4];
#pragma unroll
            for (int j = 0; j < 4; ++j) { const float r0 = br[2 * j], r1 = br[2 * j + 1], i0 = bi[2 * j], i1 = bi[2 * j + 1];
                wr_[j] = pk2(cr * r0 - ci * i0, cr * r1 - ci * i1); wi_[j] = pk2(cr * i0 + ci * r0, cr * i1 + ci * r1); }
            Bf[0][ph] = __builtin_bit_cast(bf16x8, (u32x4){wr_[0], wr_[1], wr_[2], wr_[3]}); Bf[1][ph] = __builtin_bit_cast(bf16x8, (u32x4){wi_[0], wi_[1], wi_[2], wi_[3]}); }
        bf16x8 Cf[4];
#pragma unroll
        for (int ks = 0; ks < 4; ++ks) { const int hp = lane & 15, p0 = 16 * ks + 4 * (lane >> 4);
            const float* crp = F.in[I_SCRE] + ((size_t)pg * 16 + hp) * 64 + p0; const float* cip = F.in[I_SCIM] + ((size_t)pg * 16 + hp) * 64 + p0;
            Cf[ks] = __builtin_bit_cast(bf16x8, (u32x4){pk2(crp[0], -cip[0]), pk2(crp[1], -cip[1]), pk2(crp[2], -cip[2]), pk2(crp[3], -cip[3])}); }
        bf16* Yp = (bf16*)(F.ws + (dir ? WS_YB : WS_YF));
        float hr = 0.f, hi = 0.f;
#define urow(ti_, tau_) s5_row((ti_), (tau_), b, dir)
        const int tau_a = lane & 31, coff = 16 * g + 8 * (lane >> 5);
        constexpr int NPF = 3;
        bf16x8 uq[NPF];
#pragma unroll
        for (int k = 0; k < NPF; ++k) uq[k] = *(const GAS bf16x8*)(U + urow(1 + k, tau_a) * D + coff);
        f32x16 z16;
#pragma unroll
        for (int i = 0; i < 16; ++i) z16[i] = 0.f;
        float bur[32], bui[32];
        f32x16 aR0, aR1, aI0, aI1;
#define S5_BPROJ(uf) do { aR0 = __builtin_amdgcn_mfma_f32_32x32x16_bf16(uf, Bf[0][0], z16, 0, 0, 0); aR1 = __builtin_amdgcn_mfma_f32_32x32x16_bf16(uf, Bf[0][1], z16, 0, 0, 0); \
            aI0 = __builtin_amdgcn_mfma_f32_32x32x16_bf16(uf, Bf[1][0], z16, 0, 0, 0); aI1 = __builtin_amdgcn_mfma_f32_32x32x16_bf16(uf, Bf[1][1], z16, 0, 0, 0); } while (0)
#define S5_SWAPS() do { _Pragma("unroll") for (int r = 0; r < 16; ++r) { \
            const float fa = aR0[r], fb = aR1[r], fc = aI0[r], fd = aI1[r];     \
            auto sr = __builtin_amdgcn_permlane32_swap(__float_as_uint(fa), __float_as_uint(fb), false, false); \
            auto si = __builtin_amdgcn_permlane32_swap(__float_as_uint(fc), __float_as_uint(fd), false, false); \
            const unsigned sr0 = sr[0], sr1 = sr[1], si0 = si[0], si1 = si[1]; const int tA = (r & 3) + 8 * (r >> 2); \
            bur[tA] = __uint_as_float(sr0); bur[tA + 4] = __uint_as_float(sr1); bui[tA] = __uint_as_float(si0); bui[tA + 4] = __uint_as_float(si1); } } while (0)
#define S5_SCAN(HS, OUT) do { _Pragma("unroll") for (int tau = 0; tau < 32; ++tau) { \
            const float t1 = __builtin_fmaf(lr, hr, bur[tau]), t2 = __builtin_fmaf(lr, hi, bui[tau]); \
            const float nhr = __builtin_fmaf(-li, hi, t1), nhi = __builtin_fmaf(li, hr, t2); hr = nhr; hi = nhi; \
            if (OUT) *(LAS unsigned*)((HS) + tau * 288 + lane * 4) = cvt_pk_nv(hr, hi); } } while (0)
        { const bf16x8 ufirst = *(const GAS bf16x8*)(U + urow(0, tau_a) * D + coff); S5_BPROJ(ufirst); S5_SWAPS(); }
#pragma unroll 1
        for (int ti = 0; ti < 8; ++ti) {
            const bf16x8 unew = *(const GAS bf16x8*)(U + urow(ti + 1 + NPF < 136 ? ti + 1 + NPF : 135, tau_a) * D + coff);
            const bf16x8 un = uq[0];
            S5_BPROJ(un);
            S5_SCAN(Hs0, false);
            S5_SWAPS();
#pragma unroll
            for (int k = 0; k + 1 < NPF; ++k) uq[k] = uq[k + 1];
            uq[NPF - 1] = unew;
        }
        f32x4 ay0 = {0.f, 0.f, 0.f, 0.f}, ay1 = ay0;
#pragma unroll 1
        for (int ti = 8; ti < 136; ++ti) {
            const bf16x8 unew = *(const GAS bf16x8*)(U + urow(ti + 1 + NPF < 136 ? ti + 1 + NPF : 135, tau_a) * D + coff);
            const bf16x8 un = uq[0];
            LAS unsigned char* hcur = Hs0 + (ti & 1) * S5_HS; const LAS unsigned char* hprev = Hs0 + ((ti - 1) & 1) * S5_HS;
            S5_BPROJ(un);
            S5_SCAN(hcur, true);
            if (ti > 8) {
                asm volatile("s_waitcnt lgkmcnt(0)" ::: "memory");
                ay0 = (f32x4){0.f, 0.f, 0.f, 0.f}; ay1 = ay0;
#pragma unroll
                for (int ks = 0; ks < 4; ++ks) { const bf16x8 h0 = *(const LAS bf16x8*)(hprev + (lane & 15) * 288 + (32 * ks + 8 * (lane >> 4)) * 2), h1 = *(const LAS bf16x8*)(hprev + (16 + (lane & 15)) * 288 + (32 * ks + 8 * (lane >> 4)) * 2);
                    ay0 = __builtin_amdgcn_mfma_f32_16x16x32_bf16(Cf[ks], h0, ay0, 0, 0, 0); ay1 = __builtin_amdgcn_mfma_f32_16x16x32_bf16(Cf[ks], h1, ay1, 0, 0, 0); } }
            S5_SWAPS();
            if (ti > 8) { u32x2 o0, o1; o0.x = pk2(ay0[0], ay0[1]); o0.y = pk2(ay0[2], ay0[3]); o1.x = pk2(ay1[0], ay1[1]); o1.y = pk2(ay1[2], ay1[3]);
                *(GAS u32x2*)(Yp + urow(ti - 1, lane & 15) * D + 16 * g + 4 * (lane >> 4)) = o0; *(GAS u32x2*)(Yp + urow(ti - 1, 16 + (lane & 15)) * D + 16 * g + 4 * (lane >> 4)) = o1; }
#pragma unroll
            for (int k = 0; k + 1 < NPF; ++k) uq[k] = uq[k + 1];
            uq[NPF - 1] = unew;
        }
        {
            const LAS unsigned char* hprev = Hs0 + (135 & 1) * S5_HS;
            asm volatile("s_waitcnt lgkmcnt(0)" ::: "memory");
            ay0 = (f32x4){0.f, 0.f, 0.f, 0.f}; ay1 = ay0;
#pragma unroll
            for (int ks = 0; ks < 4; ++ks) { const bf16x8 h0 = *(const LAS bf16x8*)(hprev + (lane & 15) * 288 + (32 * ks + 8 * (lane >> 4)) * 2), h1 = *(const LAS bf16x8*)(hprev + (16 + (lane & 15)) * 288 + (32 * ks + 8 * (lane >> 4)) * 2);
                ay0 = __builtin_amdgcn_mfma_f32_16x16x32_bf16(Cf[ks], h0, ay0, 0, 0, 0); ay1 = __builtin_amdgcn_mfma_f32_16x16x32_bf16(Cf[ks], h1, ay1, 0, 0, 0); }
            u32x2 o0, o1; o0.x = pk2(ay0[0], ay0[1]); o0.y = pk2(ay0[2], ay0[3]); o1.x = pk2(ay1[0], ay1[1]); o1.y = pk2(ay1[2], ay1[3]);
            *(GAS u32x2*)(Yp + urow(135, lane & 15) * D + 16 * g + 4 * (lane >> 4)) = o0; *(GAS u32x2*)(Yp + urow(135, 16 + (lane & 15)) * D + 16 * g + 4 * (lane >> 4)) = o1;
            asm volatile("s_waitcnt lgkmcnt(0)" ::: "memory");
        }
#undef S5_BPROJ
#undef S5_SWAPS
#undef S5_SCAN
#undef urow
    }
}
__device__ __forceinline__ float gelu_tanh(float x) { const float u = 0.7978845608028654f * (x + 0.044715f * x * x * x); const float e = __expf(2.0f * u); const float th = 1.0f - 2.0f / (e + 1.0f); return 0.5f * x * (1.0f + th); }
__device__ __forceinline__ void p_s5_gelu(Frame& F) {
    const bf16* U = (const bf16*)(F.ws + WS_U); const bf16* YF = (const bf16*)(F.ws + WS_YF); const bf16* YB = (const bf16*)(F.ws + WS_YB); bf16* Gb = (bf16*)(F.ws + WS_G);
    const float* dsk = F.in[I_SD];
    const size_t n8 = (size_t)TL * D / 8, stride = (size_t)F.G * NTHR;
    for (size_t i = (size_t)F.c * NTHR + F.tid; i < n8; i += stride) {
        const u32x4 u = *(const GAS u32x4*)(U + 8 * i), a = *(const GAS u32x4*)(YF + 8 * i), b = *(const GAS u32x4*)(YB + 8 * i);
        const int c = (int)((8 * i) & 2047); const f32x4 d0 = *(const GAS f32x4*)(dsk + c), d1 = *(const GAS f32x4*)(dsk + c + 4);
        const unsigned uw[4] = {u.x, u.y, u.z, u.w}, aw[4] = {a.x, a.y, a.z, a.w}, bw[4] = {b.x, b.y, b.z, b.w}; const float dv[8] = {d0[0], d0[1], d0[2], d0[3], d1[0], d1[1], d1[2], d1[3]}; unsigned ow[4];
#pragma unroll
        for (int p = 0; p < 4; ++p) { const float y0 = dv[2 * p] * bflo(uw[p]) + bflo(aw[p]) + bflo(bw[p]), y1 = dv[2 * p + 1] * bfhi(uw[p]) + bfhi(aw[p]) + bfhi(bw[p]);
            ow[p] = pk2(gelu_tanh(y0), gelu_tanh(y1)); }
        *(GAS u32x4*)(Gb + 8 * i) = (u32x4){ow[0], ow[1], ow[2], ow[3]};
    }
}
#ifndef MK_N_LAUNCHES
#define MK_N_LAUNCHES 1
#endif
constexpr int N_PHASES = 17;

__device__ __forceinline__ void moe_rowtab(Frame& F, int nrb) {
    const LAS int* rb_e = (const LAS int*)(F.lds + TAB_OFF); const LAS int* rbfirst = rb_e + 168; const LAS int* cnt = rbfirst + 33;
    LAS unsigned* rowtab = (LAS unsigned*)(F.lds + ROWTAB_OFF); const int* list = (const int*)(F.ws + WS_LIST);
    const int nu = nrb * 8, h = F.tid >> 8, sl = F.tid & 255; int tok[4]; bool ok[4];
#pragma unroll
    for (int j = 0; j < 4; ++j) { const int i = 2 * j + h; const int L0 = i * F.G + F.c; const int L = L0 < nu ? L0 : nu - 1;
        const int rbi = L >> 3, e = rb_e[rbi], rbl = rbi - rbfirst[e]; const int slot = rbl * 256 + sl; const bool v = slot < cnt[e];
        tok[j] = ((const GAS int*)list)[(size_t)e * TT + (v ? slot : 0)]; ok[j] = v; }
#pragma unroll
    for (int j = 0; j < 4; ++j) { const int i = 2 * j + h; if (i * F.G + F.c < nu) rowtab[i * 256 + sl] = ok[j] ? (unsigned)tok[j] * (unsigned)(D * 2) : 0u; }
    __syncthreads();
}

__global__ void __launch_bounds__(NTHR, 2) mega_fwd(Params P) {
    extern __shared__ __attribute__((aligned(16))) unsigned char lds_raw[];
    Frame F;
    F.lds = (LAS unsigned char*)lds_raw; F.ws = P.ws; F.ctl = (unsigned*)(P.ws + WS_CTL); F.in = P.in; F.out = P.out;
    F.tid = threadIdx.x; F.lane = F.tid & 63; F.wave = __builtin_amdgcn_readfirstlane(F.tid >> 6); F.G = gridDim.x; F.c = blockIdx.x;
    volatile LAS unsigned* MISC = (volatile LAS unsigned*)(F.lds + MISC_OFF);
    if (F.tid < 4) MISC[F.tid] = 0u;
    __syncthreads();
    XcdBarrier bar; bar.bar = F.ctl + CW_BAR; bar.x = 0; bar.st = MISC;
    if (MK_N_LAUNCHES == 1) bar = xcd_barrier_post(F.ctl + CW_BAR, MISC);
    const int lo = P.ph_lo, hi = P.ph_hi;
#define IN(k) (lo <= (k) && (k) < hi)
#define SEAM(k) do { if (IN(k) && IN((k) + 1)) xcd_barrier(bar); } while (0)
#ifndef PROBE_REP
#define PROBE_REP -1
#endif
    const size_t TS2048 = (size_t)256 * 2048 * 2, TS1024 = (size_t)256 * 1024 * 2;

#ifndef PROBE_N
#define PROBE_N 1
#endif
#ifndef PROBE_DRY
#define PROBE_DRY 0
#endif
#ifndef PROBE_SEL
#define PROBE_SEL 0
#endif
#ifndef PROBE_F
#define PROBE_F 4
#endif
#define STAMP(k) do { if (PROBE_SEL != 0 && blockIdx.x == 0) { int t_ = threadIdx.x; asm volatile("" : "+v"(t_)); if (t_ == 0) ((volatile LAS unsigned long long*)(F.lds + MISC_OFF + 128))[k] = __builtin_amdgcn_s_memrealtime(); } } while (0)
#define REFRESH() do { int t_ = threadIdx.x; asm volatile("" : "+v"(t_)); F.tid = t_; F.lane = t_ & 63; } while (0)
#define RUN(k, ...) if (IN(k)) { STAMP(k); REFRESH(); __VA_ARGS__ if (PROBE_REP == (k)) { _Pragma("unroll 1") for (int rep_ = 0; rep_ < PROBE_N; ++rep_) { xcd_barrier(bar); __VA_ARGS__ } } } SEAM(k);
#ifndef USE_TAILS
#define USE_TAILS 0
#endif
#define TAIL(nunits_, chunks_) do { if (!USE_TAILS) break; const int nu_ = (nunits_), mx_ = (nu_ + F.G - 1) / F.G, my_ = nu_ > F.c ? (nu_ - F.c + F.G - 1) / F.G : 0; if (my_ < mx_) cvt_pull(F, CVT_NITEMS, (chunks_), true); } while (0)
    RUN(0, { _Pragma("unroll 1") for (int st = 0; st < 3; ++st) { const int odd = F.c & 1; const int part = odd ? (st == 0 ? 1 : (st == 1 ? 0 : 2)) : (st == 0 ? 0 : (st == 1 ? 2 : 1));
        if (part == 0) p0_adaln(F); else if (part == 1) p0_filter(F); else cvt_weights(F, 0, CVT_DENSE, F.c * NWAVES + F.wave, F.G * NWAVES, (LAS float*)(F.lds + F.wave * 8448));
        __syncthreads(); REFRESH(); } })
    RUN(1, p_norm1_l0(F);)
    RUN(2, {
        pg8::DenseOrder S; S.init(F.ws + WS_WIN, F.ws + WS_U, 6144, TT, 2048, F.G, F.c);
        pg8::EpiZT E{(bf16*)(F.ws + WS_ZT), ZLD, F.in[I_HBIN]};
        pg8::gemm_phase<pg8::EpiZT, pg8::DenseOrder, false>(F.lds, 2048, S, E, nullptr);
        if (F.c >= 96) { REFRESH(); cvt_weights(F, CVT_P3_END, CVT_P10, (F.c - 96) * NWAVES + F.wave, (F.G - 96) * NWAVES, (LAS float*)(F.lds + F.wave * 8448)); } })
#ifndef USE_CONV4
#define USE_CONV4 1
#endif
#if USE_CONV4
#ifdef PROBE_CONVONLY
    RUN(3, p_conv_mix(F); xcd_barrier(bar); REFRESH(); p_conv_mix(F, false);)
#else
    RUN(3, p_conv_mix(F);)
#endif
#else
    RUN(3, p_conv(F);)
#endif
    if (IN(4)) { _Pragma("unroll 1") for (int sub = 0; sub < 2; ++sub) {
        if (sub == 0) { STAMP(4); REFRESH(); p_transpose_yx(F); if (F.c < 32) p4_ctx_handoff(F); REFRESH(); } else { STAMP(5); REFRESH(); }
        pg8::P5Order S; S.D.init(F.ws + WS_YX, F.ws + WS_WOUT, TL, 2048, 2048, F.G, F.c); S.sub = sub;
        pg8::EpiRes E{F.in[I_X], F.out, MODP(F, 0, 0) + 4096, F.in[I_CTX], (float*)(F.ws + WS_XC), MODP(F, 0, 4) + 4096, 12288, F.in[I_HBOUT]};
        pg8::gemm_phase<pg8::EpiRes, pg8::P5Order, false>(F.lds, 2048, S, E, nullptr);
        xcd_barrier(bar); } }
#define MOE_PHASES(l, P_R, P_GU, P_DN, NTOK, LIM_GU, LIM_DN) \
    RUN(P_R, if (!USE_CONV4) { cvt_drain(F, 2 * (l), LIM_GU); REFRESH(); } p_router(F, (l), (NTOK)); if (PROBE_DRY) { xcd_barrier(bar); REFRESH(); p_router(F, (l), (NTOK), PROBE_DRY); }) \
    RUN(P_GU, { if (!USE_CONV4) { cvt_drain(F, 2 * (l) + 1, LIM_DN); REFRESH(); } const int nrb = moe_tables(F, (l)); moe_rowtab(F, nrb); \
        pg8::MoeOrder S{(const char*)(F.ws + WS_U), (const char*)(F.ws + WS_WGU) + (size_t)(l) * 32 * 2048 * 2048 * 2, (const LAS int*)(F.lds + TAB_OFF), nrb, 8, F.G, F.c, 0, TS2048, (size_t)2048 * 2048 * 2, true}; \
        pg8::EpiGU E{(bf16*)(F.ws + WS_H), 1024}; \
        pg8::gemm_phase<pg8::EpiGU, pg8::MoeOrder, true>(F.lds, 2048, S, E, (const LAS unsigned*)(F.lds + ROWTAB_OFF)); TAIL(nrb * 8, 12); }) \
    RUN(P_DN, { const int nrb = moe_tables_cached(F, (l)); \
        pg8::MoeOrder S{(const char*)(F.ws + WS_H), (const char*)(F.ws + WS_WD) + (size_t)(l) * 32 * 2048 * 1024 * 2, (const LAS int*)(F.lds + TAB_OFF), nrb, 8, F.G, F.c, TS1024, TS1024, (size_t)2048 * 1024 * 2, false}; \
        pg8::EpiBf E{(bf16*)(F.ws + WS_EO), 2048}; \
        pg8::gemm_phase<pg8::EpiBf, pg8::MoeOrder, false>(F.lds, 1024, S, E, nullptr); TAIL(nrb * 8, 6); })
    MOE_PHASES(0, 6, 7, 8, TT, CVT_GU0, CVT_D0)
    RUN(9, p_comb_norm1_l1(F);)
#ifndef USE_S5_PIPE
#define USE_S5_PIPE 0
#endif
#if USE_S5_PIPE
    RUN(10, p_s5_pipe(F);)
#else
    RUN(10, p_s5(F); if (PROBE_DRY) { xcd_barrier(bar); REFRESH(); p_s5(F, PROBE_DRY); })
#endif
    RUN(11, p_s5_gelu(F);)
    RUN(12, {
        pg8::DenseOrder S; S.init(F.ws + WS_G, F.ws + WS_W12, TL, 4096, 2048, F.G, F.c);
        pg8::EpiGlu E{F.out, MODP(F, 1, 0) + 4096, 12288, F.in[I_SB1], F.in[I_SB2]};
        pg8::gemm_phase<pg8::EpiGlu, pg8::DenseOrder, false>(F.lds, 2048, S, E, nullptr); TAIL(64 * 16, 12); })
    MOE_PHASES(1, 13, 14, 15, TL, CVT_GU1, CVT_NITEMS)
    if (IN(16)) { STAMP(16); REFRESH(); p_final(F); }
    if (PROBE_SEL != 0) {
        asm volatile("s_waitcnt vmcnt(0)" ::: "memory"); __syncthreads();
        int tq_ = threadIdx.x; asm volatile("" : "+v"(tq_));
        if (blockIdx.x == 0 && tq_ == 0) { volatile LAS unsigned long long* ts = (volatile LAS unsigned long long*)(F.lds + MISC_OFF + 128);
            const unsigned long long tend = __builtin_amdgcn_s_memrealtime(); unsigned long long sum = 0;
            for (int k = 0; k < 17; ++k) if ((PROBE_SEL >> k) & 1) sum += (k < 16 ? ts[k + 1] : tend) - ts[k];
            while (__builtin_amdgcn_s_memrealtime() - tend < (unsigned long long)PROBE_F * sum) __builtin_amdgcn_s_sleep(8); }
    }
#undef IN
#undef SEAM
}

extern "C" void kernel_launch(void* const* d_in, const int* in_sizes, int n_in, void* d_out, int out_size, void* d_ws, size_t ws_size, hipStream_t stream) {
    static int grid = 0;
    if (grid == 0) {
        if (n_in != 40 || out_size != TL * D || ws_size < WS_END) { fprintf(stderr, "kernel_launch: unexpected shapes (n_in %d, out %d, ws %zu)\n", n_in, out_size, ws_size); grid = -1; return; }
        int dev = 0, cus = 0, per_cu = 0;
        if (hipGetDevice(&dev) != hipSuccess || hipDeviceGetAttribute(&cus, hipDeviceAttributeMultiprocessorCount, dev) != hipSuccess) { grid = -1; return; }
        if (hipFuncSetAttribute((const void*)mega_fwd, hipFuncAttributeMaxDynamicSharedMemorySize, LDS_BYTES) != hipSuccess) { fprintf(stderr, "kernel_launch: hipFuncSetAttribute failed\n"); grid = -1; return; }
        if (hipOccupancyMaxActiveBlocksPerMultiprocessor(&per_cu, (const void*)mega_fwd, NTHR, LDS_BYTES) != hipSuccess || per_cu < 1) { fprintf(stderr, "kernel_launch: occupancy query reports %d blocks per CU\n", per_cu); }
        (void)hipGetLastError();
        if (cus < 64) { fprintf(stderr, "kernel_launch: needs at least 64 CUs\n"); grid = -1; return; }
        grid = cus;
    }
    if (grid < 0) return;
    (void)hipMemsetAsync((char*)d_ws + WS_CTL, 0, CTL_BYTES, stream);
    Params p{};
    for (int i = 0; i < 40; ++i) p.in[i] = (const float*)d_in[i];
    p.out = (float*)d_out; p.ws = (unsigned char*)d_ws;
#if MK_N_LAUNCHES == 1
    p.ph_lo = 0; p.ph_hi = N_PHASES;
    hipLaunchKernelGGL(mega_fwd, dim3(grid), dim3(NTHR), LDS_BYTES, stream, p);
#else
    for (int k = 0; k < N_PHASES; ++k) { p.ph_lo = k; p.ph_hi = k + 1; hipLaunchKernelGGL(mega_fwd, dim3(grid), dim3(NTHR), LDS_BYTES, stream, p); }
#endif
}
```
